# Optimizing an MI355X kernel written in HIP

```python
import math
import jax, jax.numpy as jnp
from jax import lax
import numpy as np

D_MODEL = 1024
BATCH = 4
SEQ = 8192
DEPTH = 2

MIX_WIDTH = D_MODEL
DIFF_HEADS = 4
DIFF_D = D_MODEL // 16
DIFF_DV = 2 * DIFF_D
GLA_HEADS = 4
GLA_DV = D_MODEL // 8
GLA_DK = GLA_DV // 2
GLA_GATE_RANK = 16
GLA_GATE_NORMALIZER = 16.0
GLA_CHUNK = 64
PEER_HEADS = 8
PEER_N_KEYS = 128
PEER_N_EXPERTS = PEER_N_KEYS * PEER_N_KEYS
PEER_D_KEY = 256
PEER_TOPK = 16
PEER_TOKEN_BLOCK = 128
ATTN_Q_BLOCK = 128
RMS_EPS = 1e-6

IN_SIZES = (
    DIFF_HEADS * 2 * DIFF_D,
    DIFF_HEADS * 2 * DIFF_D,
    DIFF_HEADS * DIFF_DV,
    GLA_HEADS * GLA_DK,
    GLA_HEADS * GLA_DK,
    GLA_HEADS * GLA_DV,
    GLA_HEADS * GLA_DV,
    GLA_GATE_RANK,
)
IN_COLS = sum(IN_SIZES)

kernel_name = "hymba_diffattn_gla_peer"


def _split_points():
    pts, acc = [], 0
    for s in IN_SIZES[:-1]:
        acc += s
        pts.append(acc)
    return pts


def rms_norm(x, w):
    xf = x.astype(jnp.float32)
    y = xf * lax.rsqrt(jnp.mean(xf * xf, axis=-1, keepdims=True) + RMS_EPS)
    return (y * w.astype(jnp.float32)).astype(x.dtype)


def diff_attention(q, k, v, q_norm_w, k_norm_w, lam, lam_init, out_norm_w):
    B, T = q.shape[0], q.shape[1]
    q = rms_norm(q, q_norm_w) * (DIFF_D ** -0.5)
    k = rms_norm(k, k_norm_w)
    nb = T // ATTN_Q_BLOCK
    qb = q.reshape(B, nb, ATTN_Q_BLOCK, DIFF_HEADS, 2, DIFF_D).transpose(1, 0, 2, 3, 4, 5)
    kpos = jnp.arange(T)

    def block(args):
        qi, i = args
        s = jnp.einsum('bqhmd,bkhmd->bhmqk', qi, k, preferred_element_type=jnp.float32)
        qpos = i * ATTN_Q_BLOCK + jnp.arange(ATTN_Q_BLOCK)
        mask = kpos[None, :] <= qpos[:, None]
        p = jax.nn.softmax(jnp.where(mask, s, -jnp.inf), axis=-1)
        a = p[:, :, 0] - lam * p[:, :, 1]
        return jnp.einsum('bhqk,bkhe->bqhe', a.astype(v.dtype), v)

    o = lax.map(block, (qb, jnp.arange(nb)))
    o = o.transpose(1, 0, 2, 3, 4).reshape(B, T, DIFF_HEADS, DIFF_DV)
    o = rms_norm(o, out_norm_w) * (1.0 - lam_init)
    return o.reshape(B, T, DIFF_HEADS * DIFF_DV)


def gla_chunked(q, k, v, g_log, out_gate, out_norm_w):
    B, T = q.shape[0], q.shape[1]
    C = GLA_CHUNK
    n = T // C
    out_dtype = v.dtype

    def chunks(a):
        return a.astype(jnp.float32).reshape(B, n, C, GLA_HEADS, a.shape[-1]).transpose(0, 3, 1, 2, 4)

    qc = chunks(q) * (GLA_DK ** -0.5)
    kc, vc, gc = chunks(k), chunks(v), chunks(g_log)
    b = jnp.cumsum(gc, axis=3)
    b_last = b[:, :, :, -1:, :]
    q_dec = qc * jnp.exp(b)
    k_inv = kc * jnp.exp(-b)
    k_dec = kc * jnp.exp(b_last - b)
    causal = jnp.tril(jnp.ones((C, C), dtype=bool))
    A = jnp.where(causal, jnp.einsum('bhnid,bhnjd->bhnij', q_dec, k_inv), 0.0)
    o_intra = jnp.einsum('bhnij,bhnje->bhnie', A, vc)
    U = jnp.einsum('bhncd,bhnce->nbhde', k_dec, vc)
    decay = jnp.exp(b_last[:, :, :, 0, :]).transpose(2, 0, 1, 3)

    def step(S, inp):
        dec, u = inp
        return dec[..., None] * S + u, S

    S0 = jnp.zeros((B, GLA_HEADS, GLA_DK, GLA_DV), jnp.float32)
    _, S_prev = lax.scan(step, S0, (decay, U))
    o_inter = jnp.einsum('bhncd,nbhde->bhnce', q_dec, S_prev)
    o = (o_intra + o_inter).transpose(0, 2, 3, 1, 4).reshape(B, T, GLA_HEADS, GLA_DV)
    o = rms_norm(o, out_norm_w) * jax.nn.silu(out_gate.astype(jnp.float32))
    return o.reshape(B, T, GLA_HEADS * GLA_DV).astype(out_dtype)


def peer(h, w_q, sub_keys, u_tab, v_tab):
    B, T, D = h.shape
    nt = (B * T) // PEER_TOKEN_BLOCK
    hb = h.reshape(nt, PEER_TOKEN_BLOCK, D)
    tb, kk = PEER_TOKEN_BLOCK, PEER_TOPK

    def block(xb):
        q = (xb @ w_q).reshape(tb, PEER_HEADS, 2, PEER_D_KEY // 2)
        s = jnp.einsum('thcd,hckd->thck', q, sub_keys, preferred_element_type=jnp.float32)
        top_s, top_i = lax.top_k(s, kk)
        cand = top_s[:, :, 0, :, None] + top_s[:, :, 1, None, :]
        cand_idx = top_i[:, :, 0, :, None] * PEER_N_KEYS + top_i[:, :, 1, None, :]
        best_s, best_pos = lax.top_k(cand.reshape(tb, PEER_HEADS, kk * kk), kk)
        expert = jnp.take_along_axis(cand_idx.reshape(tb, PEER_HEADS, kk * kk), best_pos, axis=-1)
        gate = jax.nn.softmax(best_s, axis=-1)
        u = u_tab[expert]
        act = jax.nn.gelu(jnp.einsum('td,thkd->thk', xb, u, preferred_element_type=jnp.float32),
                          approximate=False)
        w = (gate * act).astype(xb.dtype)
        return jnp.einsum('thk,thkd->td', w, v_tab[expert])

    return lax.map(block, hb).reshape(B, T, D)


def setup_inputs(seed: int = 0) -> dict:
    key = jax.random.key(seed)
    ks = jax.random.split(key, 20)

    def nrm(k, shape, scale):
        return jax.random.normal(k, shape, jnp.float32) * scale

    return {
        "x": nrm(ks[0], (BATCH, SEQ, D_MODEL), 1.0),
        "attn_norm_w": 1.0 + nrm(ks[1], (DEPTH, D_MODEL), 0.02),
        "w_in": nrm(ks[2], (DEPTH, D_MODEL, IN_COLS), D_MODEL ** -0.5),
        "diff_q_norm_w": 1.0 + nrm(ks[3], (DEPTH, DIFF_D), 0.02),
        "diff_k_norm_w": 1.0 + nrm(ks[4], (DEPTH, DIFF_D), 0.02),
        "lambda_q1": nrm(ks[5], (DEPTH, DIFF_D), 0.1),
        "lambda_k1": nrm(ks[6], (DEPTH, DIFF_D), 0.1),
        "lambda_q2": nrm(ks[7], (DEPTH, DIFF_D), 0.1),
        "lambda_k2": nrm(ks[8], (DEPTH, DIFF_D), 0.1),
        "diff_out_norm_w": 1.0 + nrm(ks[9], (DEPTH, DIFF_DV), 0.02),
        "gla_gate_w2": nrm(ks[10], (DEPTH, GLA_GATE_RANK, GLA_HEADS * GLA_DK), GLA_GATE_RANK ** -0.5),
        "gla_gate_b": nrm(ks[11], (DEPTH, GLA_HEADS * GLA_DK), 0.01),
        "gla_out_norm_w": 1.0 + nrm(ks[12], (DEPTH, GLA_DV), 0.02),
        "w_out": nrm(ks[13], (DEPTH, MIX_WIDTH, D_MODEL), MIX_WIDTH ** -0.5),
        "ffn_norm_w": 1.0 + nrm(ks[14], (DEPTH, D_MODEL), 0.02),
        "peer_w_q": nrm(ks[15], (DEPTH, D_MODEL, PEER_HEADS * PEER_D_KEY), D_MODEL ** -0.5),
        "peer_sub_keys": nrm(ks[16], (DEPTH, PEER_HEADS, 2, PEER_N_KEYS, PEER_D_KEY // 2),
                             (PEER_D_KEY // 2) ** -0.5),
        "peer_u": nrm(ks[17], (DEPTH, PEER_N_EXPERTS, D_MODEL), D_MODEL ** -0.5),
        "peer_v": nrm(ks[18], (DEPTH, PEER_N_EXPERTS, D_MODEL), PEER_HEADS ** -0.5),
    }


def reference(x, attn_norm_w, w_in, diff_q_norm_w, diff_k_norm_w, lambda_q1, lambda_k1,
              lambda_q2, lambda_k2, diff_out_norm_w, gla_gate_w2, gla_gate_b, gla_out_norm_w,
              w_out, ffn_norm_w, peer_w_q, peer_sub_keys, peer_u, peer_v):
    B, T, _ = x.shape
    split_pts = _split_points()
    for l in range(DEPTH):
        h = rms_norm(x, attn_norm_w[l])
        proj = h @ w_in[l]
        d_q, d_k, d_v, g_q, g_k, g_v, g_out, g_lr = jnp.split(proj, split_pts, axis=-1)

        lam_init = 0.8 - 0.6 * math.exp(-0.3 * l)
        lam = (jnp.exp(jnp.sum(lambda_q1[l].astype(jnp.float32) * lambda_k1[l].astype(jnp.float32)))
               - jnp.exp(jnp.sum(lambda_q2[l].astype(jnp.float32) * lambda_k2[l].astype(jnp.float32)))
               + lam_init)
        diff_o = diff_attention(
            d_q.reshape(B, T, DIFF_HEADS, 2, DIFF_D),
            d_k.reshape(B, T, DIFF_HEADS, 2, DIFF_D),
            d_v.reshape(B, T, DIFF_HEADS, DIFF_DV),
            diff_q_norm_w[l], diff_k_norm_w[l], lam, lam_init, diff_out_norm_w[l])

        g_log = jax.nn.log_sigmoid((g_lr @ gla_gate_w2[l] + gla_gate_b[l]).astype(jnp.float32)) \
            / GLA_GATE_NORMALIZER
        gla_o = gla_chunked(
            g_q.reshape(B, T, GLA_HEADS, GLA_DK),
            g_k.reshape(B, T, GLA_HEADS, GLA_DK),
            g_v.reshape(B, T, GLA_HEADS, GLA_DV),
            g_log.reshape(B, T, GLA_HEADS, GLA_DK),
            g_out.reshape(B, T, GLA_HEADS, GLA_DV),
            gla_out_norm_w[l])

        mix = jnp.concatenate([diff_o.astype(x.dtype), gla_o.astype(x.dtype)], axis=-1)
        x = x + mix @ w_out[l]

        h = rms_norm(x, ffn_norm_w[l])
        x = x + peer(h, peer_w_q[l], peer_sub_keys[l], peer_u[l], peer_v[l])
    return x
```

```cpp
#include <hip/hip_runtime.h>
#include <cstdio>
#include <cstdint>
#include <utility>
namespace pg8 {
#define PG8_LAS __attribute__((address_space(3)))
typedef unsigned short bf16_t;
typedef short bf16x8 __attribute__((ext_vector_type(8)));
typedef float f32x4 __attribute__((ext_vector_type(4)));
typedef unsigned u32x4 __attribute__((ext_vector_type(4)));
__device__ __forceinline__ float xsum16(float v) { auto rr = __builtin_amdgcn_permlane16_swap(__float_as_uint(v), __float_as_uint(v), false, false); return __uint_as_float(rr[0]) + __uint_as_float(rr[1]); }
__device__ __forceinline__ float xsum32(float v) { auto rr = __builtin_amdgcn_permlane32_swap(__float_as_uint(v), __float_as_uint(v), false, false); return __uint_as_float(rr[0]) + __uint_as_float(rr[1]); }
constexpr int BM = 256, BK = 64, HALF = 128, HTB = HALF * BK * 2  , STAGE_BYTES = 8 * HTB, NXCD = 8, WGM = 8;

__host__ __device__ __forceinline__ int lds_byte(int r, int c) { const int st = (r >> 4) * 2 + (c >> 5), rr = r & 15, cc = c & 31, ob = rr * 64 + cc * 2; return st * 1024 + (ob ^ (((ob >> 9) & 1) << 5)); }
__host__ __device__ __forceinline__ void stage_rc(int b, int& R, int& C) { const int st = b / 1024, sb = b % 1024, swz = sb ^ (((sb >> 9) & 1) << 5); R = (st >> 1) * 16 + swz / 64; C = (st & 1) * 32 + (swz % 64) / 2; }
__host__ __device__ __forceinline__ int perm32(int rho) { const int n = rho >> 4, i = rho & 15; return 8 * (i >> 2) + 4 * n + (i & 3); }

typedef int i32x4 __attribute__((ext_vector_type(4)));
template <bool I8> __device__ __forceinline__ f32x4 pg8_mma(bf16x8 b, bf16x8 a, f32x4 c) {
    if constexpr (I8) return __builtin_bit_cast(f32x4, __builtin_amdgcn_mfma_i32_16x16x64_i8(__builtin_bit_cast(i32x4, b), __builtin_bit_cast(i32x4, a), __builtin_bit_cast(i32x4, c), 0, 0, 0));
    else return __builtin_amdgcn_mfma_f32_16x16x32_bf16(b, a, c, 0, 0, 0);
}
struct Unit { int pm, pn; };
struct Gemm { const bf16_t* A; const bf16_t* Bt; int M, N, K; };

struct StaticOrder {
    int nM, nN, nwg, G, c, wgm;
    __host__ __device__ void init(int M, int N, int G_, int c_, int wgm_ = WGM) { nM = M / BM; nN = N / BM; nwg = nM * nN; G = G_; c = c_; wgm = wgm_; }
    __host__ __device__ bool next(int i, Unit& u) const {
#ifdef PROBE_DUP_A1S
        const long L = (long)(nN == 13 ? (i >> 1) : i) * G + c; if (L >= nwg) return false;
#else
        const long L = (long)i * G + c; if (L >= nwg) return false;
#endif
        int wgid = (int)L; { const int q = nwg / NXCD, r = nwg % NXCD, xcd = wgid % NXCD, off = wgid / NXCD; wgid = (xcd < r ? xcd * (q + 1) : r * (q + 1) + (xcd - r) * q) + off; }
        const int nig = wgm * nN, gid = wgid / nig, fm = gid * wgm, gsz = (nM - fm) < wgm ? (nM - fm) : wgm;
        u.pm = fm + ((wgid % nig) % gsz); u.pn = (wgid % nig) / gsz; return true;
    }
    __device__ __forceinline__ void a_ready(const Unit&) const {}
    __device__ __forceinline__ void done(const Unit&) const {}
};

__device__ __forceinline__ unsigned cvt_pk_bf16(float lo, float hi) { unsigned r; asm volatile("v_cvt_pk_bf16_f32 %0, %1, %2" : "=v"(r) : "v"(lo), "v"(hi)); return r; }
constexpr size_t WSO_Q = 160u << 20, WSO_K = 192u << 20, WSO_DV = 224u << 20, WSO_GQ = 256u << 20, WSO_GO = 272u << 20, WSO_GK = 400u << 20, WSO_GV = 416u << 20, WSO_GLOG = 448u << 20;
__device__ __forceinline__ void store8_bf16(bf16_t* p, f32x4 v0, f32x4 v1) { u32x4 w; w.x = cvt_pk_bf16(v0[0], v0[1]); w.y = cvt_pk_bf16(v0[2], v0[3]); w.z = cvt_pk_bf16(v1[0], v1[1]); w.w = cvt_pk_bf16(v1[2], v1[3]); *(u32x4*)p = w; }
__device__ __forceinline__ u32x4 pack8_bf16(f32x4 v0, f32x4 v1) { u32x4 w; w.x = cvt_pk_bf16(v0[0], v0[1]); w.y = cvt_pk_bf16(v0[2], v0[3]); w.z = cvt_pk_bf16(v1[0], v1[1]); w.w = cvt_pk_bf16(v1[2], v1[3]); return w; }
__device__ __forceinline__ void store_pair_rows(bf16_t* rowp, int ld, u32x4 x0, u32x4 x1, bool odd) {
    const u32x4 snd = odd ? x0 : x1; u32x4 rcv;
    rcv.x = (unsigned)__builtin_amdgcn_update_dpp(0, (int)snd.x, 0xB1, 0xF, 0xF, true); rcv.y = (unsigned)__builtin_amdgcn_update_dpp(0, (int)snd.y, 0xB1, 0xF, 0xF, true);
    rcv.z = (unsigned)__builtin_amdgcn_update_dpp(0, (int)snd.z, 0xB1, 0xF, 0xF, true); rcv.w = (unsigned)__builtin_amdgcn_update_dpp(0, (int)snd.w, 0xB1, 0xF, 0xF, true);
    bf16_t* pa = odd ? rowp - ld + 32 : rowp; bf16_t* pb = odd ? rowp + 32 : rowp + ld;
    __builtin_nontemporal_store(odd ? rcv : x0, (u32x4*)pa); __builtin_nontemporal_store(odd ? x1 : rcv, (u32x4*)pb);
}
__device__ __forceinline__ float log_sigmoid_f(float x) { return fminf(x, 0.f) - __logf(1.f + __expf(-fabsf(x))); }
struct EpiPlain {
    static constexpr bool PERM = true, AFTER_DRAIN = false, IDEMPOTENT = true, I8 = false;
    bf16_t* O; int ldc;
    __device__ __forceinline__ void operator()(const f32x4 (&acc)[2][2][4][2], const Unit& u, int wr, int wc, int fr, int fq) const {
        const int row0 = u.pm * BM + wr * 64 + fr, col0 = u.pn * BM + wc * 32 + 8 * fq;
#pragma unroll
        for (int ai = 0; ai < 2; ++ai)
#pragma unroll
            for (int m = 0; m < 4; ++m) { bf16_t* rowp = O + (size_t)(row0 + ai * HALF + m * 16) * ldc + col0;
#pragma unroll
                for (int bj = 0; bj < 2; ++bj) store8_bf16(rowp + bj * HALF, acc[ai][bj][m][0], acc[ai][bj][m][1]); }
    }
};
__host__ __device__ __forceinline__ int inproj_phys_row(int n) { const int cl = n & 255; return (n & ~255) + 128 * ((cl >> 5) & 1) + 32 * (cl >> 6) + (cl & 31); }
struct EpiInProj {
    static constexpr bool PERM = true, AFTER_DRAIN = false, IDEMPOTENT = true, I8 = true;
    unsigned char* ws; const float* gate_b; const float* qn_w; const float* kn_w; float qscale;
    const float* arow; const float* wcol;
#ifdef PROBE_DUP_EPI8
    bool nostore = false;
    __device__ __forceinline__ void store8_bf16(bf16_t* p, f32x4 v0, f32x4 v1) const { if (!nostore) pg8::store8_bf16(p, v0, v1); else asm volatile("" :: "v"(v0[0] + v0[1] + v0[2] + v0[3] + v1[0] + v1[1] + v1[2] + v1[3])); }
#endif
    __device__ __forceinline__ static f32x4 cvt(const f32x4& a) { const i32x4 i = __builtin_bit_cast(i32x4, a); return (f32x4){(float)i[0], (float)i[1], (float)i[2], (float)i[3]}; }
    __device__ __forceinline__ void operator()(const f32x4 (&acc)[2][2][4][2], const Unit& u, int wr, int wc, int fr, int fq) const {
        const int pn = u.pn, row0 = u.pm * BM + wr * 64 + fr, cl = wc * 64 + 8 * fq;
        f32x4 cs[2][2];
#pragma unroll
        for (int bj = 0; bj < 2; ++bj)
#pragma unroll
            for (int n = 0; n < 2; ++n) cs[bj][n] = *(const f32x4*)(wcol + pn * 256 + cl + 32 * bj + 4 * n);
        float rrv[2][4];
#pragma unroll
        for (int ai = 0; ai < 2; ++ai)
#pragma unroll
            for (int m = 0; m < 4; ++m) rrv[ai][m] = arow[row0 + ai * HALF + m * 16];
        asm volatile("" : "+v"(rrv[0][0]), "+v"(rrv[0][1]), "+v"(rrv[0][2]), "+v"(rrv[0][3]), "+v"(rrv[1][0]), "+v"(rrv[1][1]), "+v"(rrv[1][2]), "+v"(rrv[1][3]));
        if (pn == 12) {
            f32x4 bv[2][2];
#pragma unroll
            for (int bj = 0; bj < 2; ++bj)
#pragma unroll
                for (int n = 0; n < 2; ++n) bv[bj][n] = *(const f32x4*)(gate_b + cl + 32 * bj + 4 * n);
#pragma unroll
            for (int ai = 0; ai < 2; ++ai)
#pragma unroll
                for (int m = 0; m < 4; ++m) { const int row = row0 + ai * HALF + m * 16; float* rowp = (float*)(ws + WSO_GLOG) + (size_t)row * 256 + cl; const float rr = rrv[ai][m];
#pragma unroll
                    for (int bj = 0; bj < 2; ++bj)
#pragma unroll
                        for (int n = 0; n < 2; ++n) { const f32x4 v = cvt(acc[ai][bj][m][n]) * (cs[bj][n] * rr) + bv[bj][n]; f32x4 o;
                            o[0] = log_sigmoid_f(v[0]) * 0.0625f; o[1] = log_sigmoid_f(v[1]) * 0.0625f; o[2] = log_sigmoid_f(v[2]) * 0.0625f; o[3] = log_sigmoid_f(v[3]) * 0.0625f;
#ifdef PROBE_DUP_EPI8
                            if (nostore) asm volatile("" :: "v"(o[0] + o[1] + o[2] + o[3])); else
#endif
                            *(f32x4*)(rowp + 32 * bj + 4 * n) = o; } }
            return;
        }
        if (pn < 4) {
            const bool isk = pn >= 2; const float* nw = isk ? kn_w : qn_w; const float sc = isk ? 1.f : qscale;
            f32x4 wv[2][2];
#pragma unroll
            for (int bj = 0; bj < 2; ++bj)
#pragma unroll
                for (int n = 0; n < 2; ++n) wv[bj][n] = *(const f32x4*)(nw + 8 * fq + 32 * bj + 4 * n) * sc;
            bf16_t* base = (bf16_t*)(ws + (isk ? WSO_K : WSO_Q)); const int c0 = (pn & 1) * 256;
#pragma unroll
            for (int ai = 0; ai < 2; ++ai)
#pragma unroll
                for (int m = 0; m < 4; ++m) { const int row = row0 + ai * HALF + m * 16; const float rr = rrv[ai][m];
                    f32x4 x[2][2]; float ss = 0.f;
#pragma unroll
                    for (int bj = 0; bj < 2; ++bj)
#pragma unroll
                        for (int n = 0; n < 2; ++n) { x[bj][n] = cvt(acc[ai][bj][m][n]) * (cs[bj][n] * rr); ss += (x[bj][n][0] * x[bj][n][0] + x[bj][n][1] * x[bj][n][1]) + (x[bj][n][2] * x[bj][n][2] + x[bj][n][3] * x[bj][n][3]); }
                    ss = xsum32(xsum16(ss));
                    const float rs = __builtin_amdgcn_rsqf(ss * (1.f / 64.f) + 1e-6f);
                    bf16_t* rowp = base + (size_t)row * 512 + c0 + cl;
                    store_pair_rows(rowp, 512, pack8_bf16(x[0][0] * rs * wv[0][0], x[0][1] * rs * wv[0][1]), pack8_bf16(x[1][0] * rs * wv[1][0], x[1][1] * rs * wv[1][1]), fr & 1);
                }
            return;
        }
        size_t bo; int ldc, c0;
        if (pn < 6) { bo = WSO_DV; ldc = 512; c0 = (pn - 4) * 256; }
        else if (pn == 6) { bo = WSO_GQ; ldc = 256; c0 = 0; }
        else if (pn == 7) { bo = WSO_GK; ldc = 256; c0 = 0; }
        else if (pn < 10) { bo = WSO_GV; ldc = 512; c0 = (pn - 8) * 256; }
        else { bo = WSO_GO; ldc = 512; c0 = (pn - 10) * 256; }
        bf16_t* base = (bf16_t*)(ws + bo);
#pragma unroll
        for (int ai = 0; ai < 2; ++ai)
#pragma unroll
            for (int m = 0; m < 4; ++m) { const int row = row0 + ai * HALF + m * 16; bf16_t* rowp = base + (size_t)row * ldc + c0 + cl; const float rr = rrv[ai][m];
                store_pair_rows(rowp, ldc, pack8_bf16(cvt(acc[ai][0][m][0]) * (cs[0][0] * rr), cvt(acc[ai][0][m][1]) * (cs[0][1] * rr)), pack8_bf16(cvt(acc[ai][1][m][0]) * (cs[1][0] * rr), cvt(acc[ai][1][m][1]) * (cs[1][1] * rr)), fr & 1); }
    }
};
template <bool FIRST> struct EpiResid {
    static constexpr bool PERM = true, AFTER_DRAIN = false, IDEMPOTENT = FIRST, I8 = true;
    const float* x; bf16_t* res; const float* arow; const float* wcol;
    __device__ __forceinline__ static f32x4 cvt(const f32x4& a) { const i32x4 i = __builtin_bit_cast(i32x4, a); return (f32x4){(float)i[0], (float)i[1], (float)i[2], (float)i[3]}; }
    __device__ __forceinline__ void operator()(const f32x4 (&acc)[2][2][4][2], const Unit& u, int wr, int wc, int fr, int fq) const {
        const int row0 = u.pm * BM + wr * 64 + fr, col0 = u.pn * BM + wc * 32 + 8 * fq;
        f32x4 cs[2][2];
#pragma unroll
        for (int bj = 0; bj < 2; ++bj)
#pragma unroll
            for (int n = 0; n < 2; ++n) cs[bj][n] = *(const f32x4*)(wcol + col0 + bj * HALF + 4 * n);
        float rrv[2][4];
#pragma unroll
        for (int ai = 0; ai < 2; ++ai)
#pragma unroll
            for (int m = 0; m < 4; ++m) rrv[ai][m] = arow[row0 + ai * HALF + m * 16];
        asm volatile("" : "+v"(rrv[0][0]), "+v"(rrv[0][1]), "+v"(rrv[0][2]), "+v"(rrv[0][3]), "+v"(rrv[1][0]), "+v"(rrv[1][1]), "+v"(rrv[1][2]), "+v"(rrv[1][3]));
#pragma unroll
        for (int ai = 0; ai < 2; ++ai)
#pragma unroll
            for (int m = 0; m < 4; ++m) { const int row = row0 + ai * HALF + m * 16; const size_t off = (size_t)row * 1024 + col0; const float rr = rrv[ai][m];
#pragma unroll
                for (int bj = 0; bj < 2; ++bj) { f32x4 r0, r1;
                    if (FIRST) { r0 = *(const f32x4*)(x + off + bj * HALF); r1 = *(const f32x4*)(x + off + bj * HALF + 4); }
                    else { const u32x4 w = *(const u32x4*)(res + off + bj * HALF);
                        r0 = (f32x4){__builtin_bit_cast(float, w.x << 16), __builtin_bit_cast(float, w.x & 0xffff0000u), __builtin_bit_cast(float, w.y << 16), __builtin_bit_cast(float, w.y & 0xffff0000u)};
                        r1 = (f32x4){__builtin_bit_cast(float, w.z << 16), __builtin_bit_cast(float, w.z & 0xffff0000u), __builtin_bit_cast(float, w.w << 16), __builtin_bit_cast(float, w.w & 0xffff0000u)}; }
                    r0 = r0 + cvt(acc[ai][bj][m][0]) * (cs[bj][0] * rr); r1 = r1 + cvt(acc[ai][bj][m][1]) * (cs[bj][1] * rr);
                    store8_bf16(res + off + bj * HALF, r0, r1); }
            }
    }
};
struct EpiRowScale {
    static constexpr bool PERM = true, AFTER_DRAIN = false, IDEMPOTENT = true, I8 = true;
    bf16_t* O; int ldc; const float* arow; const float* wcol;
    __device__ __forceinline__ static f32x4 cvt(const f32x4& a) { const i32x4 i = __builtin_bit_cast(i32x4, a); return (f32x4){(float)i[0], (float)i[1], (float)i[2], (float)i[3]}; }
    __device__ __forceinline__ void operator()(const f32x4 (&acc)[2][2][4][2], const Unit& u, int wr, int wc, int fr, int fq) const {
        const int row0 = u.pm * BM + wr * 64 + fr, col0 = u.pn * BM + wc * 32 + 8 * fq;
        f32x4 cs[2][2];
#pragma unroll
        for (int bj = 0; bj < 2; ++bj)
#pragma unroll
            for (int n = 0; n < 2; ++n) cs[bj][n] = *(const f32x4*)(wcol + col0 + bj * HALF + 4 * n);
        float rrv[2][4];
#pragma unroll
        for (int ai = 0; ai < 2; ++ai)
#pragma unroll
            for (int m = 0; m < 4; ++m) rrv[ai][m] = arow[row0 + ai * HALF + m * 16];
        asm volatile("" : "+v"(rrv[0][0]), "+v"(rrv[0][1]), "+v"(rrv[0][2]), "+v"(rrv[0][3]), "+v"(rrv[1][0]), "+v"(rrv[1][1]), "+v"(rrv[1][2]), "+v"(rrv[1][3]));
#pragma unroll
        for (int ai = 0; ai < 2; ++ai)
#pragma unroll
            for (int m = 0; m < 4; ++m) { const int row = row0 + ai * HALF + m * 16; const float rr = rrv[ai][m];
                bf16_t* rowp = O + (size_t)row * ldc + col0;
#pragma unroll
                for (int bj = 0; bj < 2; ++bj) __builtin_nontemporal_store(pack8_bf16(cvt(acc[ai][bj][m][0]) * (cs[bj][0] * rr), cvt(acc[ai][bj][m][1]) * (cs[bj][1] * rr)), (u32x4*)(rowp + bj * HALF)); }
    }
};
template <class Epi, class Sched, bool ALIGN_EPI = false, bool SP2 = false>
__device__ __forceinline__ void gemm_phase(PG8_LAS unsigned char* lds, const Gemm g, const Sched& S, const Epi& E) {
    const int tid = threadIdx.x, wid = __builtin_amdgcn_readfirstlane(tid >> 6), lane = tid & 63, wr = wid >> 2, wc = wid & 3, fr = lane & 15, fq = lane >> 4;
    const int K = g.K, nt = K / BK;
    unsigned voffA[2], voffB[2];
#pragma unroll
    for (int i = 0; i < 2; ++i) { int R, C; stage_rc(tid * 16 + i * 8192, R, C); const int Rb = Epi::PERM ? ((R & ~31) + perm32(R & 31)) : R;
        voffA[i] = (unsigned)(R * K + C) * 2u; voffB[i] = (unsigned)(Rb * K + C) * 2u; }
    const size_t kstep = (size_t)(BK * 2);
    const size_t hstep = (size_t)HALF * K * 2;
    const size_t tstep = 2 * hstep;
    const unsigned ldsw = (unsigned)wid * 1024u;
    const int aoff = lds_byte(wr * 64 + fr, fq * 8), boff = lds_byte(wc * 32 + fr, fq * 8);
#define PG8_SA(b, h) (((b) * 2 + (h)) * HTB)
#define PG8_SB(b, h) ((4 + (b) * 2 + (h)) * HTB)
#define PG8_STAGE(bufoff, gbase, voff) do { _Pragma("unroll") for (int _i = 0; _i < 2; ++_i) \
        __builtin_amdgcn_global_load_lds((const unsigned*)((const char*)(gbase) + (voff)[_i]), (PG8_LAS unsigned*)(lds + (bufoff) + ldsw + _i * 8192), 16, 0, 0); } while (0)
#define PG8_LDA(dst, b, h) do { _Pragma("unroll") for (int m = 0; m < 4; ++m) _Pragma("unroll") for (int k = 0; k < 2; ++k) dst[m][k] = *(const PG8_LAS bf16x8*)(lds + PG8_SA(b, h) + aoff + m * 2048 + k * 1024); } while (0)
#define PG8_LDB(dst, b, h) do { _Pragma("unroll") for (int n = 0; n < 2; ++n) _Pragma("unroll") for (int k = 0; k < 2; ++k) dst[n][k] = *(const PG8_LAS bf16x8*)(lds + PG8_SB(b, h) + boff + n * 2048 + k * 1024); } while (0)
#define PG8_MMA(ai, bj, At, Bt) do { __builtin_amdgcn_s_setprio(1); _Pragma("unroll") for (int k = 0; k < 2; ++k) _Pragma("unroll") for (int m = 0; m < 4; ++m) _Pragma("unroll") for (int n = 0; n < 2; ++n)   \
        acc[ai][bj][m][n] = pg8_mma<Epi::I8>(Bt[n][k], At[m][k], acc[ai][bj][m][n]); __builtin_amdgcn_s_setprio(0); } while (0)
#define PG8_WAIT_V(n) asm volatile("s_waitcnt vmcnt(" #n ")" ::: "memory")
#define PG8_WAIT_L(n) asm volatile("s_waitcnt lgkmcnt(" #n ")" ::: "memory")
#define PG8_BAR __builtin_amdgcn_s_barrier()
#define PG8_SCHED __builtin_amdgcn_sched_barrier(0)
    Unit cur, nxt; int ui = 0;
    if (!S.next(0, cur)) return;
    f32x4 acc[2][2][4][2];
#pragma unroll
    for (int a = 0; a < 2; ++a)
#pragma unroll
        for (int b = 0; b < 2; ++b)
#pragma unroll
            for (int m = 0; m < 4; ++m)
#pragma unroll
                for (int n = 0; n < 2; ++n) acc[a][b][m][n] = (f32x4){0.f, 0.f, 0.f, 0.f};
    bf16x8 At[4][2], B0[2][2], B1[2][2];
    const char* cA = (const char*)g.A + (size_t)cur.pm * tstep; const char* cB = (const char*)g.Bt + (size_t)cur.pn * tstep;
    S.a_ready(cur);
    if constexpr (SP2) {
        PG8_STAGE(PG8_SB(0, 0), cB, voffB); PG8_STAGE(PG8_SB(0, 1), cB + hstep, voffB); PG8_STAGE(PG8_SA(0, 0), cA, voffA); PG8_STAGE(PG8_SA(0, 1), cA + hstep, voffA);
        if (wr == 1) PG8_BAR;
        PG8_WAIT_V(2); PG8_BAR;
        PG8_STAGE(PG8_SB(1, 0), cB + kstep, voffB); PG8_STAGE(PG8_SA(1, 0), cA + kstep, voffA); PG8_STAGE(PG8_SB(1, 1), cB + hstep + kstep, voffB);
        PG8_WAIT_V(6); PG8_BAR;
    } else {
        PG8_STAGE(PG8_SB(0, 0), cB, voffB); PG8_STAGE(PG8_SA(0, 0), cA, voffA); PG8_STAGE(PG8_SB(0, 1), cB + hstep, voffB); PG8_STAGE(PG8_SA(0, 1), cA + hstep, voffA);
        if (wr == 1) PG8_BAR;
        PG8_WAIT_V(4); PG8_BAR;
        PG8_STAGE(PG8_SB(1, 0), cB + kstep, voffB); PG8_STAGE(PG8_SA(1, 0), cA + kstep, voffA); PG8_STAGE(PG8_SB(1, 1), cB + hstep + kstep, voffB);
        PG8_WAIT_V(6); PG8_BAR;
    }
    for (;;) {
        const bool has_next = S.next(ui + 1, nxt);
        const char* nA = has_next ? (const char*)g.A + (size_t)nxt.pm * tstep : cA; const char* nB = has_next ? (const char*)g.Bt + (size_t)nxt.pn * tstep : cB;
        for (int t = 0; t < nt; t += 2) {
            const bool last = (t == nt - 2);
            const char* a1 = cA + (size_t)(t + 1) * kstep;
            const char* a2 = last ? nA : cA + (size_t)(t + 2) * kstep; const char* b2 = last ? nB : cB + (size_t)(t + 2) * kstep;
            const char* a3 = a2 + kstep; const char* b3 = b2 + kstep;
            if (last && has_next) S.a_ready(nxt);
            if constexpr (SP2) {
            PG8_LDB(B0, 0, 0); PG8_LDB(B1, 0, 1); PG8_SCHED; PG8_LDA(At, 0, 0); PG8_STAGE(PG8_SA(1, 1), a1 + hstep, voffA);
            PG8_WAIT_V(8); PG8_WAIT_L(0); PG8_BAR; PG8_MMA(0, 0, At, B0); PG8_MMA(0, 1, At, B1); PG8_BAR; PG8_SCHED;
            PG8_LDA(At, 0, 1); PG8_STAGE(PG8_SB(0, 0), b2, voffB); PG8_STAGE(PG8_SB(0, 1), b2 + hstep, voffB); PG8_STAGE(PG8_SA(0, 0), a2, voffA);
            PG8_WAIT_V(8); PG8_WAIT_L(0); PG8_BAR; PG8_MMA(1, 0, At, B0); PG8_MMA(1, 1, At, B1); PG8_BAR; PG8_SCHED;
            PG8_LDB(B0, 1, 0); PG8_LDB(B1, 1, 1); PG8_SCHED; PG8_LDA(At, 1, 0); PG8_STAGE(PG8_SA(0, 1), a2 + hstep, voffA);
            PG8_WAIT_V(8); PG8_WAIT_L(0); PG8_BAR; PG8_MMA(0, 0, At, B0); PG8_MMA(0, 1, At, B1); PG8_BAR; PG8_SCHED;
            PG8_LDA(At, 1, 1); PG8_STAGE(PG8_SB(1, 0), b3, voffB); PG8_STAGE(PG8_SB(1, 1), b3 + hstep, voffB); PG8_STAGE(PG8_SA(1, 0), a3, voffA);
            PG8_WAIT_V(8); PG8_WAIT_L(0); PG8_BAR; PG8_MMA(1, 0, At, B0); PG8_MMA(1, 1, At, B1); PG8_BAR; PG8_SCHED;
            } else {
            PG8_LDB(B0, 0, 0); PG8_SCHED; PG8_LDA(At, 0, 0); PG8_STAGE(PG8_SA(1, 1), a1 + hstep, voffA);
            PG8_WAIT_L(8); PG8_BAR; PG8_WAIT_L(0); PG8_MMA(0, 0, At, B0); PG8_BAR; PG8_SCHED;
            PG8_LDB(B1, 0, 1); PG8_STAGE(PG8_SB(0, 0), b2, voffB);
            PG8_BAR; PG8_WAIT_L(0); PG8_MMA(0, 1, At, B1); PG8_BAR;
            PG8_LDA(At, 0, 1); PG8_STAGE(PG8_SA(0, 0), a2, voffA);
            PG8_BAR; PG8_WAIT_L(0); PG8_MMA(1, 0, At, B0); PG8_BAR; PG8_SCHED;
            PG8_STAGE(PG8_SB(0, 1), b2 + hstep, voffB);
            PG8_WAIT_V(6); PG8_BAR; PG8_MMA(1, 1, At, B1); PG8_BAR;
            PG8_LDB(B0, 1, 0); PG8_SCHED; PG8_LDA(At, 1, 0); PG8_STAGE(PG8_SA(0, 1), a2 + hstep, voffA);
            PG8_WAIT_L(8); PG8_BAR; PG8_WAIT_L(0); PG8_MMA(0, 0, At, B0); PG8_BAR; PG8_SCHED;
            PG8_LDB(B1, 1, 1); PG8_STAGE(PG8_SB(1, 0), b3, voffB);
            PG8_BAR; PG8_WAIT_L(0); PG8_MMA(0, 1, At, B1); PG8_BAR;
            PG8_LDA(At, 1, 1); PG8_STAGE(PG8_SA(1, 0), a3, voffA);
            PG8_BAR; PG8_WAIT_L(0); PG8_MMA(1, 0, At, B0); PG8_BAR; PG8_SCHED;
            PG8_STAGE(PG8_SB(1, 1), b3 + hstep, voffB);
            PG8_WAIT_V(6); PG8_BAR; PG8_MMA(1, 1, At, B1); PG8_BAR;
            }
        }
        if constexpr (ALIGN_EPI) { if (wr == 0) PG8_BAR; }
        if constexpr (!Epi::AFTER_DRAIN) { E(acc, cur, wr, wc, fr, fq);
#ifdef PROBE_DUP_EPI
            if constexpr (Epi::IDEMPOTENT) { asm volatile("" ::: "memory"); E(acc, cur, wr, wc, fr, fq); }
#endif
#ifdef PROBE_DUP_EPI8
            if constexpr (Epi::IDEMPOTENT && Epi::I8) { asm volatile("" ::: "memory"); Epi E2 = E;
#ifdef PROBE_NOSTORE
                E2.nostore = true;
#endif
                E2(acc, cur, wr, wc, fr, fq); }
#endif
            S.done(cur); }
        if (!has_next) break;
#pragma unroll
        for (int a = 0; a < 2; ++a)
#pragma unroll
            for (int b = 0; b < 2; ++b)
#pragma unroll
                for (int m = 0; m < 4; ++m)
#pragma unroll
                    for (int n = 0; n < 2; ++n) acc[a][b][m][n] = (f32x4){0.f, 0.f, 0.f, 0.f};
        cur = nxt; cA = nA; cB = nB; ++ui;
        if constexpr (ALIGN_EPI) { if (wr == 1) PG8_BAR; }
    }
    PG8_WAIT_V(0);
    if constexpr (!ALIGN_EPI) { if (wr == 0) PG8_BAR; }
    PG8_BAR;
    if constexpr (Epi::AFTER_DRAIN) { E.fused(acc, cur, wr, wc, fr, fq, lds, wid, lane); S.done(cur); }
#undef PG8_SA
#undef PG8_SB
#undef PG8_STAGE
#undef PG8_LDA
#undef PG8_LDB
#undef PG8_MMA
#undef PG8_WAIT_V
#undef PG8_WAIT_L
#undef PG8_BAR
#undef PG8_SCHED
}
}

#include <hip/hip_bf16.h>
#include <cmath>
namespace attn_body {
using bf16=__hip_bfloat16;
using bf16x8=__attribute__((ext_vector_type(8)))short;
using s16x4=__attribute__((ext_vector_type(4)))short;
using f32x16=__attribute__((ext_vector_type(16)))float;
using u32x4=__attribute__((ext_vector_type(4)))unsigned;
constexpr int BATCH=4,NHEAD=16,SEQ=8192,D=64,DM=NHEAD*D;
constexpr int QP=512,KP=512,VP=512,OP=1024;
constexpr int NW=8,QBLK=32,QB=QBLK*NW,KVBLK=64,NQB=SEQ/QB;
constexpr int ATTN_PITCH=DM, ATTN_UNIT_ROWS=QB;
__device__ __forceinline__ int crow(int r,int hi){return (r&3)+8*(r>>2)+4*hi;}
#define SBAR() __builtin_amdgcn_sched_barrier(0)
__device__ __forceinline__ void cmask(f32x16&p0,f32x16&p1,int jb,int qrel,int hi){
  const float NEG=-INFINITY; int kb=64*jb+4*hi;
  #pragma unroll
  for(int r=0;r<16;++r){int kv=kb+(r&3)+8*(r>>2); if(kv>qrel)p0[r]=NEG; if(kv+32>qrel)p1[r]=NEG;}
}

constexpr int NSLOT=3, SLOTB=8192;
constexpr int LDS_K=0, LDS_V=NSLOT*SLOTB, LDS_WS=2*NSLOT*SLOTB, LDS_OST=LDS_WS+NW*64*4, LDS_BYTES=LDS_OST+NW*4096;
constexpr float C2=0.125f*1.4426950408889634f;
__device__ __forceinline__ void glds16(const void*gsrc,unsigned lds_dst){unsigned keep;
  asm volatile("s_mov_b32 %0, m0\n\ts_mov_b32 m0, %2\n\ts_nop 0\n\tglobal_load_lds_dwordx4 %1, off\n\ts_mov_b32 m0, %0":"=&s"(keep):"v"(gsrc),"s"(lds_dst):"memory");}
__device__ __forceinline__ float max3f(float a,float b,float c){float r;asm("v_max3_f32 %0, %1, %2, %3":"=v"(r):"v"(a),"v"(b),"v"(c));return r;}
__device__ __forceinline__ float max2f(float a,float b){float r;asm("v_max_f32_e32 %0, %1, %2":"=v"(r):"v"(a),"v"(b));return r;}
__device__ __forceinline__ float fadd_s(float a,float b){float r;asm("v_add_f32_e32 %0, %1, %2":"=v"(r):"v"(a),"v"(b));return r;}
__device__ __forceinline__ float fsub_s(float a,float b){float r;asm("v_sub_f32_e32 %0, %1, %2":"=v"(r):"v"(a),"v"(b));return r;}
typedef float f32x2_t __attribute__((ext_vector_type(2))); typedef __bf16 bf16x2_t __attribute__((ext_vector_type(2)));
__device__ __forceinline__ unsigned cvtpk_s(float lo,float hi){f32x2_t v={lo,hi};bf16x2_t b=__builtin_convertvector(v,bf16x2_t);return __builtin_bit_cast(unsigned,b);}
#define WAIT_BAR(N) asm volatile("s_waitcnt vmcnt(" #N ") lgkmcnt(0)\n\ts_barrier":::"memory")

__device__ __forceinline__ void qkt(f32x16&p0,f32x16&p1,const char*Kslot,const bf16x8*qr,const f32x16&negm,int r32,int hi){
  const char*kb=Kslot+hi*1024+r32*16;
  #pragma unroll
  for(int d0=0;d0<4;++d0){
    const bf16x8 b0=*reinterpret_cast<const bf16x8*>(kb+d0*2048);
    const bf16x8 b1=*reinterpret_cast<const bf16x8*>(kb+d0*2048+512);
    if(d0==0){p0=__builtin_amdgcn_mfma_f32_32x32x16_bf16(b0,qr[0],negm,0,0,0);p1=__builtin_amdgcn_mfma_f32_32x32x16_bf16(b1,qr[0],negm,0,0,0);}
    else{p0=__builtin_amdgcn_mfma_f32_32x32x16_bf16(b0,qr[d0],p0,0,0,0);p1=__builtin_amdgcn_mfma_f32_32x32x16_bf16(b1,qr[d0],p1,0,0,0);}}
}
typedef __attribute__((address_space(3))) const char* lds_cptr;
typedef short v4i16_t __attribute__((ext_vector_type(4)));
__device__ __forceinline__ void kload8(bf16x8*kf,lds_cptr kp){
  kf[0]=*(const __attribute__((address_space(3))) bf16x8*)(kp);      kf[1]=*(const __attribute__((address_space(3))) bf16x8*)(kp+512);
  kf[2]=*(const __attribute__((address_space(3))) bf16x8*)(kp+2048); kf[3]=*(const __attribute__((address_space(3))) bf16x8*)(kp+2560);
  kf[4]=*(const __attribute__((address_space(3))) bf16x8*)(kp+4096); kf[5]=*(const __attribute__((address_space(3))) bf16x8*)(kp+4608);
  kf[6]=*(const __attribute__((address_space(3))) bf16x8*)(kp+6144); kf[7]=*(const __attribute__((address_space(3))) bf16x8*)(kp+6656);
}
__device__ __forceinline__ void kload2(bf16x8*kf,lds_cptr kp,int j){ kf[2*j]=*(const __attribute__((address_space(3))) bf16x8*)(kp+j*2048); kf[2*j+1]=*(const __attribute__((address_space(3))) bf16x8*)(kp+j*2048+512); }
__device__ __forceinline__ s16x4 vtr(lds_cptr p){ return __builtin_bit_cast(s16x4,__builtin_amdgcn_ds_read_tr16_b64_v4i16((__attribute__((address_space(3))) v4i16_t*)p)); }
__device__ __forceinline__ float rowmax(const f32x16&p0,const f32x16&p1){
  float a=max3f(p0[0],p0[1],p1[0]),b=max3f(p0[2],p0[3],p1[1]);a=max3f(a,p1[2],p1[3]);
  #pragma unroll
  for(int r=4;r<16;r+=4){a=max3f(a,p0[r],p0[r+1]);b=max3f(b,p0[r+2],p0[r+3]);a=max3f(a,p1[r],p1[r+1]);b=max3f(b,p1[r+2],p1[r+3]);}
  const float m=max2f(a,b);
  auto rr=__builtin_amdgcn_permlane32_swap(__float_as_uint(m),__float_as_uint(m),false,false);
  return max2f(__uint_as_float(rr[0]),__uint_as_float(rr[1]));
}
__device__ __forceinline__ void pv(f32x16*o,int vb,bf16x8 pa0,bf16x8 pa1,bf16x8 pa2,bf16x8 pa3){
  #pragma unroll
  for(int d0=0;d0<2;++d0){s16x4 lo[4],hi[4];
    #pragma unroll
    for(int ks=0;ks<4;++ks){
      asm volatile("ds_read_b64_tr_b16 %0,%1 offset:%c2":"=&v"(lo[ks]):"v"(vb),"i"(d0*4096+ks*1024):"memory");
      asm volatile("ds_read_b64_tr_b16 %0,%1 offset:%c2":"=&v"(hi[ks]):"v"(vb),"i"(d0*4096+ks*1024+512):"memory");}
    asm volatile("s_waitcnt lgkmcnt(0)":::"memory");SBAR();
    #define PK(k) (bf16x8){lo[k][0],lo[k][1],lo[k][2],lo[k][3],hi[k][0],hi[k][1],hi[k][2],hi[k][3]}
    o[d0]=__builtin_amdgcn_mfma_f32_32x32x16_bf16(pa0,PK(0),o[d0],0,0,0);
    o[d0]=__builtin_amdgcn_mfma_f32_32x32x16_bf16(pa1,PK(1),o[d0],0,0,0);
    o[d0]=__builtin_amdgcn_mfma_f32_32x32x16_bf16(pa2,PK(2),o[d0],0,0,0);
    o[d0]=__builtin_amdgcn_mfma_f32_32x32x16_bf16(pa3,PK(3),o[d0],0,0,0);
    #undef PK
  }
}

#ifndef ATTN_STORE16
#define ATTN_STORE16(p,v) (*(u32x4*)(p)=(v))
#endif
template<int THRL> __device__ __forceinline__ void attn_unit(int b,int h,int qb,const bf16*Q,const bf16*__restrict__ K,const bf16*__restrict__ V,bf16*O,char*shm){
  const int tid=threadIdx.x,lane=tid&63,r32=lane&31,hi=lane>>5; const int wid=__builtin_amdgcn_readfirstlane(tid>>6);
  const long rowbase=(long)b*SEQ; const int q0=qb*QB;
  const bf16*Qw=Q+(rowbase+q0+wid*QBLK)*QP+(h>>1)*D;
  const bf16*Kh=K+rowbase*KP+(h>>1)*D,*Vh=V+rowbase*VP+(h>>2)*128+(h&1)*D;
  const unsigned lds0=(unsigned)(uintptr_t)shm;
  float*wsf=(float*)(shm+LDS_WS)+wid*64;
  const bf16*ksrc=Kh+(long)lane*KP+wid*8;
  const bf16*vsrc=Vh+(long)(16*(wid&3)+(lane>>2))*VP+(wid>>2)*32+(lane&3)*8;
  const unsigned kdst=lds0+LDS_K+wid*1024, vdst=lds0+LDS_V+wid*1024;
  #define DMA_K(t,slot) glds16(ksrc+(long)(t)*KVBLK*KP,(unsigned)__builtin_amdgcn_readfirstlane(kdst+(slot)))
  #define DMA_V(t,slot) glds16(vsrc+(long)(t)*KVBLK*VP,(unsigned)__builtin_amdgcn_readfirstlane(vdst+(slot)))
  const int vb0=(int)(lds0+LDS_V)+((lane>>4)&1)*32+(lane&3)*8+(4*hi+((lane&15)>>2))*64;
  const char*Kbase=shm+LDS_K; bf16x8 kf[8];
  const lds_cptr shm3=(lds_cptr)shm; const lds_cptr kp0=shm3+LDS_K+hi*1024+r32*16; const lds_cptr vp0=shm3+LDS_V+((lane>>4)&1)*32+(lane&3)*8+(4*hi+((lane&15)>>2))*64;
  const int NT=(q0+QB)/KVBLK;
  DMA_K(0,0);DMA_V(0,0);DMA_K(1,SLOTB);
  bf16x8 qr[4];
  #pragma unroll
  for(int d0=0;d0<4;++d0)qr[d0]=*reinterpret_cast<const bf16x8*>(&Qw[(long)r32*QP+d0*16+hi*8]);
  float mhat=0.f,l_reg=0.f;f32x16 o[2];o[0]=f32x16{};o[1]=f32x16{};f32x16 negm=f32x16{};asm volatile("":"+v"(negm));
  const int qrel=wid*QBLK+r32;
  #define CMASK(P0,P1,t) do{int jb_=(t)-(NT-4); if(jb_>=0)cmask(P0,P1,jb_,qrel,hi);}while(0)
  bool resc=false;
  #define START(P0,P1) do{ const float rm=rowmax(P0,P1); resc=false; \
    { const float dl=rm; mhat=fadd_s(mhat,dl); \
      _Pragma("unroll") for(int r=0;r<16;++r){P0[r]=fsub_s(P0[r],dl);P1[r]=fsub_s(P1[r],dl);} \
      _Pragma("unroll") for(int r=0;r<16;++r)negm[r]=-mhat; asm volatile("":"+v"(negm)); } \
    _Pragma("unroll") for(int r=0;r<16;++r)P0[r]=__builtin_amdgcn_exp2f(P0[r]); }while(0)
  #define RESC() do{ if(resc){ asm volatile("s_waitcnt lgkmcnt(0)":::"memory"); \
      _Pragma("unroll") for(int d_=0;d_<2;++d_) _Pragma("unroll") for(int r=0;r<16;++r)o[d_][r]*=wsf[crow(r,hi)]; } }while(0)
  f32x16 pA0,pA1,pB0,pB1;
  int sl_prev=0,sl_cur=0,sl_next=SLOTB;
  #define ROT() do{sl_prev=sl_cur;sl_cur=sl_next;sl_next=(sl_next==(NSLOT-1)*SLOTB)?0:sl_next+SLOTB;}while(0)
  DMA_K(2,2*SLOTB);
  WAIT_BAR(3);
  qkt(pA0,pA1,Kbase,qr,negm,r32,hi);asm volatile("s_nop 15\n\ts_nop 7":"+v"(pA0),"+v"(pA1));CMASK(pA0,pA1,0);
  START(pA0,pA1);
  _Pragma("unroll") for(int r=0;r<16;++r)pA1[r]=__builtin_amdgcn_exp2f(pA1[r]);
  WAIT_BAR(0);
  DMA_K(3,0);DMA_V(1,SLOTB);
  ROT();
  kload8(kf,kp0+sl_cur);
  WAIT_BAR(2);
  s16x4 vlo[8],vhi[8]; u32x4 pw0,pw1,pw2,pw3;
  #define PKW(P,B) cvtpk_s(P[B],P[B+1])
  #define PAF(k) __builtin_bit_cast(bf16x8,pw##k)
  #define VFR(i) (bf16x8){vlo[i][0],vlo[i][1],vlo[i][2],vlo[i][3],vhi[i][0],vhi[i][1],vhi[i][2],vhi[i][3]}
  #define PIN(x) asm volatile("":"+v"(x))
  #define MX3(a,b,c) __builtin_fmaxf(__builtin_fmaxf((a),(b)),(c))
  #define GAPA(MF,A0,A1,A2,A3,W0,W1,PW) do{ MF; sacc+=A0; sacc+=A1; sacc+=A2; sacc+=A3; PIN(sacc); W0; W1; PIN(PW); SBAR(); }while(0)
  #define EX(v) __builtin_amdgcn_exp2f(v)
  #define GAPB(MF,X,B) do{ MF; X[B]=EX(X[B]); X[B+1]=EX(X[B+1]); X[B+2]=EX(X[B+2]); X[B+3]=EX(X[B+3]); PIN(X); SBAR(); }while(0)
  #define VRD(i) do{ vlo[i]=vtr(vp_+(((i)>>2)*4096+((i)&3)*1024)); vhi[i]=vtr(vp_+(((i)>>2)*4096+((i)&3)*1024+512)); }while(0)
  #define KRD(G,j) do{ if(G){ kload2(kf,kp0+sl_next,j); SBAR(); } }while(0)
  #define STEP(C0,C1,P0,P1,t,GK,GV,GL) do{ SBAR(); \
    const lds_cptr vp_=vp0+sl_prev; \
    VRD(0); SBAR(); float sacc=(P0[0]+P0[1]); \
    GAPA(C0=__builtin_amdgcn_mfma_f32_32x32x16_bf16(kf[0],qr[0],negm,0,0,0), P0[2],P0[3],P0[4],P0[5],     pw0[0]=PKW(P0,0), pw0[1]=PKW(P0,2), pw0); \
    VRD(4); SBAR(); GAPA(C1=__builtin_amdgcn_mfma_f32_32x32x16_bf16(kf[1],qr[0],negm,0,0,0), P0[6],P0[7],P0[8],P0[9],     pw0[2]=PKW(P0,4), pw0[3]=PKW(P0,6), pw0); \
    VRD(1); SBAR(); GAPA(C0=__builtin_amdgcn_mfma_f32_32x32x16_bf16(kf[2],qr[1],C0,0,0,0),   P0[10],P0[11],P0[12],P0[13], pw1[0]=PKW(P0,8), pw1[1]=PKW(P0,10), pw1); \
    VRD(5); SBAR(); GAPA(C1=__builtin_amdgcn_mfma_f32_32x32x16_bf16(kf[3],qr[1],C1,0,0,0),   P0[14],P0[15],P1[0],P1[1],   pw1[2]=PKW(P0,12),pw1[3]=PKW(P0,14), pw1); \
    VRD(2); SBAR(); GAPA(C0=__builtin_amdgcn_mfma_f32_32x32x16_bf16(kf[4],qr[2],C0,0,0,0),   P1[2],P1[3],P1[4],P1[5],     pw2[0]=PKW(P1,0), pw2[1]=PKW(P1,2), pw2); \
    VRD(6); SBAR(); GAPA(C1=__builtin_amdgcn_mfma_f32_32x32x16_bf16(kf[5],qr[2],C1,0,0,0),   P1[6],P1[7],P1[8],P1[9],     pw2[2]=PKW(P1,4), pw2[3]=PKW(P1,6), pw2); \
    VRD(3); SBAR(); GAPA(C0=__builtin_amdgcn_mfma_f32_32x32x16_bf16(kf[6],qr[3],C0,0,0,0),   P1[10],P1[11],P1[12],P1[13], pw3[0]=PKW(P1,8), pw3[1]=PKW(P1,10), pw3); \
    VRD(7); SBAR(); GAPA(C1=__builtin_amdgcn_mfma_f32_32x32x16_bf16(kf[7],qr[3],C1,0,0,0),   P1[14],P1[15],0.f,0.f,       pw3[2]=PKW(P1,12),pw3[3]=PKW(P1,14), pw3); \
    l_reg+=sacc; \
    if(GK){DMA_K((t)+3,sl_cur);} if(GV){DMA_V((t)+1,sl_next);} \
    CMASK(C0,C1,t); \
    { float a=MX3(C0[0],C0[1],C1[0]),b=MX3(C0[2],C0[3],C1[1]); a=MX3(a,C1[2],C1[3]); \
      _Pragma("unroll") for(int r=4;r<16;r+=4){a=MX3(a,C0[r],C0[r+1]);b=MX3(b,C0[r+2],C0[r+3]);a=MX3(a,C1[r],C1[r+1]);b=MX3(b,C1[r+2],C1[r+3]);} \
      float rm=__builtin_fmaxf(a,b); { auto rr=__builtin_amdgcn_permlane32_swap(__float_as_uint(rm),__float_as_uint(rm),false,false); rm=__builtin_fmaxf(__uint_as_float(rr[0]),__uint_as_float(rr[1])); } \
      resc=false; \
      if(__builtin_expect(__any(rm>(float)THRL),0)){ const float dl=__builtin_fmaxf(rm,0.f); mhat+=dl; \
        _Pragma("unroll") for(int r=0;r<16;++r){C0[r]-=dl;C1[r]-=dl;} \
        _Pragma("unroll") for(int r=0;r<16;++r)negm[r]=-mhat; asm volatile("":"+v"(negm)); \
        const float f=__builtin_amdgcn_exp2f(-dl); l_reg*=f; if(hi==0)wsf[r32]=f; resc=true; } } \
    SBAR(); \
    GAPB(o[0]=__builtin_amdgcn_mfma_f32_32x32x16_bf16(PAF(0),VFR(0),o[0],0,0,0), C0,0); \
    GAPB(o[1]=__builtin_amdgcn_mfma_f32_32x32x16_bf16(PAF(0),VFR(4),o[1],0,0,0), C0,4); \
    KRD(GL,0); GAPB(o[0]=__builtin_amdgcn_mfma_f32_32x32x16_bf16(PAF(1),VFR(1),o[0],0,0,0), C0,8); \
    KRD(GL,1); GAPB(o[1]=__builtin_amdgcn_mfma_f32_32x32x16_bf16(PAF(1),VFR(5),o[1],0,0,0), C0,12); \
    KRD(GL,2); GAPB(o[0]=__builtin_amdgcn_mfma_f32_32x32x16_bf16(PAF(2),VFR(2),o[0],0,0,0), C1,0); \
    KRD(GL,3); GAPB(o[1]=__builtin_amdgcn_mfma_f32_32x32x16_bf16(PAF(2),VFR(6),o[1],0,0,0), C1,4); \
    GAPB(o[0]=__builtin_amdgcn_mfma_f32_32x32x16_bf16(PAF(3),VFR(3),o[0],0,0,0), C1,8); \
    GAPB(o[1]=__builtin_amdgcn_mfma_f32_32x32x16_bf16(PAF(3),VFR(7),o[1],0,0,0), C1,12); \
    }while(0)
  int t=1;
  #undef CMASK
  #define CMASK(P0,P1,t) do{}while(0)
  for(;t+5<NT;t+=2){
    STEP(pB0,pB1,pA0,pA1,t,true,true,true);     WAIT_BAR(2); RESC(); ROT();
    STEP(pA0,pA1,pB0,pB1,t+1,true,true,true);   WAIT_BAR(2); RESC(); ROT();
  }
  #undef CMASK
  #define CMASK(P0,P1,t) do{int jb_=(t)-(NT-4); if(jb_>=0)cmask(P0,P1,jb_,qrel,hi);}while(0)
  #define ENDW(tt) do{ if((tt)+3<NT){WAIT_BAR(2);} else if((tt)+2<NT){WAIT_BAR(1);} else {WAIT_BAR(0);} }while(0)
  for(;t+1<NT;t+=2){
    STEP(pB0,pB1,pA0,pA1,t,(t+3<NT),(t+1<NT),(t+1<NT));       ENDW(t);   RESC(); ROT();
    STEP(pA0,pA1,pB0,pB1,t+1,(t+4<NT),(t+2<NT),(t+2<NT));     ENDW(t+1); RESC(); ROT();
  }
  STEP(pB0,pB1,pA0,pA1,NT-1,false,false,false); RESC();
  { float sacc=pB0[0]+pB0[1]; _Pragma("unroll") for(int r=2;r<16;++r)sacc+=pB0[r]; _Pragma("unroll") for(int r=0;r<16;++r)sacc+=pB1[r]; l_reg+=sacc;
    pw0=(u32x4){PKW(pB0,0),PKW(pB0,2),PKW(pB0,4),PKW(pB0,6)};pw1=(u32x4){PKW(pB0,8),PKW(pB0,10),PKW(pB0,12),PKW(pB0,14)};pw2=(u32x4){PKW(pB1,0),PKW(pB1,2),PKW(pB1,4),PKW(pB1,6)};pw3=(u32x4){PKW(pB1,8),PKW(pB1,10),PKW(pB1,12),PKW(pB1,14)};
    SBAR(); pv(o,vb0+sl_cur,PAF(0),PAF(1),PAF(2),PAF(3)); }
  #undef PKW
  #undef PAF
  #undef VFR
  #undef PIN
  #undef MX3
  #undef GAPA
  #undef GAPB
  #undef EX
  #undef VRD
  #undef KRD
  #undef STEP
  #undef ENDW
  {auto rr=__builtin_amdgcn_permlane32_swap(__float_as_uint(l_reg),__float_as_uint(l_reg),false,false);l_reg=__uint_as_float(rr[0])+__uint_as_float(rr[1]);}
  if(hi==0)wsf[32+r32]=l_reg;asm volatile("s_waitcnt lgkmcnt(0)":::"memory");
  float rli[16];
  #pragma unroll
  for(int r=0;r<16;++r)rli[r]=__builtin_amdgcn_rcpf(wsf[32+crow(r,hi)]);
  bf16*Ow=O+(rowbase+q0+wid*QBLK)*OP+h*D;
  { bf16*stg=(bf16*)(shm+LDS_OST)+wid*2048;
    #pragma unroll
    for(int r=0;r<16;++r){const int orow=crow(r,hi);
      #pragma unroll
      for(int d0=0;d0<2;++d0)stg[orow*64+d0*32+r32]=__float2bfloat16(o[d0][r]*rli[r]);}
    asm volatile("s_waitcnt lgkmcnt(0)":::"memory");
    #pragma unroll
    for(int i=0;i<4;++i){const int row=i*8+(lane>>3),ch=lane&7; const u32x4 v=*(const u32x4*)(stg+row*64+ch*8); ATTN_STORE16(Ow+(long)row*OP+ch*8,v);} }
  asm volatile("s_waitcnt lgkmcnt(0)\n\ts_barrier":::"memory");
  #undef DMA_K
  #undef DMA_V
  #undef CMASK
  #undef START
  #undef RESC
  #undef ROT
}
constexpr int SLOTK=8192, SLOTV=16384;
constexpr int L2_K=0, L2_V=NSLOT*SLOTK, L2_WS=L2_V+NSLOT*SLOTV, L2_OST=L2_WS+NW*64*4, L2_BYTES=L2_OST+NW*4096;
__device__ __forceinline__ void pv128(f32x16*o,int vb,bf16x8 pa0,bf16x8 pa1,bf16x8 pa2,bf16x8 pa3){
  #pragma unroll
  for(int d0=0;d0<4;++d0){s16x4 lo[4],hi[4];
    #pragma unroll
    for(int ks=0;ks<4;++ks){
      asm volatile("ds_read_b64_tr_b16 %0,%1 offset:%c2":"=&v"(lo[ks]):"v"(vb),"i"(d0*4096+ks*1024):"memory");
      asm volatile("ds_read_b64_tr_b16 %0,%1 offset:%c2":"=&v"(hi[ks]):"v"(vb),"i"(d0*4096+ks*1024+512):"memory");}
    asm volatile("s_waitcnt lgkmcnt(0)":::"memory");SBAR();
    #define PK(k) (bf16x8){lo[k][0],lo[k][1],lo[k][2],lo[k][3],hi[k][0],hi[k][1],hi[k][2],hi[k][3]}
    o[d0]=__builtin_amdgcn_mfma_f32_32x32x16_bf16(pa0,PK(0),o[d0],0,0,0);
    o[d0]=__builtin_amdgcn_mfma_f32_32x32x16_bf16(pa1,PK(1),o[d0],0,0,0);
    o[d0]=__builtin_amdgcn_mfma_f32_32x32x16_bf16(pa2,PK(2),o[d0],0,0,0);
    o[d0]=__builtin_amdgcn_mfma_f32_32x32x16_bf16(pa3,PK(3),o[d0],0,0,0);
    #undef PK
  }
}
__device__ __forceinline__ void attn_unit128(int b,int hm,int qb,const bf16*Q,const bf16*__restrict__ K,const bf16*__restrict__ V,bf16*O,char*shm){
  const int tid=threadIdx.x,lane=tid&63,r32=lane&31,hi=lane>>5; const int wid=__builtin_amdgcn_readfirstlane(tid>>6);
  const long rowbase=(long)b*SEQ; const int q0=qb*QB;
  const bf16*Qw=Q+(rowbase+q0+wid*QBLK)*QP+hm*D;
  const bf16*Kh=K+rowbase*KP+hm*D,*Vh=V+rowbase*VP+(hm>>1)*128;
  const unsigned lds0=(unsigned)(uintptr_t)shm;
  float*wsf=(float*)(shm+L2_WS)+wid*64;
  const bf16*ksrc=Kh+(long)lane*KP+wid*8;
  const bf16*vsrc=Vh+(long)(16*(wid&3)+(lane>>2))*VP+(wid>>2)*32+(lane&3)*8;
  const unsigned kdst=lds0+L2_K+wid*1024, vdst=lds0+L2_V+(wid>>2)*4096+(wid&3)*1024;
  #define DMA_K(t,slot) glds16(ksrc+(long)(t)*KVBLK*KP,(unsigned)__builtin_amdgcn_readfirstlane(kdst+(slot)))
  #define DMA_V(t,slot) do{ glds16(vsrc+(long)(t)*KVBLK*VP,(unsigned)__builtin_amdgcn_readfirstlane(vdst+2*(slot))); glds16(vsrc+(long)(t)*KVBLK*VP+64,(unsigned)__builtin_amdgcn_readfirstlane(vdst+2*(slot)+8192)); }while(0)
  const int vb0=(int)(lds0+L2_V)+((lane>>4)&1)*32+(lane&3)*8+(4*hi+((lane&15)>>2))*64;
  const char*Kbase=shm+L2_K; bf16x8 kf[8];
  const lds_cptr shm3=(lds_cptr)shm; const lds_cptr kp0=shm3+L2_K+hi*1024+r32*16; const lds_cptr vp0=shm3+L2_V+((lane>>4)&1)*32+(lane&3)*8+(4*hi+((lane&15)>>2))*64;
  const int NT=(q0+QB)/KVBLK;
  DMA_K(0,0);DMA_V(0,0);DMA_K(1,SLOTK);
  bf16x8 qr[4];
  #pragma unroll
  for(int d0=0;d0<4;++d0)qr[d0]=*reinterpret_cast<const bf16x8*>(&Qw[(long)r32*QP+d0*16+hi*8]);
  float l_reg=0.f;f32x16 o[4];o[0]=f32x16{};o[1]=f32x16{};o[2]=f32x16{};o[3]=f32x16{};
  const f32x16 zero=f32x16{};
  const int qrel=wid*QBLK+r32;
  #define CMASK(P0,P1,t) do{int jb_=(t)-(NT-4); if(jb_>=0)cmask(P0,P1,jb_,qrel,hi);}while(0)
  f32x16 pA0,pA1,pB0,pB1;
  int sl_prev=0,sl_cur=0,sl_next=SLOTK;
  #define ROT() do{sl_prev=sl_cur;sl_cur=sl_next;sl_next=(sl_next==(NSLOT-1)*SLOTK)?0:sl_next+SLOTK;}while(0)
  DMA_K(2,2*SLOTK);
  WAIT_BAR(4);
  qkt(pA0,pA1,Kbase,qr,zero,r32,hi);asm volatile("s_nop 15\n\ts_nop 7":"+v"(pA0),"+v"(pA1));CMASK(pA0,pA1,0);
  _Pragma("unroll") for(int r=0;r<16;++r){pA0[r]=__builtin_amdgcn_exp2f(pA0[r]);pA1[r]=__builtin_amdgcn_exp2f(pA1[r]);}
  WAIT_BAR(0);
  DMA_K(3,0);DMA_V(1,SLOTK);
  ROT();
  kload8(kf,kp0+sl_cur);
  WAIT_BAR(3);
  s16x4 vlo[4],vhi[4]; u32x4 pw0,pw1,pw2,pw3;
  #define PKW(P,B) cvtpk_s(P[B],P[B+1])
  #define PAF(k) __builtin_bit_cast(bf16x8,pw##k)
  #define VFR(i) (bf16x8){vlo[i][0],vlo[i][1],vlo[i][2],vlo[i][3],vhi[i][0],vhi[i][1],vhi[i][2],vhi[i][3]}
  #define PIN(x) asm volatile("":"+v"(x))
  #define GAPA(MF,A0,A1,A2,A3,W0,W1,PW) do{ MF; sacc+=A0; sacc+=A1; sacc+=A2; sacc+=A3; PIN(sacc); W0; W1; PIN(PW); SBAR(); }while(0)
  #define EX(v) __builtin_amdgcn_exp2f(v)
  #define DB(j) ((((j)&1))+2*((j)>>3))
  #define KS(j) (((j)>>1)&3)
  #define VRDJ(j) do{ vlo[(j)&3]=vtr(vp_+(DB(j)*4096+KS(j)*1024)); vhi[(j)&3]=vtr(vp_+(DB(j)*4096+KS(j)*1024+512)); SBAR(); }while(0)
  #define GAPB2(j,PF,X,B) do{ o[DB(j)]=__builtin_amdgcn_mfma_f32_32x32x16_bf16(PF,VFR((j)&3),o[DB(j)],0,0,0); X[B]=EX(X[B]); X[B+1]=EX(X[B+1]); PIN(X); SBAR(); }while(0)
  #define KRD(G,j) do{ if(G){ kload2(kf,kp0+sl_next,j); SBAR(); } }while(0)
  #define MF32(a,b,c) __builtin_amdgcn_mfma_f32_32x32x16_bf16(a,b,c,0,0,0)
  #define STEP(C0,C1,P0,P1,t,GK,GV,GL) do{ SBAR(); \
    const lds_cptr vp_=vp0+2*sl_prev; \
    float sacc=(P0[0]+P0[1]); \
    GAPA(C0=MF32(kf[0],qr[0],zero), P0[2],P0[3],P0[4],P0[5],     pw0[0]=PKW(P0,0), pw0[1]=PKW(P0,2), pw0); \
    GAPA(C1=MF32(kf[1],qr[0],zero), P0[6],P0[7],P0[8],P0[9],     pw0[2]=PKW(P0,4), pw0[3]=PKW(P0,6), pw0); \
    GAPA(C0=MF32(kf[2],qr[1],C0),   P0[10],P0[11],P0[12],P0[13], pw1[0]=PKW(P0,8), pw1[1]=PKW(P0,10), pw1); \
    GAPA(C1=MF32(kf[3],qr[1],C1),   P0[14],P0[15],P1[0],P1[1],   pw1[2]=PKW(P0,12),pw1[3]=PKW(P0,14), pw1); \
    GAPA(C0=MF32(kf[4],qr[2],C0),   P1[2],P1[3],P1[4],P1[5],     pw2[0]=PKW(P1,0), pw2[1]=PKW(P1,2), pw2); \
    VRDJ(0); GAPA(C1=MF32(kf[5],qr[2],C1),   P1[6],P1[7],P1[8],P1[9],     pw2[2]=PKW(P1,4), pw2[3]=PKW(P1,6), pw2); \
    VRDJ(1); GAPA(C0=MF32(kf[6],qr[3],C0),   P1[10],P1[11],P1[12],P1[13], pw3[0]=PKW(P1,8), pw3[1]=PKW(P1,10), pw3); \
    VRDJ(2); GAPA(C1=MF32(kf[7],qr[3],C1),   P1[14],P1[15],0.f,0.f,       pw3[2]=PKW(P1,12),pw3[3]=PKW(P1,14), pw3); \
    l_reg+=sacc; \
    if(GK){DMA_K((t)+3,sl_cur);} if(GV){DMA_V((t)+1,sl_next);} \
    CMASK(C0,C1,t); \
    SBAR(); \
    GAPB2(0,PAF(0),C0,0);  VRDJ(3); \
    GAPB2(1,PAF(0),C0,2);  VRDJ(4); \
    KRD(GL,0); GAPB2(2,PAF(1),C0,4);  VRDJ(5); \
    KRD(GL,1); GAPB2(3,PAF(1),C0,6);  VRDJ(6); \
    KRD(GL,2); GAPB2(4,PAF(2),C0,8);  VRDJ(7); \
    KRD(GL,3); GAPB2(5,PAF(2),C0,10); VRDJ(8); \
    GAPB2(6,PAF(3),C0,12); VRDJ(9); \
    GAPB2(7,PAF(3),C0,14); VRDJ(10); \
    GAPB2(8,PAF(0),C1,0);  VRDJ(11); \
    GAPB2(9,PAF(0),C1,2);  VRDJ(12); \
    GAPB2(10,PAF(1),C1,4); VRDJ(13); \
    GAPB2(11,PAF(1),C1,6); VRDJ(14); \
    GAPB2(12,PAF(2),C1,8); VRDJ(15); \
    GAPB2(13,PAF(2),C1,10); \
    GAPB2(14,PAF(3),C1,12); \
    GAPB2(15,PAF(3),C1,14); \
    }while(0)
  int t=1;
  #undef CMASK
  #define CMASK(P0,P1,t) do{}while(0)
  for(;t+5<NT;t+=2){
    STEP(pB0,pB1,pA0,pA1,t,true,true,true);     WAIT_BAR(3); ROT();
    STEP(pA0,pA1,pB0,pB1,t+1,true,true,true);   WAIT_BAR(3); ROT();
  }
  #undef CMASK
  #define CMASK(P0,P1,t) do{int jb_=(t)-(NT-4); if(jb_>=0)cmask(P0,P1,jb_,qrel,hi);}while(0)
  #define ENDW(tt) do{ if((tt)+3<NT){WAIT_BAR(3);} else if((tt)+2<NT){WAIT_BAR(2);} else {WAIT_BAR(0);} }while(0)
  for(;t+1<NT;t+=2){
    STEP(pB0,pB1,pA0,pA1,t,(t+3<NT),(t+1<NT),(t+1<NT));       ENDW(t);   ROT();
    STEP(pA0,pA1,pB0,pB1,t+1,(t+4<NT),(t+2<NT),(t+2<NT));     ENDW(t+1); ROT();
  }
  STEP(pB0,pB1,pA0,pA1,NT-1,false,false,false);
  { float sacc=pB0[0]+pB0[1]; _Pragma("unroll") for(int r=2;r<16;++r)sacc+=pB0[r]; _Pragma("unroll") for(int r=0;r<16;++r)sacc+=pB1[r]; l_reg+=sacc;
    pw0=(u32x4){PKW(pB0,0),PKW(pB0,2),PKW(pB0,4),PKW(pB0,6)};pw1=(u32x4){PKW(pB0,8),PKW(pB0,10),PKW(pB0,12),PKW(pB0,14)};pw2=(u32x4){PKW(pB1,0),PKW(pB1,2),PKW(pB1,4),PKW(pB1,6)};pw3=(u32x4){PKW(pB1,8),PKW(pB1,10),PKW(pB1,12),PKW(pB1,14)};
    SBAR(); pv128(o,vb0+2*sl_cur,PAF(0),PAF(1),PAF(2),PAF(3)); }
  #undef PKW
  #undef PAF
  #undef VFR
  #undef PIN
  #undef GAPA
  #undef GAPB2
  #undef EX
  #undef VRDJ
  #undef DB
  #undef KS
  #undef KRD
  #undef MF32
  #undef STEP
  #undef ENDW
  {auto rr=__builtin_amdgcn_permlane32_swap(__float_as_uint(l_reg),__float_as_uint(l_reg),false,false);l_reg=__uint_as_float(rr[0])+__uint_as_float(rr[1]);}
  if(hi==0)wsf[32+r32]=l_reg;asm volatile("s_waitcnt lgkmcnt(0)":::"memory");
  float rli[16];
  #pragma unroll
  for(int r=0;r<16;++r)rli[r]=__builtin_amdgcn_rcpf(wsf[32+crow(r,hi)]);
  bf16*Ow=O+(rowbase+q0+wid*QBLK)*OP+hm*128;
  { bf16*stg=(bf16*)(shm+L2_OST)+wid*2048;
    #pragma unroll
    for(int dh=0;dh<2;++dh){
      #pragma unroll
      for(int r=0;r<16;++r){const int orow=crow(r,hi);
        #pragma unroll
        for(int d0=0;d0<2;++d0)stg[orow*64+d0*32+r32]=__float2bfloat16(o[2*dh+d0][r]*rli[r]);}
      asm volatile("s_waitcnt lgkmcnt(0)":::"memory");
      #pragma unroll
      for(int i=0;i<4;++i){const int row=i*8+(lane>>3),ch=lane&7; const u32x4 v=*(const u32x4*)(stg+row*64+ch*8); ATTN_STORE16(Ow+(long)row*OP+dh*64+ch*8,v);}
      asm volatile("s_waitcnt lgkmcnt(0)":::"memory"); } }
  asm volatile("s_waitcnt lgkmcnt(0)\n\ts_barrier":::"memory");
  #undef DMA_K
  #undef DMA_V
  #undef CMASK
  #undef ROT
}
struct AttnUnit128 { int bh; int qb; };
struct StaticOrder128 {
  int vcu;
  __device__ __forceinline__ explicit StaticOrder128(int grid,int block):vcu((block%8)*(grid/8)+block/8){}
#ifdef PROBE_DUP_ATTN2
  __device__ __forceinline__ bool next(int ii,AttnUnit128&u)const{ if(ii>=8)return false; const int i=ii>>1; const int s=vcu&7; u.bh=vcu>>3; u.qb=(i==0)?s:(i==1)?15-s:(i==2)?16+s:31-s; return true; }
#else
  __device__ __forceinline__ bool next(int i,AttnUnit128&u)const{ if(i>=4)return false; const int s=vcu&7; u.bh=vcu>>3; u.qb=(i==0)?s:(i==1)?15-s:(i==2)?16+s:31-s; return true; }
#endif
};
__device__ __forceinline__ void attn_phase128(char*lds,const bf16*Q,const bf16*K,const bf16*V,bf16*O,const StaticOrder128&S){
  AttnUnit128 u;
  for(int i=0;S.next(i,u);++i) attn_unit128(u.bh>>3,u.bh&7,u.qb,Q,K,V,O,lds);
}
constexpr int ATTN_LDS_BYTES=LDS_BYTES;
struct AttnTensors { const bf16* Q; const bf16* K; const bf16* V; bf16* O; };
struct AttnUnit { int bh; int qb; };
struct StaticOrder {
  int vcu;
  __device__ __forceinline__ explicit StaticOrder(int grid,int block):vcu((block%8)*(grid/8)+block/8){}
  __device__ __forceinline__ bool next(int i,AttnUnit&u)const{ if(i>=8)return false; const int s=vcu&7,j=i&3; u.bh=2*(vcu>>3)+(i>>2); u.qb=(j==0)?s:(j==1)?15-s:(j==2)?16+s:31-s; return true; }
  __device__ __forceinline__ void a_ready(const AttnUnit&)const{}
  __device__ __forceinline__ void done(const AttnUnit&)const{}
};
template<class Sched,int THRL=8> __device__ __forceinline__ void attn_phase(char*lds,const AttnTensors&T,const Sched&S){
  AttnUnit u;
  for(int i=0;S.next(i,u);++i){ S.a_ready(u); attn_unit<THRL>(u.bh/NHEAD,u.bh%NHEAD,u.qb,T.Q,T.K,T.V,T.O,lds); S.done(u); }
}
#undef SBAR
#undef WAIT_BAR
}

constexpr int NWAVES = 8;
constexpr int BATCH = 4, T = 8192, D = 1024, M = BATCH * T, DEPTH = 2;
constexpr int IN_COLS = 3088, NIN = 3328;
constexpr int NEXP = 16384;
constexpr float RMS_EPS = 1e-6f;
constexpr int NPHASE = 24;
#ifndef MK_PER_PHASE
#define MK_PER_PHASE 0
#endif

constexpr size_t MiB = 1u << 20;
constexpr size_t WS_CTL = 0, CTL_ZERO_BYTES = 1 * MiB;
constexpr size_t WS_WIN = 2 * MiB;
constexpr size_t WS_WOUT = 16 * MiB;
constexpr size_t WS_WQ = 20 * MiB;
constexpr size_t WS_SK = 28 * MiB;
constexpr size_t WS_USC = 30 * MiB, WS_VSC = 30 * MiB + 256 * 1024;
constexpr size_t WS_TU = 32 * MiB, WS_TV = 64 * MiB;
constexpr size_t WS_XN8 = 96 * MiB;
constexpr size_t WS_XN = 96 * MiB;
constexpr size_t WS_Q = 160 * MiB, WS_K = 192 * MiB, WS_DV = 224 * MiB;
constexpr size_t WS_GQ = 256 * MiB;
constexpr size_t WS_GO = 272 * MiB;
constexpr size_t WS_OI = 304 * MiB;
constexpr size_t WS_UT = 336 * MiB;
constexpr size_t WS_GK = 400 * MiB, WS_GV = 416 * MiB, WS_GLOG = 448 * MiB;
constexpr size_t WS_O = 96 * MiB;
constexpr size_t WS_RES = 336 * MiB;
constexpr size_t WS_USUM = 304 * MiB, WS_PDS = 312 * MiB;
constexpr size_t WS_Q2 = 160 * MiB;
constexpr size_t WS_IDX = 288 * MiB, WS_GATE = 304 * MiB;
constexpr size_t WS_EW8 = 320 * MiB, WS_EWSC = 324 * MiB;
constexpr size_t WS_PART = 400 * MiB;
constexpr size_t WS_SSQ = 18 * MiB;
constexpr size_t WS_AS = 29 * MiB;
constexpr size_t WS_WCS = 29 * MiB + 512 * 1024;
constexpr size_t WS_RS = 30 * MiB + 512 * 1024;
constexpr size_t WS_END = 480 * MiB;
static_assert(WS_GLOG + (size_t)M * 256 * 4 <= WS_END && WS_PART + (size_t)8 * M * 128 * 2 <= WS_END, "workspace map");
constexpr size_t WS_WQCS = 29 * MiB + 640 * 1024;
constexpr int CW_BAR = 4096;
constexpr int CW_LBAR = 13312;
constexpr size_t WS_WOCS = 29 * MiB + 576 * 1024;
constexpr size_t OUT_MIX8 = 64 * MiB, OUT_MS = 96 * MiB;
static_assert(pg8::WSO_Q == WS_Q && pg8::WSO_K == WS_K && pg8::WSO_DV == WS_DV && pg8::WSO_GQ == WS_GQ && pg8::WSO_GO == WS_GO && pg8::WSO_GK == WS_GK && pg8::WSO_GV == WS_GV && pg8::WSO_GLOG == WS_GLOG, "epilogue offsets");

constexpr int RING_OFF = 0, RING_BYTES = 131072;
constexpr int LDSCTL_OFF = RING_BYTES, MISC_OFF = LDSCTL_OFF + 320;
constexpr int LDS_BYTES = 147456;

#define GAS __attribute__((address_space(1)))
#define LAS __attribute__((address_space(3)))
typedef unsigned short bf16;
typedef unsigned v4u __attribute__((ext_vector_type(4)));
typedef unsigned v2u __attribute__((ext_vector_type(2)));
typedef float f32x4 __attribute__((ext_vector_type(4)));
typedef float f32x16 __attribute__((ext_vector_type(16)));
typedef short bf16x8 __attribute__((ext_vector_type(8)));
typedef GAS unsigned gu32;
#define RLX_AGENT __ATOMIC_RELAXED, __HIP_MEMORY_SCOPE_AGENT
#define LDS_WAIT() asm volatile("s_waitcnt lgkmcnt(0)" ::: "memory")
__device__ __forceinline__ unsigned f2bf(float f) { unsigned u = __builtin_bit_cast(unsigned, f); return (u + 0x7fffu + ((u >> 16) & 1u)) >> 16; }
__device__ __forceinline__ unsigned pk2(float lo, float hi) { return f2bf(lo) | (f2bf(hi) << 16); }
__device__ __forceinline__ float bf2f(unsigned short h) { return __builtin_bit_cast(float, (unsigned)h << 16); }
__device__ __forceinline__ float bflo(unsigned w) { return __builtin_bit_cast(float, w << 16); }
__device__ __forceinline__ float bfhi(unsigned w) { return __builtin_bit_cast(float, w & 0xffff0000u); }

#define XB_TMO      128
#define XB_XCNT(j)  (256  + 64 * (j))
#define XB_XSUB(j)  (1280 + 64 * (j))
#define XB_XGEN(j)  (2304 + 64 * (j))
#define XB_TOP      3328
#define XB_TOPGEN   3392
#define XCD_BAR_WORDS 3456
#define XB_SPIN_CAP (1u << 18)

__device__ __forceinline__ unsigned xb_ld(unsigned* p)              { return __hip_atomic_load(p, __ATOMIC_RELAXED, __HIP_MEMORY_SCOPE_AGENT); }
__device__ __forceinline__ unsigned xb_add(unsigned* p, unsigned v) { return __hip_atomic_fetch_add(p, v, __ATOMIC_RELAXED, __HIP_MEMORY_SCOPE_AGENT); }
__device__ __forceinline__ unsigned xb_xcc_id() { return (unsigned)__builtin_amdgcn_s_getreg((3 << 11) | 20) & 0xFu; }
#define XB_SPIN(cond, bar) do { unsigned _sp = 0; while (cond) { __builtin_amdgcn_s_sleep(1); \
    if ((++_sp & 255u) == 0u) { if (xb_ld(&(bar)[XB_TMO])) break; if (_sp > XB_SPIN_CAP) { atomicAdd(&(bar)[XB_TMO], 1u); break; } } } } while (0)

struct XcdBarrier {
    unsigned* bar; unsigned x;
    volatile LAS unsigned* st;
};

__device__ __forceinline__ XcdBarrier xcd_barrier_post(unsigned* bar, volatile LAS unsigned* st) {
    XcdBarrier b; b.bar = bar; b.x = xb_xcc_id(); b.st = st;
    if (threadIdx.x == 0) st[2] = xb_add(&bar[XB_XCNT(b.x)], 1u);
    return b;
}
__device__ __forceinline__ void xcd_barrier_complete(unsigned* bar, unsigned x, unsigned& nloc, unsigned& nx) {
    const unsigned G = gridDim.x * gridDim.y * gridDim.z;
    unsigned sum, cnt, mine, sp = 0u;
    for (;;) {
        sum = 0u; cnt = 0u; mine = 0u;
#pragma unroll
        for (unsigned j = 0; j < 16; ++j) { const unsigned c = xb_ld(&bar[XB_XCNT(j)]); sum += c; cnt += (c > 0u) ? 1u : 0u; mine = (j == x) ? c : mine; }
        if (sum == G) break;
        __builtin_amdgcn_s_sleep(1);
        if ((++sp & 255u) == 0u) { if (xb_ld(&bar[XB_TMO])) break; if (sp > XB_SPIN_CAP) { atomicAdd(&bar[XB_TMO], 1u); break; } }
    }
    nloc = mine > 0u ? mine : 1u; nx = cnt > 0u ? cnt : 1u;
}

__device__ __forceinline__ void xcd_barrier(const XcdBarrier& b) {
    asm volatile("s_waitcnt vmcnt(0)" ::: "memory");
    __syncthreads();
    if (threadIdx.x == 0) {
        unsigned* bar = b.bar;
        __builtin_amdgcn_s_waitcnt(0);
        unsigned nloc = b.st[0], nx = b.st[1];
        if (nloc == 0u) { xcd_barrier_complete(bar, b.x, nloc, nx); b.st[0] = nloc; b.st[1] = nx;
            const unsigned G = gridDim.x * gridDim.y * gridDim.z; unsigned okc = (G == 256u) ? 1u : 0u;
#pragma unroll
            for (unsigned j = 0; j < 16; ++j) { const unsigned c = xb_ld(&bar[XB_XCNT(j)]); okc &= (c == (j < 8u ? G / 8u : 0u)) ? 1u : 0u; }
            b.st[3] = okc; }
        const unsigned old = xb_add(&bar[XB_XSUB(b.x)], 1u);
        const unsigned gen = old / nloc;
        if (old + 1u == (gen + 1u) * nloc) {
            __builtin_amdgcn_fence(__ATOMIC_RELEASE, "agent");
            asm volatile("s_waitcnt vmcnt(0)" ::: "memory");
            const unsigned og = xb_add(&bar[XB_TOP], 1u);
            const unsigned tg = og / nx;
            if (og + 1u == (tg + 1u) * nx) xb_add(&bar[XB_TOPGEN], 1u);
            else XB_SPIN(xb_ld(&bar[XB_TOPGEN]) == tg, bar);
            __builtin_amdgcn_fence(__ATOMIC_ACQUIRE, "agent");
            xb_add(&bar[XB_XGEN(b.x)], 1u);
            asm volatile("s_waitcnt vmcnt(0)" ::: "memory");
        } else {
            XB_SPIN(xb_ld(&bar[XB_XGEN(b.x)]) == gen, bar);
            __builtin_amdgcn_fence(__ATOMIC_ACQUIRE, "agent");
            asm volatile("s_waitcnt vmcnt(0)" ::: "memory");
        }
    }
    __syncthreads();
}

__device__ __forceinline__ void xcd_local_barrier(const XcdBarrier& b, unsigned* lbar) {
    asm volatile("s_waitcnt vmcnt(0)" ::: "memory");
    __syncthreads();
    if (threadIdx.x == 0) {
        __builtin_amdgcn_s_waitcnt(0);
        const unsigned nloc = b.st[0], gen = b.st[4]; b.st[4] = gen + 1u;
        unsigned* ctr = &lbar[64 * b.x];
        (void)xb_add(ctr, 1u);
        const unsigned target = (gen + 1u) * nloc;
        XB_SPIN(xb_ld(ctr) < target, b.bar);
        __builtin_amdgcn_fence(__ATOMIC_ACQUIRE, "agent");
        asm volatile("s_waitcnt vmcnt(0)" ::: "memory");
    }
    __syncthreads();
}

struct Args {
    const float* in[19]; float* out; unsigned char* ws; int ph_lo, ph_hi;
};
struct Frame {
    LAS unsigned char* lds;
    int tid, lane, wave, vcu, G, bx, gw, NGW;
};
enum { I_X = 0, I_ANW, I_WIN, I_QNW, I_KNW, I_LQ1, I_LK1, I_LQ2, I_LK2, I_DONW, I_GW2, I_GB, I_GONW, I_WOUT, I_FNW, I_PWQ, I_PSK, I_PU, I_PV };
typedef const __attribute__((address_space(4))) Args* KArgs;
__device__ __forceinline__ KArgs kargs() { KArgs p = (KArgs)__builtin_amdgcn_kernarg_segment_ptr(); asm volatile("" : "+s"(p)); return p; }
__device__ __forceinline__ float row16_sum(float v) {
    v += __builtin_bit_cast(float, __builtin_amdgcn_update_dpp(0, __builtin_bit_cast(int, v), 0xB1, 0xf, 0xf, true)); v += __builtin_bit_cast(float, __builtin_amdgcn_update_dpp(0, __builtin_bit_cast(int, v), 0x4E, 0xf, 0xf, true));
    v += __builtin_bit_cast(float, __builtin_amdgcn_update_dpp(0, __builtin_bit_cast(int, v), 0x141, 0xf, 0xf, true)); v += __builtin_bit_cast(float, __builtin_amdgcn_update_dpp(0, __builtin_bit_cast(int, v), 0x140, 0xf, 0xf, true));
    return v;
}
__device__ __forceinline__ float wave_max_nn(float v) {
    v = fmaxf(v, __builtin_bit_cast(float, __builtin_amdgcn_update_dpp(0, __builtin_bit_cast(int, v), 0xB1, 0xf, 0xf, true))); v = fmaxf(v, __builtin_bit_cast(float, __builtin_amdgcn_update_dpp(0, __builtin_bit_cast(int, v), 0x4E, 0xf, 0xf, true)));
    v = fmaxf(v, __builtin_bit_cast(float, __builtin_amdgcn_update_dpp(0, __builtin_bit_cast(int, v), 0x141, 0xf, 0xf, true))); v = fmaxf(v, __builtin_bit_cast(float, __builtin_amdgcn_update_dpp(0, __builtin_bit_cast(int, v), 0x140, 0xf, 0xf, true)));
    { auto rr = __builtin_amdgcn_permlane16_swap(__float_as_uint(v), __float_as_uint(v), false, false); v = fmaxf(__uint_as_float(rr[0]), __uint_as_float(rr[1])); }
    { auto rr = __builtin_amdgcn_permlane32_swap(__float_as_uint(v), __float_as_uint(v), false, false); v = fmaxf(__uint_as_float(rr[0]), __uint_as_float(rr[1])); }
    return v;
}
__device__ __forceinline__ float wave_sum(float v) { return pg8::xsum32(pg8::xsum16(row16_sum(v))); }
__device__ __forceinline__ void p0_transpose_item(const float* W, int K, int ld, int nblk, bf16* WT, int row_off, LAS float* scr, int item, int lane, const float* kscale = nullptr) {
    const int kb = item / nblk, nb = item % nblk, k0 = 64 * kb, n0 = 32 * nb;
    float tv[32];
#pragma unroll
    for (int i = 0; i < 32; ++i) tv[i] = W[(size_t)(k0 + 2 * i + (lane >> 5)) * ld + n0 + (lane & 31)];
#pragma unroll
    for (int i = 0; i < 32; ++i) scr[(2 * i + (lane >> 5)) * 33 + (lane & 31)] = tv[i];
    LDS_WAIT(); asm volatile("" ::: "memory");
    const int c = lane & 7;
    float ks[8];
#pragma unroll
    for (int i = 0; i < 8; ++i) ks[i] = kscale ? kscale[k0 + 8 * c + i] : 1.f;
#pragma unroll
    for (int j = 0; j < 4; ++j) { const int n = (lane >> 3) + 8 * j; const LAS float* s = scr + (8 * c) * 33 + n;
        v4u o; o.x = pk2(s[0 * 33] * ks[0], s[1 * 33] * ks[1]); o.y = pk2(s[2 * 33] * ks[2], s[3 * 33] * ks[3]); o.z = pk2(s[4 * 33] * ks[4], s[5 * 33] * ks[5]); o.w = pk2(s[6 * 33] * ks[6], s[7 * 33] * ks[7]);
        *(GAS v4u*)(WT + (size_t)(row_off + n0 + n) * K + k0 + 8 * c) = o; }
    LDS_WAIT(); asm volatile("" ::: "memory");
}
__device__ __forceinline__ void rms_row_to_bf16(int lane, const float* xrow, const float* w, bf16* orow) {
    const GAS f32x4* xr = (const GAS f32x4*)xrow + lane; const GAS f32x4* wr = (const GAS f32x4*)w + lane;
    f32x4 v[4]; float s = 0.f;
#pragma unroll
    for (int j = 0; j < 4; ++j) { v[j] = xr[64 * j]; s += (v[j].x * v[j].x + v[j].y * v[j].y) + (v[j].z * v[j].z + v[j].w * v[j].w); }
    const float rs = 1.f / sqrtf(wave_sum(s) * (1.f / 1024.f) + RMS_EPS);
    GAS unsigned long long* o8 = (GAS unsigned long long*)orow + lane;
#pragma unroll
    for (int j = 0; j < 4; ++j) { const f32x4 ww = wr[64 * j]; o8[64 * j] = (unsigned long long)pk2(v[j].x * rs * ww.x, v[j].y * rs * ww.y) | ((unsigned long long)pk2(v[j].z * rs * ww.z, v[j].w * rs * ww.w) << 32); }
}
__device__ __forceinline__ void rms_regs_to_bf16(int lane, const f32x4 (&v)[4], const float* w, bf16* orow) {
    const GAS f32x4* wr = (const GAS f32x4*)w + lane; float s = 0.f;
#pragma unroll
    for (int j = 0; j < 4; ++j) s += (v[j].x * v[j].x + v[j].y * v[j].y) + (v[j].z * v[j].z + v[j].w * v[j].w);
    const float rs = 1.f / sqrtf(wave_sum(s) * (1.f / 1024.f) + RMS_EPS);
    GAS unsigned long long* o8 = (GAS unsigned long long*)orow + lane;
#pragma unroll
    for (int j = 0; j < 4; ++j) { const f32x4 ww = wr[64 * j]; o8[64 * j] = (unsigned long long)pk2(v[j].x * rs * ww.x, v[j].y * rs * ww.y) | ((unsigned long long)pk2(v[j].z * rs * ww.z, v[j].w * rs * ww.w) << 32); }
}
__device__ __forceinline__ void rms_row16_to_bf16(int lane, const bf16* xrow, const float* w, bf16* orow) {
    const v4u a = ((const GAS v4u*)(xrow + 16 * lane))[0], b = ((const GAS v4u*)(xrow + 16 * lane))[1]; const unsigned ww[8] = {a.x, a.y, a.z, a.w, b.x, b.y, b.z, b.w};
    float x[16]; float s = 0.f;
#pragma unroll
    for (int q = 0; q < 8; ++q) { x[2 * q] = bflo(ww[q]); x[2 * q + 1] = bfhi(ww[q]); s += x[2 * q] * x[2 * q] + x[2 * q + 1] * x[2 * q + 1]; }
    const float rs = 1.f / sqrtf(wave_sum(s) * (1.f / 1024.f) + RMS_EPS);
    const float* wp = w + 16 * lane; v4u oa, ob;
    oa.x = pk2(x[0] * rs * wp[0], x[1] * rs * wp[1]); oa.y = pk2(x[2] * rs * wp[2], x[3] * rs * wp[3]); oa.z = pk2(x[4] * rs * wp[4], x[5] * rs * wp[5]); oa.w = pk2(x[6] * rs * wp[6], x[7] * rs * wp[7]);
    ob.x = pk2(x[8] * rs * wp[8], x[9] * rs * wp[9]); ob.y = pk2(x[10] * rs * wp[10], x[11] * rs * wp[11]); ob.z = pk2(x[12] * rs * wp[12], x[13] * rs * wp[13]); ob.w = pk2(x[14] * rs * wp[14], x[15] * rs * wp[15]);
    ((GAS v4u*)(orow + 16 * lane))[0] = oa; ((GAS v4u*)(orow + 16 * lane))[1] = ob;
}
__device__ __forceinline__ void conv_bf16(const float* src, bf16* dst, size_t n8, size_t gtid, size_t nthr) {
    for (size_t i = gtid; i < n8; i += nthr) { const f32x4 a = ((const GAS f32x4*)src)[2 * i], b = ((const GAS f32x4*)src)[2 * i + 1];
        v4u o; o.x = pk2(a.x, a.y); o.y = pk2(a.z, a.w); o.z = pk2(b.x, b.y); o.w = pk2(b.z, b.w); ((GAS v4u*)dst)[i] = o; }
}
template <bool OFFS> __device__ __forceinline__ void quant_row(int lane, const float* src, unsigned char* dst, float* scale_out) {
    const GAS f32x4* p = (const GAS f32x4*)(src + 16 * lane); f32x4 v[4]; float am = 0.f;
#pragma unroll
    for (int j = 0; j < 4; ++j) { v[j] = p[j]; am = fmaxf(fmaxf(am, fmaxf(fabsf(v[j].x), fabsf(v[j].y))), fmaxf(fabsf(v[j].z), fabsf(v[j].w))); }
    am = wave_max_nn(am);
    const float inv = am > 0.f ? 127.f / am : 0.f; const int off = OFFS ? 128 : 0;
    v4u o4; unsigned w[4];
#pragma unroll
    for (int j = 0; j < 4; ++j) { const int b0 = (int)rintf(v[j].x * inv) + off, b1 = (int)rintf(v[j].y * inv) + off, b2 = (int)rintf(v[j].z * inv) + off, b3 = (int)rintf(v[j].w * inv) + off;
        w[j] = (unsigned)(b0 & 0xff) | ((unsigned)(b1 & 0xff) << 8) | ((unsigned)(b2 & 0xff) << 16) | ((unsigned)(b3 & 0xff) << 24); }
    o4.x = w[0]; o4.y = w[1]; o4.z = w[2]; o4.w = w[3];
    *(GAS v4u*)(dst + (size_t)(lane >> 3) * NEXP * 128 + 16 * (lane & 7)) = o4;
    if (lane == 0) *scale_out = am * (1.f / 127.f);
}
__device__ __forceinline__ void quant_row_regs(int lane, const f32x4 (&v)[4], unsigned char* dst, float* scale_out) {
    float am = 0.f;
#pragma unroll
    for (int j = 0; j < 4; ++j) am = fmaxf(fmaxf(am, fmaxf(fabsf(v[j].x), fabsf(v[j].y))), fmaxf(fabsf(v[j].z), fabsf(v[j].w)));
    am = wave_max_nn(am);
    const float inv = am > 0.f ? 127.f / am : 0.f;
    v4u o4; unsigned w[4];
#pragma unroll
    for (int j = 0; j < 4; ++j) { const int b0 = (int)rintf(v[j].x * inv), b1 = (int)rintf(v[j].y * inv), b2 = (int)rintf(v[j].z * inv), b3 = (int)rintf(v[j].w * inv);
        w[j] = (unsigned)(b0 & 0xff) | ((unsigned)(b1 & 0xff) << 8) | ((unsigned)(b2 & 0xff) << 16) | ((unsigned)(b3 & 0xff) << 24); }
    o4.x = w[0]; o4.y = w[1]; o4.z = w[2]; o4.w = w[3];
    *(GAS v4u*)(dst + (size_t)(lane >> 3) * NEXP * 128 + 16 * (lane & 7)) = o4;
    if (lane == 0) *scale_out = am * (1.f / 127.f);
}
__device__ __forceinline__ void quant_tables(KArgs A, int layer, int gw0, int ngw, int lane, int rlo = 0, int rhi = 2 * NEXP) {
    unsigned char* const ws = A->ws;
    f32x4 wfv[4];
#pragma unroll
    for (int j = 0; j < 4; ++j) wfv[j] = ((const GAS f32x4*)(A->in[I_FNW] + layer * D + 16 * lane))[j];
    for (int r0 = rlo + gw0; r0 < rhi; r0 += 2 * ngw) {
        f32x4 va[4], vb[4]; const int r1 = r0 + ngw; const bool has1 = r1 < rhi;
        const int isv0 = r0 >= NEXP, isv1 = r1 >= NEXP; const int row0 = layer * NEXP + (isv0 ? r0 - NEXP : r0), row1 = layer * NEXP + (isv1 ? r1 - NEXP : r1);
        const GAS f32x4* p0 = (const GAS f32x4*)((isv0 ? A->in[I_PV] : A->in[I_PU]) + (size_t)row0 * D + 16 * lane); const GAS f32x4* p1 = (const GAS f32x4*)((isv1 ? A->in[I_PV] : A->in[I_PU]) + (size_t)(has1 ? row1 : row0) * D + 16 * lane);
#pragma unroll
        for (int j = 0; j < 4; ++j) { va[j] = p0[j]; vb[j] = p1[j]; }
        if (!isv0) {
#pragma unroll
            for (int j = 0; j < 4; ++j) va[j] = va[j] * wfv[j]; }
        if (!isv1) {
#pragma unroll
            for (int j = 0; j < 4; ++j) vb[j] = vb[j] * wfv[j]; }
        const size_t sl0 = ((size_t)layer * 8 * NEXP + (row0 & (NEXP - 1))) * 128, sl1 = ((size_t)layer * 8 * NEXP + (row1 & (NEXP - 1))) * 128;
        quant_row_regs(lane, va, ws + (isv0 ? WS_TV : WS_TU) + sl0, (float*)(ws + (isv0 ? WS_VSC : WS_USC)) + row0);
        if (has1) quant_row_regs(lane, vb, ws + (isv1 ? WS_TV : WS_TU) + sl1, (float*)(ws + (isv1 ? WS_VSC : WS_USC)) + row1);
    }
}
__device__ __forceinline__ void row_to_i8(int lane, const f32x4 (&v)[4], const float* w, unsigned char* dst, float* fac, float* rs_out = nullptr) {
    float x[16]; float s = 0.f;
#pragma unroll
    for (int j = 0; j < 4; ++j) { x[4 * j] = v[j].x; x[4 * j + 1] = v[j].y; x[4 * j + 2] = v[j].z; x[4 * j + 3] = v[j].w; }
#pragma unroll
    for (int i = 0; i < 16; ++i) s += x[i] * x[i];
    const float rs = __builtin_amdgcn_rsqf(wave_sum(s) * (1.f / 1024.f) + RMS_EPS);
    float am = 0.f;
#pragma unroll
    for (int i = 0; i < 16; ++i) { if (w) x[i] = x[i] * rs * w[16 * lane + i]; am = fmaxf(am, fabsf(x[i])); }
    am = wave_max_nn(am);
    const float inv = am > 0.f ? 127.f / am : 0.f;
    unsigned q[4];
#pragma unroll
    for (int j = 0; j < 4; ++j) { const int b0 = (int)rintf(x[4 * j] * inv), b1 = (int)rintf(x[4 * j + 1] * inv), b2 = (int)rintf(x[4 * j + 2] * inv), b3 = (int)rintf(x[4 * j + 3] * inv);
        q[j] = (unsigned)(b0 & 0xff) | ((unsigned)(b1 & 0xff) << 8) | ((unsigned)(b2 & 0xff) << 16) | ((unsigned)(b3 & 0xff) << 24); }
    *(GAS v4u*)(dst + 16 * lane) = (v4u){q[0], q[1], q[2], q[3]};
    if (lane == 0) { *fac = am * (1.f / 127.f) * (w ? 1.f : rs); if (rs_out) *rs_out = rs; }
}
constexpr int P0_WBLOCKS = DEPTH * (104 + 32 + 64);
__device__ __forceinline__ void p0_wblock(KArgs A, Frame& F, int item) {
    const int lane = F.lane, w = F.wave, kh = lane >> 5, c = lane & 31;
    const bool isin = item < DEPTH * 104, isq = item >= DEPTH * (104 + 32); const int r = isin ? item : isq ? item - DEPTH * (104 + 32) : item - DEPTH * 104, l = isin ? r / 104 : isq ? r / 64 : r / 32, nb = isin ? r % 104 : isq ? r % 64 : r % 32, n = 32 * nb + c;
    LAS float* scr = (LAS float*)(F.lds + RING_OFF + w * 16384); LAS float* XCH = (LAS float*)(F.lds + RING_OFF + 7 * 16384 + 12288);
    float v[2][32];
    if (isin && nb >= 96) {
        const float* wbase = A->in[I_WIN] + (size_t)l * D * IN_COLS + 3072; const int j = n - 3072; float g2[16];
#pragma unroll
        for (int q = 0; q < 16; ++q) g2[q] = A->in[I_GW2][(size_t)l * 16 * 256 + q * 256 + j];
        { f32x4 t[8];
#pragma unroll
          for (int q = 0; q < 8; ++q) { const int e = q * 64 + lane; t[q] = *(const GAS f32x4*)(wbase + (size_t)(128 * w + (e >> 2)) * IN_COLS + 4 * (e & 3)); }
#pragma unroll
          for (int q = 0; q < 8; ++q) ((LAS f32x4*)scr)[q * 64 + lane] = t[q]; }
        LDS_WAIT(); asm volatile("" ::: "memory");
#pragma unroll
        for (int sb = 0; sb < 2; ++sb)
#pragma unroll
            for (int i = 0; i < 32; ++i) { const LAS f32x4* wr = (const LAS f32x4*)scr + (64 * sb + 2 * i + kh) * 4; float s = 0.f;
#pragma unroll
                for (int q = 0; q < 4; ++q) { const f32x4 w4 = wr[q]; s += w4.x * g2[4 * q] + w4.y * g2[4 * q + 1] + w4.z * g2[4 * q + 2] + w4.w * g2[4 * q + 3]; }
                v[sb][i] = s; if ((i & 3) == 3) __builtin_amdgcn_sched_barrier(0); }
        LDS_WAIT(); asm volatile("" ::: "memory");
    } else {
        const float* src = isin ? A->in[I_WIN] + (size_t)l * D * IN_COLS + n : isq ? A->in[I_PWQ] + (size_t)l * D * 2048 + n : A->in[I_WOUT] + (size_t)l * D * D + n; const size_t ld = isin ? IN_COLS : isq ? 2048 : D;
#pragma unroll
        for (int sb = 0; sb < 2; ++sb)
#pragma unroll
            for (int i = 0; i < 32; ++i) v[sb][i] = src[(size_t)(128 * w + 64 * sb + 2 * i + kh) * ld];
    }
    if ((isin && l > 0) || isq) { const float* an = (isq ? A->in[I_FNW] : A->in[I_ANW]) + l * D + 128 * w + kh;
#pragma unroll
        for (int sb = 0; sb < 2; ++sb)
#pragma unroll
            for (int i = 0; i < 32; ++i) v[sb][i] *= an[64 * sb + 2 * i];
    }
    float am = 0.f;
#pragma unroll
    for (int sb = 0; sb < 2; ++sb)
#pragma unroll
        for (int i = 0; i < 32; ++i) am = fmaxf(am, fabsf(v[sb][i]));
    { auto rr = __builtin_amdgcn_permlane32_swap(__float_as_uint(am), __float_as_uint(am), false, false); am = fmaxf(__uint_as_float(rr[0]), __uint_as_float(rr[1])); }
    if (kh == 0) XCH[w * 32 + c] = am;
    __syncthreads();
    float cm = 0.f;
#pragma unroll
    for (int q = 0; q < 8; ++q) cm = fmaxf(cm, XCH[q * 32 + c]);
    __syncthreads();
    const float inv = cm > 0.f ? 127.f / cm : 0.f;
    if (w == 0 && kh == 0) (isin ? (float*)(A->ws + WS_WCS) + l * NIN : isq ? (float*)(A->ws + WS_WQCS) + l * 2048 : (float*)(A->ws + WS_WOCS) + l * D)[n] = cm * (1.f / 127.f);
    unsigned char* WT = isin ? A->ws + WS_WIN + ((size_t)l * NIN + pg8::inproj_phys_row(32 * nb)) * D : isq ? A->ws + WS_WQ + ((size_t)l * 2048 + 32 * nb) * D : A->ws + WS_WOUT + ((size_t)l * D + 32 * nb) * D;
    LAS int* sq = (LAS int*)scr;
#pragma unroll
    for (int sb = 0; sb < 2; ++sb) {
#pragma unroll
        for (int i = 0; i < 32; ++i) sq[(2 * i + kh) * 33 + c] = (int)rintf(v[sb][i] * inv);
        LDS_WAIT(); asm volatile("" ::: "memory");
        { const int nn = lane >> 1, hf = lane & 1; unsigned q[8];
#pragma unroll
          for (int j = 0; j < 8; ++j) { const LAS int* s = sq + (32 * hf + 4 * j) * 33 + nn; q[j] = (unsigned)(s[0] & 0xff) | ((unsigned)(s[33] & 0xff) << 8) | ((unsigned)(s[66] & 0xff) << 16) | ((unsigned)(s[99] & 0xff) << 24); }
          unsigned char* dst = WT + (size_t)nn * D + 128 * w + 64 * sb + 32 * hf;
          ((GAS v4u*)dst)[0] = (v4u){q[0], q[1], q[2], q[3]}; ((GAS v4u*)dst)[1] = (v4u){q[4], q[5], q[6], q[7]}; }
        LDS_WAIT(); asm volatile("" ::: "memory");
    }
}
__device__ __forceinline__ void p0_prologue(Frame& F) {
    KArgs A = kargs(); unsigned char* const ws = A->ws;
    LAS float* scr = (LAS float*)(F.lds + RING_OFF + F.wave * 16384);
    for (int item = F.bx; item < P0_WBLOCKS; item += F.G) p0_wblock(A, F, item);
    const size_t gtid = (size_t)F.gw * 64 + F.lane, nthr = (size_t)F.NGW * 64;
    conv_bf16(A->in[I_PSK], (bf16*)(ws + WS_SK), (size_t)DEPTH * 8 * 2 * 128 * 128 / 8, gtid, nthr);
    const int NX = (F.G & 7) == 0 ? 8 : 1, XI = F.bx % NX, RX = M / NX, xw = (F.bx / NX) * NWAVES + F.wave, WX = (F.G / NX) * NWAVES;
    for (int m = RX * XI + xw; m < RX * (XI + 1); m += 2 * WX) {
        const int m1 = m + WX < RX * (XI + 1) ? m + WX : m;
        const GAS f32x4* xa = (const GAS f32x4*)(A->in[I_X] + (size_t)m * D + 16 * F.lane); const GAS f32x4* xb = (const GAS f32x4*)(A->in[I_X] + (size_t)m1 * D + 16 * F.lane);
        f32x4 va[4], vb[4];
#pragma unroll
        for (int j = 0; j < 4; ++j) { va[j] = xa[j]; vb[j] = xb[j]; }
        row_to_i8(F.lane, va, A->in[I_ANW], ws + WS_XN8 + (size_t)m * D, (float*)(ws + WS_AS) + m);
        if (m1 != m) row_to_i8(F.lane, vb, A->in[I_ANW], ws + WS_XN8 + (size_t)m1 * D, (float*)(ws + WS_AS) + m1);
    }
}

__device__ __forceinline__ f32x4 mma16_k64(const LAS bf16* A, int lda, const LAS bf16* B, int ldb, int lane) {
    f32x4 acc = {0.f, 0.f, 0.f, 0.f};
    const LAS bf16* ap = A + (lane & 15) * lda + 8 * (lane >> 4); const LAS bf16* bp = B + (lane & 15) * ldb + 8 * (lane >> 4);
#pragma unroll
    for (int kk = 0; kk < 2; ++kk) { const bf16x8 a = *(const LAS bf16x8*)(ap + kk * 32), b = *(const LAS bf16x8*)(bp + kk * 32); acc = __builtin_amdgcn_mfma_f32_16x16x32_bf16(a, b, acc, 0, 0, 0); }
    return acc;
}
constexpr int LP = 72;
__device__ __forceinline__ void diff_rows(Frame& F, int l) {
    KArgs A = kargs(); unsigned char* const ws = A->ws;
    const int lane = F.lane;
    const float lam_init = 0.8f - 0.6f * expf(-0.3f * (float)l);
    const float s1 = wave_sum(A->in[I_LQ1][l * 64 + lane] * A->in[I_LK1][l * 64 + lane]), s2 = wave_sum(A->in[I_LQ2][l * 64 + lane] * A->in[I_LK2][l * 64 + lane]);
    const float lam = expf(s1) - expf(s2) + lam_init;
    const int hh = lane >> 4, c0 = 8 * (lane & 15);
    float wv[8];
#pragma unroll
    for (int i = 0; i < 8; ++i) wv[i] = A->in[I_DONW][l * 128 + c0 + i] * (1.f - lam_init);
    const bf16* O = (const bf16*)(ws + WS_O); const bf16* MIX = (const bf16*)A->out;
    unsigned char* MIX8 = (unsigned char*)A->out + OUT_MIX8; float* MS = (float*)((unsigned char*)A->out + OUT_MS);
    const int NX = (F.G & 7) == 0 ? 8 : 1, XI = F.bx % NX, RX = M / NX, xw = (F.bx / NX) * NWAVES + F.wave, WX = (F.G / NX) * NWAVES;
    const int tend = RX * (XI + 1), tstep = 4 * WX;
    v4u a[4], b[4], g[4];
#define DR_LOAD(A_, B_, G_, T_) do { _Pragma("unroll") for (int j = 0; j < 4; ++j) { const bf16* orow = O + (size_t)((T_) + j) * 1024 + 256 * hh + c0; \
            A_[j] = *(const GAS v4u*)orow; B_[j] = *(const GAS v4u*)(orow + 128); G_[j] = *(const GAS v4u*)(MIX + (size_t)((T_) + j) * 1024 + 512 + 8 * lane); } } while (0)
    int t0 = RX * XI + 4 * xw;
    if (t0 < tend) DR_LOAD(a, b, g, t0);
    for (; t0 < tend; t0 += tstep) {
        const bool hn = t0 + tstep < tend; v4u an[4], bn[4], gn[4];
        if (hn) DR_LOAD(an, bn, gn, t0 + tstep);
#pragma unroll
        for (int j = 0; j < 4; ++j) {
            const unsigned aw[4] = {a[j].x, a[j].y, a[j].z, a[j].w}, bw[4] = {b[j].x, b[j].y, b[j].z, b[j].w}, gw[4] = {g[j].x, g[j].y, g[j].z, g[j].w};
            float d[8], gv[8]; float ss = 0.f;
#pragma unroll
            for (int i = 0; i < 4; ++i) { d[2 * i] = bflo(aw[i]) - lam * bflo(bw[i]); d[2 * i + 1] = bfhi(aw[i]) - lam * bfhi(bw[i]); ss += d[2 * i] * d[2 * i] + d[2 * i + 1] * d[2 * i + 1]; gv[2 * i] = bflo(gw[i]); gv[2 * i + 1] = bfhi(gw[i]); }
            const float rs = 1.f / sqrtf(row16_sum(ss) * (1.f / 128.f) + RMS_EPS);
            float am = 0.f;
#pragma unroll
            for (int i = 0; i < 8; ++i) { d[i] = bf2f((unsigned short)f2bf(d[i] * rs * wv[i])); am = fmaxf(am, fmaxf(fabsf(d[i]), fabsf(gv[i]))); }
            am = wave_max_nn(am);
            const float inv = am > 0.f ? 127.f / am : 0.f;
            unsigned wd[2], wg[2];
#pragma unroll
            for (int q = 0; q < 2; ++q) {
                const int b0 = (int)rintf(d[4 * q] * inv), b1 = (int)rintf(d[4 * q + 1] * inv), b2 = (int)rintf(d[4 * q + 2] * inv), b3 = (int)rintf(d[4 * q + 3] * inv);
                wd[q] = (unsigned)(b0 & 0xff) | ((unsigned)(b1 & 0xff) << 8) | ((unsigned)(b2 & 0xff) << 16) | ((unsigned)(b3 & 0xff) << 24);
                const int e0 = (int)rintf(gv[4 * q] * inv), e1 = (int)rintf(gv[4 * q + 1] * inv), e2 = (int)rintf(gv[4 * q + 2] * inv), e3 = (int)rintf(gv[4 * q + 3] * inv);
                wg[q] = (unsigned)(e0 & 0xff) | ((unsigned)(e1 & 0xff) << 8) | ((unsigned)(e2 & 0xff) << 16) | ((unsigned)(e3 & 0xff) << 24); }
            unsigned char* mrow = MIX8 + (size_t)(t0 + j) * 1024;
            *(GAS v2u*)(mrow + 128 * hh + c0) = (v2u){wd[0], wd[1]};
            *(GAS v2u*)(mrow + 512 + 8 * lane) = (v2u){wg[0], wg[1]};
            if (lane == 0) MS[t0 + j] = am * (1.f / 127.f);
        }
        if (hn) {
#pragma unroll
            for (int j = 0; j < 4; ++j) { a[j] = an[j]; b[j] = bn[j]; g[j] = gn[j]; } }
    }
#undef DR_LOAD
}
namespace psel {
constexpr int cand_count() { int n = 0; for (int a = 0; a < 16; ++a) for (int b = 0; b < 16; ++b) if ((a + 1) * (b + 1) <= 16) ++n; return n; }
static_assert(cand_count() == 50, "candidate frontier");
constexpr int cand_ab(int idx) { int n = 0; for (int a = 0; a < 16; ++a) for (int b = 0; b < 16; ++b) if ((a + 1) * (b + 1) <= 16) { if (n == idx) return a * 16 + b; ++n; } return 0; }
__device__ __forceinline__ float pmax32(float m) { auto rr = __builtin_amdgcn_permlane32_swap(__float_as_uint(m), __float_as_uint(m), false, false); return fmaxf(__uint_as_float(rr[0]), __uint_as_float(rr[1])); }
__device__ __forceinline__ void ce_desc(float& a, float& b) { const float hi = fmaxf(a, b), lo = fminf(a, b); a = hi; b = lo; }
constexpr unsigned char OE16[63][2] = {{0, 1}, {2, 3}, {0, 2}, {1, 3}, {1, 2}, {4, 5}, {6, 7}, {4, 6}, {5, 7}, {5, 6}, {0, 4}, {2, 6}, {2, 4}, {1, 5}, {3, 7}, {3, 5}, {1, 2}, {3, 4}, {5, 6}, {8, 9}, {10, 11}, {8, 10}, {9, 11}, {9, 10}, {12, 13}, {14, 15}, {12, 14}, {13, 15}, {13, 14}, {8, 12}, {10, 14}, {10, 12}, {9, 13}, {11, 15}, {11, 13}, {9, 10}, {11, 12}, {13, 14}, {0, 8}, {4, 12}, {4, 8}, {2, 10}, {6, 14}, {6, 10}, {2, 4}, {6, 8}, {10, 12}, {1, 9}, {5, 13}, {5, 9}, {3, 11}, {7, 15}, {7, 11}, {3, 5}, {7, 9}, {11, 13}, {1, 2}, {3, 4}, {5, 6}, {7, 8}, {9, 10}, {11, 12}, {13, 14}};
template <int OFF, int NA> __device__ __forceinline__ void sort16_desc(float (&v)[NA]) {
#pragma unroll
    for (int i = 0; i < 63; ++i) ce_desc(v[OFF + OE16[i][0]], v[OFF + OE16[i][1]]);
}
template <int OFF, int NA> __device__ __forceinline__ void merge16_desc(float (&v)[NA]) {
#pragma unroll
    for (int lj = 3; lj >= 0; --lj)
#pragma unroll
        for (int i = 0; i < 16; ++i) { const int l = i ^ (1 << lj); if (l > i) ce_desc(v[OFF + i], v[OFF + l]); }
}
template <int A, int B, int NA> __device__ __forceinline__ void top16_merge(float (&v)[NA]) {
#pragma unroll
    for (int i = 0; i < 16; ++i) v[A + i] = fmaxf(v[A + i], v[B + 15 - i]);
    merge16_desc<A, NA>(v);
}
template <int NA> __device__ __forceinline__ void top16_cross(float (&v)[NA], float (&out)[16]) {
    float lo[16], hi[16];
#pragma unroll
    for (int i = 0; i < 16; ++i) { auto rr = __builtin_amdgcn_permlane32_swap(__float_as_uint(v[i]), __float_as_uint(v[i]), false, false); lo[i] = __uint_as_float(rr[0]); hi[i] = __uint_as_float(rr[1]); }
#pragma unroll
    for (int i = 0; i < 16; ++i) out[i] = fmaxf(lo[i], hi[15 - i]);
    merge16_desc<0, 16>(out);
}
__device__ __forceinline__ void top16_of_128(float (&sc)[64], float (&out)[16]) {
    sort16_desc<0, 64>(sc); sort16_desc<16, 64>(sc); sort16_desc<32, 64>(sc); sort16_desc<48, 64>(sc);
    top16_merge<0, 16, 64>(sc); top16_merge<32, 48, 64>(sc); top16_merge<0, 32, 64>(sc);
    top16_cross<64>(sc, out);
}
template <int S> __device__ __forceinline__ void cand_one(float (&cand)[25], const float (&v0)[16], const float (&v1)[16], bool hi) {
    constexpr int ab0 = cand_ab(2 * S), ab1 = cand_ab(2 * S + 1);
    const float s0 = v0[ab0 >> 4] + v1[ab0 & 15], s1 = v0[ab1 >> 4] + v1[ab1 & 15];
    const float s = hi ? s1 : s0; const unsigned id = hi ? (unsigned)ab1 : (unsigned)ab0;
    cand[S] = __uint_as_float((__float_as_uint(s) & ~0xFFu) | id);
}
template <int... S> __device__ __forceinline__ void cand_all(float (&cand)[25], const float (&v0)[16], const float (&v1)[16], bool hi, std::integer_sequence<int, S...>) { (cand_one<S>(cand, v0, v1, hi), ...); }
__device__ __forceinline__ unsigned lookup7(const unsigned (&tab)[4], unsigned a) {
    const unsigned sel = 0x0c0c0c00u | (a & 7u); const unsigned lo = __builtin_amdgcn_perm(tab[1], tab[0], sel), hi = __builtin_amdgcn_perm(tab[3], tab[2], sel); return (a & 8u) ? hi : lo; }
}
__device__ __forceinline__ void peer_select(Frame& F, int l) {
    KArgs A = kargs(); unsigned char* const ws = A->ws;
    const int lane = F.lane, r32 = lane & 31, hi = lane >> 5;
    const bf16* Q2 = (const bf16*)(ws + WS_Q2); const bf16* SK = (const bf16*)(ws + WS_SK) + (size_t)l * 8 * 2 * 128 * 128;
    unsigned short* IDX = (unsigned short*)(ws + WS_IDX); float* GATE = (float*)(ws + WS_GATE);
    const bool aff = F.G == 256; const int h = aff ? (F.bx >> 3) & 7 : F.bx & 7, jb = F.bx >> 3; constexpr int KP = 136;
    LAS bf16* KL = (LAS bf16*)F.lds;
#pragma unroll
    for (int i = 0; i < 8; ++i) { const int p = F.tid + 512 * i, row = p >> 4, j = p & 15; *(LAS v4u*)(KL + row * KP + 8 * j) = *(const GAS v4u*)(SK + ((size_t)h * 256 + row) * 128 + 8 * j); }
    __syncthreads();
    const int tg0 = aff ? 128 * (F.bx & 7) + 32 * (F.bx >> 6) + F.wave : jb * 8 + F.wave, tg1 = aff ? 128 * (F.bx & 7) + 32 * (F.bx >> 6) + 32 : M / 32, tgs = aff ? 8 : (F.G >> 3) * 8;
    for (int tg = tg0; tg < tg1; tg += tgs) {
        const size_t tok = (size_t)tg * 32 + r32;
        bf16x8 bq[2][8];
#pragma unroll
        for (int c = 0; c < 2; ++c)
#pragma unroll
            for (int ks = 0; ks < 8; ++ks) bq[c][ks] = *(const GAS bf16x8*)(Q2 + tok * 2048 + (h * 2 + c) * 128 + ks * 16 + 8 * hi);
        float ts[2][16];
#pragma unroll
        for (int c = 0; c < 2; ++c) {
            f32x16 acc[4];
#pragma unroll
            for (int mt = 0; mt < 4; ++mt) acc[mt] = f32x16{};
            const LAS bf16* kp = KL + (c * 128 + r32) * KP + 8 * hi;
#pragma unroll
            for (int ks = 0; ks < 8; ++ks)
#pragma unroll
                for (int mt = 0; mt < 4; ++mt) { const bf16x8 ak = *(const LAS bf16x8*)(kp + mt * 32 * KP + ks * 16); acc[mt] = __builtin_amdgcn_mfma_f32_32x32x16_bf16(ak, bq[c][ks], acc[mt], 0, 0, 0); }
            float sc[64];
#pragma unroll
            for (int mt = 0; mt < 4; ++mt)
#pragma unroll
                for (int r = 0; r < 16; ++r) { const unsigned key = (unsigned)(32 * mt + (r & 3) + 8 * (r >> 2) + 4 * hi); sc[mt * 16 + r] = __uint_as_float((__float_as_uint(acc[mt][r]) & ~0x7Fu) | key); }
            __builtin_amdgcn_sched_barrier(0);
            psel::top16_of_128(sc, ts[c]);
            __builtin_amdgcn_sched_barrier(0);
        }
        unsigned kt0[4], kt1[4]; float v0[16], v1[16];
#pragma unroll
        for (int q = 0; q < 4; ++q) { kt0[q] = 0u; kt1[q] = 0u;
#pragma unroll
            for (int j = 0; j < 4; ++j) { kt0[q] |= (__float_as_uint(ts[0][4 * q + j]) & 0x7Fu) << (8 * j); kt1[q] |= (__float_as_uint(ts[1][4 * q + j]) & 0x7Fu) << (8 * j); } }
#pragma unroll
        for (int i = 0; i < 16; ++i) { v0[i] = __uint_as_float(__float_as_uint(ts[0][i]) & ~0x7Fu); v1[i] = __uint_as_float(__float_as_uint(ts[1][i]) & ~0x7Fu); }
        float cand[25];
        psel::cand_all(cand, v0, v1, hi != 0, std::make_integer_sequence<int, 25>{});
        float c32[32];
#pragma unroll
        for (int i = 0; i < 25; ++i) c32[i] = cand[i];
#pragma unroll
        for (int i = 25; i < 32; ++i) c32[i] = -INFINITY;
        psel::sort16_desc<0, 32>(c32); psel::sort16_desc<16, 32>(c32); psel::top16_merge<0, 16, 32>(c32);
        float best[16];
        psel::top16_cross<32>(c32, best);
        int ex[16];
#pragma unroll
        for (int k = 0; k < 16; ++k) { const unsigned bb = __float_as_uint(best[k]); ex[k] = (int)(psel::lookup7(kt0, (bb >> 4) & 15u) * 128u + psel::lookup7(kt1, bb & 15u)); }
        if (hi == 0) { GAS v4u* o = (GAS v4u*)(IDX + tok * 128 + h * 16);
#pragma unroll
            for (int q = 0; q < 2; ++q) o[q] = (v4u){(unsigned)ex[8 * q] | ((unsigned)ex[8 * q + 1] << 16), (unsigned)ex[8 * q + 2] | ((unsigned)ex[8 * q + 3] << 16), (unsigned)ex[8 * q + 4] | ((unsigned)ex[8 * q + 5] << 16), (unsigned)ex[8 * q + 6] | ((unsigned)ex[8 * q + 7] << 16)}; }
        else {
            float mx = __uint_as_float(__float_as_uint(best[0]) & ~0xFFu); float g[16]; float sum = 0.f;
#pragma unroll
            for (int k = 0; k < 16; ++k) { g[k] = __expf(__uint_as_float(__float_as_uint(best[k]) & ~0xFFu) - mx); sum += g[k]; }
            const float inv = 1.f / sum; GAS f32x4* o = (GAS f32x4*)(GATE + tok * 128 + h * 16);
#pragma unroll
            for (int q = 0; q < 4; ++q) o[q] = (f32x4){g[4 * q] * inv, g[4 * q + 1] * inv, g[4 * q + 2] * inv, g[4 * q + 3] * inv}; }
    }
}
__device__ __forceinline__ float gelu_erf(float x) { return 0.5f * x * (1.f + erff(x * 0.70710678118654752f)); }
__device__ __forceinline__ float dppf(float v, const int ctrl_sel) {
    const int x = __builtin_bit_cast(int, v);
    int r;
    if (ctrl_sel == 0) r = __builtin_amdgcn_update_dpp(0, x, 0xB1, 0xf, 0xf, true);
    else if (ctrl_sel == 1) r = __builtin_amdgcn_update_dpp(0, x, 0x4E, 0xf, 0xf, true);
    else if (ctrl_sel == 2) r = __builtin_amdgcn_update_dpp(0, x, 0x141, 0xf, 0xf, true);
    else r = __builtin_amdgcn_update_dpp(0, x, 0x128, 0xf, 0xf, true);
    return __builtin_bit_cast(float, r);
}
__device__ __forceinline__ float swap_add32(float a, float b) { auto rr = __builtin_amdgcn_permlane32_swap(__float_as_uint(a), __float_as_uint(b), false, false); return __uint_as_float(rr[0]) + __uint_as_float(rr[1]); }
__device__ __forceinline__ float swap_add16(float a, float b) { auto rr = __builtin_amdgcn_permlane16_swap(__float_as_uint(a), __float_as_uint(b), false, false); return __uint_as_float(rr[0]) + __uint_as_float(rr[1]); }
__device__ __forceinline__ float reduce8(const float (&p)[8], int lane) {
    const float r0 = swap_add32(p[0], p[4]), r1 = swap_add32(p[1], p[5]), r2 = swap_add32(p[2], p[6]), r3 = swap_add32(p[3], p[7]);
    const float s0 = swap_add16(r0, r2), s1 = swap_add16(r1, r3);
    const bool b3 = (lane & 8) != 0;
    const float keep = b3 ? s1 : s0, send = b3 ? s0 : s1;
    float z = keep + dppf(send, 3);
    z += dppf(z, 0); z += dppf(z, 1); z += dppf(z, 2);
    return z;
}
__device__ __forceinline__ float ub(unsigned w, int k) { return (float)((w >> (8 * k)) & 0xffu); }
constexpr int PEER_TG = 4, PEER_NGRP = M / PEER_TG;
constexpr int CW_PEER = 8192;
__device__ __forceinline__ int peer_dequeue(gu32* ctr, int lane) {
    unsigned v = 0u; if (lane == 0) v = __hip_atomic_fetch_add(ctr, 1u, __ATOMIC_RELAXED, __HIP_MEMORY_SCOPE_AGENT);
    return __builtin_amdgcn_readfirstlane((int)v);
}
__device__ __forceinline__ unsigned peer_dequeue_issue(gu32* ctr, int lane) { unsigned v = 0u, off = 0u; asm volatile("" : "+v"(off));
    if (lane == 0) v = __hip_atomic_fetch_add(ctr + off, 1u, __ATOMIC_RELAXED, __HIP_MEMORY_SCOPE_AGENT); return v; }
__device__ __forceinline__ int peer_dequeue_get(unsigned v) { asm volatile("" : "+v"(v) :: "memory"); return __builtin_amdgcn_readfirstlane((int)v); }
struct HalfBuf { v4u p[8]; };
struct IdSet { v4u id[2]; };
struct TokAux { v4u a[2]; };
__device__ __forceinline__ void ps_ids(IdSet& I, const unsigned short* idrow) {
#pragma unroll
    for (int q = 0; q < 2; ++q) I.id[q] = ((const GAS v4u*)idrow)[q];
}
template <int HALF_> __device__ __forceinline__ void ps_gather(HalfBuf& B, const unsigned char* tab_slice, const IdSet& I, int c) {
    const unsigned c16 = 16u * (unsigned)c;
#pragma unroll
    for (int i = 0; i < 8; ++i) { const unsigned w = I.id[HALF_][i >> 1]; const unsigned e = (i & 1) ? w >> 16 : w & 0xffffu; B.p[i] = *(const GAS v4u*)(tab_slice + (e * 128u + c16)); }
}
__device__ __forceinline__ int dppi(int x, const int sel) {
    if (sel == 0) return __builtin_amdgcn_update_dpp(0, x, 0xB1, 0xf, 0xf, true);
    if (sel == 1) return __builtin_amdgcn_update_dpp(0, x, 0x4E, 0xf, 0xf, true);
    return __builtin_amdgcn_update_dpp(0, x, 0x141, 0xf, 0xf, true);
}
struct UState { int hq[4]; float sc; };
template <int HALF_> __device__ __forceinline__ void ps_compute_u(const HalfBuf& B, const TokAux& X, UState& U, bf16* part_row, int g, int c) {
    if (HALF_ == 0) {
        const unsigned rw[8] = {X.a[0].x, X.a[0].y, X.a[0].z, X.a[0].w, X.a[1].x, X.a[1].y, X.a[1].z, X.a[1].w};
        float a[16]; float mx = 0.f;
#pragma unroll
        for (int q = 0; q < 8; ++q) { a[2 * q] = bflo(rw[q]); a[2 * q + 1] = bfhi(rw[q]); mx = fmaxf(mx, fmaxf(fabsf(a[2 * q]), fabsf(a[2 * q + 1]))); }
        mx = fmaxf(mx, dppf(mx, 0)); mx = fmaxf(mx, dppf(mx, 1)); mx = fmaxf(mx, dppf(mx, 2));
        const float inv = mx > 0.f ? 127.f / mx : 0.f; U.sc = mx * (1.f / 127.f);
#pragma unroll
        for (int q = 0; q < 4; ++q) { const int b0 = (int)rintf(a[4 * q] * inv), b1 = (int)rintf(a[4 * q + 1] * inv), b2 = (int)rintf(a[4 * q + 2] * inv), b3 = (int)rintf(a[4 * q + 3] * inv);
            U.hq[q] = (int)((unsigned)(b0 & 0xff) | ((unsigned)(b1 & 0xff) << 8) | ((unsigned)(b2 & 0xff) << 16) | ((unsigned)(b3 & 0xff) << 24)); }
    }
    int d[8];
#pragma unroll
    for (int i = 0; i < 8; ++i) { int x = __builtin_amdgcn_sdot4((int)B.p[i].x, U.hq[0], 0, false); x = __builtin_amdgcn_sdot4((int)B.p[i].y, U.hq[1], x, false);
        x = __builtin_amdgcn_sdot4((int)B.p[i].z, U.hq[2], x, false); x = __builtin_amdgcn_sdot4((int)B.p[i].w, U.hq[3], x, false);
        x += dppi(x, 0); x += dppi(x, 1); x += dppi(x, 2); d[i] = x; }
    const float sc = U.sc;
    if (c == 0) *(GAS v4u*)(part_row + 16 * g + 8 * HALF_) = (v4u){pk2((float)d[0] * sc, (float)d[1] * sc), pk2((float)d[2] * sc, (float)d[3] * sc), pk2((float)d[4] * sc, (float)d[5] * sc), pk2((float)d[6] * sc, (float)d[7] * sc)};
}
struct VState { int acc[16]; };
template <int HALF_, bool LAST> __device__ __forceinline__ void ps_compute_v(const HalfBuf& B, const TokAux& X, VState& S, const bf16* res_cols, bf16* res_w, float* out_cols  , int lane) {
    if (HALF_ == 0) {
#pragma unroll
        for (int j = 0; j < 16; ++j) S.acc[j] = 0; }
    const unsigned wq[4] = {X.a[0].x, X.a[0].y, X.a[0].z, X.a[0].w};
#pragma unroll
    for (int q = 0; q < 2; ++q) {
        const unsigned pa[4] = {B.p[4 * q].x, B.p[4 * q].y, B.p[4 * q].z, B.p[4 * q].w}, pb[4] = {B.p[4 * q + 1].x, B.p[4 * q + 1].y, B.p[4 * q + 1].z, B.p[4 * q + 1].w};
        const unsigned pc[4] = {B.p[4 * q + 2].x, B.p[4 * q + 2].y, B.p[4 * q + 2].z, B.p[4 * q + 2].w}, pd[4] = {B.p[4 * q + 3].x, B.p[4 * q + 3].y, B.p[4 * q + 3].z, B.p[4 * q + 3].w};
        const int wv = (int)wq[2 * HALF_ + q];
#pragma unroll
        for (int p = 0; p < 4; ++p) {
            const unsigned ab_lo = __builtin_amdgcn_perm(pb[p], pa[p], 0x05010400u), ab_hi = __builtin_amdgcn_perm(pb[p], pa[p], 0x07030602u);
            const unsigned cd_lo = __builtin_amdgcn_perm(pd[p], pc[p], 0x05010400u), cd_hi = __builtin_amdgcn_perm(pd[p], pc[p], 0x07030602u);
            const unsigned t0 = __builtin_amdgcn_perm(cd_lo, ab_lo, 0x05040100u), t1 = __builtin_amdgcn_perm(cd_lo, ab_lo, 0x07060302u);
            const unsigned t2 = __builtin_amdgcn_perm(cd_hi, ab_hi, 0x05040100u), t3 = __builtin_amdgcn_perm(cd_hi, ab_hi, 0x07060302u);
            S.acc[4 * p] = __builtin_amdgcn_sdot4((int)t0, wv, S.acc[4 * p], false); S.acc[4 * p + 1] = __builtin_amdgcn_sdot4((int)t1, wv, S.acc[4 * p + 1], false);
            S.acc[4 * p + 2] = __builtin_amdgcn_sdot4((int)t2, wv, S.acc[4 * p + 2], false); S.acc[4 * p + 3] = __builtin_amdgcn_sdot4((int)t3, wv, S.acc[4 * p + 3], false);
        }
    }
    if (HALF_ == 1) {
        const float sc = __uint_as_float(X.a[1].x);
        float fa[16];
#pragma unroll
        for (int j = 0; j < 16; ++j) fa[j] = (float)S.acc[j] * sc;
        float r[8];
#pragma unroll
        for (int j = 0; j < 8; ++j) r[j] = swap_add32(fa[j], fa[j + 8]);
        float s4[4];
#pragma unroll
        for (int j = 0; j < 4; ++j) s4[j] = swap_add16(r[j], r[j + 4]);
        const bool b3 = (lane & 8) != 0;
        float z[2];
#pragma unroll
        for (int j = 0; j < 2; ++j) { const float keep = b3 ? s4[j + 2] : s4[j], send = b3 ? s4[j] : s4[j + 2]; z[j] = keep + dppf(send, 3); }
        const int col = 16 * (lane & 7) + 2 * (lane >> 3);
        const unsigned rw = *(const GAS unsigned*)(res_cols + col);
        const float y0 = bflo(rw) + z[0], y1 = bfhi(rw) + z[1];
        if (LAST) { typedef float f32x2v __attribute__((ext_vector_type(2))); *(GAS f32x2v*)(out_cols + col) = (f32x2v){y0, y1}; }
        else *(GAS unsigned*)(res_w + col) = pk2(y0, y1);
    }
}
template <bool IS_V, bool DRY = false, bool LAST = false> __device__ __forceinline__ void peer_sliced(Frame& F, int l) {
    KArgs A = kargs(); unsigned char* const ws = A->ws;
    const int lane = F.lane, g = lane >> 3, c = lane & 7;
    const int xcc = (int)(xb_xcc_id() & 7u);
    gu32* ctr0 = (gu32*)(ws + WS_CTL) + CW_PEER + 64 * ((l * 4 + (IS_V ? 1 : 0) + (DRY ? 2 : 0)) * 8);
    const unsigned short* IDX = (const unsigned short*)(ws + WS_IDX);
    for (int s = 0; s < 8; ++s) {
        const int k = (xcc + s) & 7; gu32* ctr = ctr0 + 64 * k;
        const unsigned char* tab = ws + (IS_V ? WS_TV : WS_TU) + ((size_t)(l * 8 + k) * NEXP) * 128;
        int cur = peer_dequeue(ctr, lane);
        if (cur < PEER_NGRP) {
            size_t t0 = (size_t)cur * PEER_TG;
            HalfBuf H0, H1, H2, H3; IdSet I0, I1; TokAux X0, X1, X2, X3; UState US; VState VS;
#define PS_IDS(IS, t) ps_ids(IS, IDX + (t) * 128 + 16 * g)
#define PS_AUX(XS, t) do { if (IS_V) { XS.a[0] = *(const GAS v4u*)(ws + WS_EW8 + (t) * 128 + 16 * g); XS.a[1].x = __float_as_uint(((const float*)(ws + WS_EWSC))[(t) * 8 + g]); } \
                           else { const GAS v4u* rp_ = (const GAS v4u*)((const bf16*)(ws + WS_RES) + (t) * D + 128 * k + 16 * c); XS.a[0] = rp_[0]; XS.a[1] = rp_[1]; } } while (0)
#define PS_G(HB, IS, hf) ps_gather<hf>(HB, tab, IS, c)
#define PS_C(HB, XS, t, hf) do { if (IS_V) ps_compute_v<hf, LAST>(HB, XS, VS, (const bf16*)(ws + WS_RES) + (t) * D + 128 * k, (bf16*)(ws + (DRY ? WS_Q2 : WS_RES)) + (t) * D + 128 * k, (DRY ? (float*)(ws + WS_Q2) : A->out) + (t) * D + 128 * k, lane); \
                                 else ps_compute_u<hf>(HB, XS, US, (bf16*)(ws + WS_PART) + ((size_t)k * M + (t)) * 128, g, c); } while (0)
            PS_IDS(I0, t0); PS_IDS(I1, t0 + 1); PS_AUX(X0, t0); PS_G(H0, I0, 0); PS_G(H1, I0, 1); PS_AUX(X1, t0 + 1); PS_G(H2, I1, 0);
            for (;;) {
                const unsigned nxt_v = peer_dequeue_issue(ctr, lane);
                PS_IDS(I0, t0 + 2);                    PS_G(H3, I1, 1); PS_C(H0, X0, t0, 0);
                PS_AUX(X2, t0 + 2);                    PS_G(H0, I0, 0); PS_C(H1, X0, t0, 1);
                PS_IDS(I1, t0 + 3);                    PS_G(H1, I0, 1); PS_C(H2, X1, t0 + 1, 0);
                PS_AUX(X3, t0 + 3);                    PS_G(H2, I1, 0); PS_C(H3, X1, t0 + 1, 1);
                const int nxt = peer_dequeue_get(nxt_v);
                const bool more = nxt < PEER_NGRP; const size_t t1 = (size_t)nxt * PEER_TG;
                if (more) PS_IDS(I0, t1);              PS_G(H3, I1, 1); PS_C(H0, X2, t0 + 2, 0);
                if (more) { PS_AUX(X0, t1);            PS_G(H0, I0, 0); } PS_C(H1, X2, t0 + 2, 1);
                if (more) { PS_IDS(I1, t1 + 1);        PS_G(H1, I0, 1); } PS_C(H2, X3, t0 + 3, 0);
                if (more) { PS_AUX(X1, t1 + 1);        PS_G(H2, I1, 0); } PS_C(H3, X3, t0 + 3, 1);
                if (!more) break;
                t0 = t1;
            }
#undef PS_IDS
#undef PS_AUX
#undef PS_G
#undef PS_C
        }
    }
}
__device__ __forceinline__ void peer_w(Frame& F, int l) {
    KArgs A = kargs(); unsigned char* const ws = A->ws;
    const unsigned short* IDX = (const unsigned short*)(ws + WS_IDX); const float* GATE = (const float*)(ws + WS_GATE); const bf16* PART = (const bf16*)(ws + WS_PART);
    const float* USC = (const float*)(ws + WS_USC) + l * NEXP; const float* VSC = (const float*)(ws + WS_VSC) + l * NEXP; const float* HS = (const float*)(ws + WS_RS);
    signed char* WQ = (signed char*)(ws + WS_EW8); float* WSC = (float*)(ws + WS_EWSC);
    LAS float* UL = (LAS float*)F.lds; LAS float* VL = UL + NEXP;
    for (int i = F.tid; i < NEXP / 4; i += NWAVES * 64) { ((LAS f32x4*)UL)[i] = ((const GAS f32x4*)USC)[i]; ((LAS f32x4*)VL)[i] = ((const GAS f32x4*)VSC)[i]; }
    __syncthreads();
    const size_t nthr = (size_t)F.NGW * 64;
    const size_t iend = (size_t)M * 128, istep = 4 * nthr; size_t i0 = (size_t)F.gw * 64 + F.lane;
    unsigned pr[4][8]; int e[4]; float gt[4], hs[4];
#define W_LOAD(PR_, E_, GT_, HS_, I_) do { _Pragma("unroll") for (int j = 0; j < 4; ++j) { const size_t i = (I_) + j * nthr; \
            _Pragma("unroll") for (int k = 0; k < 8; ++k) PR_[j][k] = PART[(size_t)k * M * 128 + i]; \
            E_[j] = IDX[i]; GT_[j] = GATE[i]; HS_[j] = HS[i >> 7]; } } while (0)
    if (i0 < iend) W_LOAD(pr, e, gt, hs, i0);
    for (; i0 < iend; i0 += istep) {
        const bool hn = i0 + istep < iend; unsigned prn[4][8]; int en[4]; float gtn[4], hsn[4];
        if (hn) W_LOAD(prn, en, gtn, hsn, i0 + istep);
#pragma unroll
        for (int j = 0; j < 4; ++j) { const size_t i = i0 + j * nthr; float p = 0.f;
#pragma unroll
            for (int k = 0; k < 8; ++k) p += bf2f((unsigned short)pr[j][k]);
            const float dot = p * UL[e[j]] * hs[j];
            const float w = gt[j] * gelu_erf(dot) * VL[e[j]];
            float m = fabsf(w);
            m = fmaxf(m, dppf(m, 0)); m = fmaxf(m, dppf(m, 1)); m = fmaxf(m, dppf(m, 2));
            m = fmaxf(m, __builtin_bit_cast(float, __builtin_amdgcn_update_dpp(0, __builtin_bit_cast(int, m), 0x140, 0xf, 0xf, true)));
            const float inv = m > 0.f ? 127.f / m : 0.f;
            WQ[i] = (signed char)(int)rintf(w * inv);
            if ((F.lane & 15) == 0) WSC[i >> 4] = m * (1.f / 127.f); }
        if (hn) {
#pragma unroll
            for (int j = 0; j < 4; ++j) { e[j] = en[j]; gt[j] = gtn[j]; hs[j] = hsn[j];
#pragma unroll
                for (int k = 0; k < 8; ++k) pr[j][k] = prn[j][k]; } }
    }
#undef W_LOAD
}

#define GBAR() asm volatile("s_waitcnt lgkmcnt(0)\n\ts_barrier" ::: "memory")
namespace glas {
constexpr int LPQ = 72, LPG = 136, GP = 65;
constexpr int O_GF = 0, O_TT = 64 * GP * 4, O_BL = O_TT + 2048, O_KR = O_BL + 256, O_KRT = O_KR + 9216, O_QR = O_KRT + 9216, O_QD = O_QR  , O_KI = O_KR  , O_KDT = O_QR + 9216, O_VT = O_KDT + 9216,
              O_AM = O_VT + 18432, O_GO = O_AM + 9216, O_OST = O_GO + 64 * LPG * 2, O_DEC = O_OST + 64 * LPG * 2, O_SS = O_DEC + 256, O_END = O_SS + 2048;
static_assert(O_END <= 131072 && O_TT % 16 == 0 && O_KR % 16 == 0 && O_DEC % 16 == 0 && O_SS % 16 == 0, "gla LDS");
struct Pre { v4u g[2], go[2], q, v[2], k; };
__device__ __forceinline__ void prefetch(Pre& P, const unsigned char* ws, size_t t0, int hh, int tid) {
    const float* GLOG = (const float*)(ws + WS_GLOG); const bf16* GQ = (const bf16*)(ws + WS_GQ); const bf16* GK = (const bf16*)(ws + WS_GK); const bf16* GV = (const bf16*)(ws + WS_GV); const bf16* GO = (const bf16*)(ws + WS_GO);
#pragma unroll
    for (int i = 0; i < 2; ++i) { const int p = tid + 512 * i, c = p >> 4, j = p & 15;
        P.g[i] = *(const GAS v4u*)(GLOG + (t0 + c) * 256 + hh * 64 + 4 * j);
        P.go[i] = *(const GAS v4u*)(GO + (t0 + c) * 512 + hh * 128 + 8 * j);
        const int cv = tid & 63, jv = (tid >> 6) + 8 * i;
        P.v[i] = *(const GAS v4u*)(GV + (t0 + cv) * 512 + hh * 128 + 8 * jv); }
    { const int c = tid >> 3, j = tid & 7; P.q = *(const GAS v4u*)(GQ + (t0 + c) * 256 + hh * 64 + 8 * j); }
    { const int c = tid & 63, j = tid >> 6; P.k = *(const GAS v4u*)(GK + (t0 + c) * 256 + hh * 64 + 8 * j); }
}
__device__ __forceinline__ float rowsum16(float v) {
    v += dppf(v, 0); v += dppf(v, 1); v += dppf(v, 2);
    v += __builtin_bit_cast(float, __builtin_amdgcn_update_dpp(0, __builtin_bit_cast(int, v), 0x140, 0xf, 0xf, true));
    return v;
}
}
template <int PASS> __device__ __forceinline__ void gla_run(Frame& F, int l, int run) {
    using namespace glas;
    KArgs A = kargs(); unsigned char* const ws = A->ws;
    const int bh = run >> 4, n0 = (run & 15) * 8, b = bh >> 2, hh = bh & 3, tid = F.tid, lane = F.lane, w = F.wave, q4 = lane >> 4, r16 = lane & 15;
    LAS float* Gf = (LAS float*)(F.lds + O_GF); LAS float* Tt = (LAS float*)(F.lds + O_TT); LAS float* BL = (LAS float*)(F.lds + O_BL);
    LAS bf16* Kr = (LAS bf16*)(F.lds + O_KR); LAS bf16* KrT = (LAS bf16*)(F.lds + O_KRT); LAS bf16* Qr = (LAS bf16*)(F.lds + O_QR); LAS bf16* Qd = (LAS bf16*)(F.lds + O_QD); LAS bf16* Ki = (LAS bf16*)(F.lds + O_KI);
    LAS bf16* KdT = (LAS bf16*)(F.lds + O_KDT); LAS bf16* VT = (LAS bf16*)(F.lds + O_VT); LAS bf16* Am = (LAS bf16*)(F.lds + O_AM); LAS bf16* GOs = (LAS bf16*)(F.lds + O_GO); LAS bf16* Ost = (LAS bf16*)(F.lds + O_OST);
    LAS float* DEC = (LAS float*)(F.lds + O_DEC); LAS float* SS = (LAS float*)(F.lds + O_SS);
    bf16* MIX = (bf16*)A->out;
    float* USUM = (float*)(ws + WS_USUM); float* PDS = (float*)(ws + WS_PDS);
    const float wg = A->in[I_GONW][l * 128 + 16 * w + r16];
    f32x4 S[4], pd[4];
#pragma unroll
    for (int t = 0; t < 4; ++t) { S[t] = (f32x4){0.f, 0.f, 0.f, 0.f}; pd[t] = (f32x4){1.f, 1.f, 1.f, 1.f}; }
    Pre P; prefetch(P, ws, (size_t)b * T + (size_t)n0 * 64, hh, tid);
    if (PASS == 2) {
        int rp = run & ~15;
        for (; rp + 2 <= run; rp += 2) {
            f32x4 us[2][4], ps[2][4];
#pragma unroll
            for (int j = 0; j < 2; ++j)
#pragma unroll
                for (int t = 0; t < 4; ++t) { us[j][t] = *(const GAS f32x4*)(USUM + ((size_t)(rp + j) * 512 + tid) * 16 + 4 * t); ps[j][t] = *(const GAS f32x4*)(PDS + (size_t)(rp + j) * 64 + 16 * t + 4 * q4); }
#pragma unroll
            for (int j = 0; j < 2; ++j)
#pragma unroll
                for (int t = 0; t < 4; ++t) S[t] = S[t] * ps[j][t] + us[j][t];
        }
        for (; rp < run; ++rp) {
#pragma unroll
            for (int t = 0; t < 4; ++t) { const f32x4 us = *(const GAS f32x4*)(USUM + ((size_t)rp * 512 + tid) * 16 + 4 * t), ps = *(const GAS f32x4*)(PDS + (size_t)rp * 64 + 16 * t + 4 * q4); S[t] = S[t] * ps + us; }
        }
    }
    for (int nn = 0; nn <= 8; ++nn) {
        const int n = n0 + nn;
        const size_t t0 = (size_t)b * T + (size_t)n * 64;
        if (nn == 8) {
            if (PASS == 2 && nn > 0) {
#pragma unroll
                for (int i = 0; i < 2; ++i) { const int p = tid + 512 * i, c = p >> 4, j = p & 15;
                    *(GAS v4u*)(MIX + (t0 - 64 + c) * 1024 + 512 + hh * 128 + 8 * j) = *(const LAS v4u*)(Ost + c * LPG + 8 * j); }
            }
            break;
        }
#pragma unroll
        for (int i = 0; i < 2; ++i) { const int p = tid + 512 * i, c = p >> 4, j = p & 15;
            Gf[c * GP + 4 * j] = __uint_as_float(P.g[i].x); Gf[c * GP + 4 * j + 1] = __uint_as_float(P.g[i].y); Gf[c * GP + 4 * j + 2] = __uint_as_float(P.g[i].z); Gf[c * GP + 4 * j + 3] = __uint_as_float(P.g[i].w);
            *(LAS v4u*)(GOs + c * LPG + 8 * j) = P.go[i];
            const int cv = tid & 63, jv = (tid >> 6) + 8 * i; const unsigned vv[4] = {P.v[i].x, P.v[i].y, P.v[i].z, P.v[i].w};
#pragma unroll
            for (int e = 0; e < 4; ++e) { VT[(8 * jv + 2 * e) * LPQ + cv] = (bf16)(vv[e] & 0xffffu); VT[(8 * jv + 2 * e + 1) * LPQ + cv] = (bf16)(vv[e] >> 16); } }
        { const int c = tid >> 3, j = tid & 7; *(LAS v4u*)(Qr + c * LPQ + 8 * j) = P.q; }
        { const int c = tid & 63, j = tid >> 6; *(LAS v4u*)(Kr + c * LPQ + 8 * j) = P.k; const unsigned kk[4] = {P.k.x, P.k.y, P.k.z, P.k.w};
#pragma unroll
          for (int e = 0; e < 4; ++e) { KrT[(8 * j + 2 * e) * LPQ + c] = (bf16)(kk[e] & 0xffffu); KrT[(8 * j + 2 * e + 1) * LPQ + c] = (bf16)(kk[e] >> 16); } }
        if (PASS == 2 && nn > 0) {
#pragma unroll
            for (int i = 0; i < 2; ++i) { const int p = tid + 512 * i, c = p >> 4, j = p & 15;
                *(GAS v4u*)(MIX + (t0 - 64 + c) * 1024 + 512 + hh * 128 + 8 * j) = *(const LAS v4u*)(Ost + c * LPG + 8 * j); }
        }
        if (nn + 1 < 8) prefetch(P, ws, t0 + 64, hh, tid);
        GBAR();
        { const int d = tid & 63, seg = tid >> 6; float bv[8]; float run = 0.f;
#pragma unroll
          for (int i = 0; i < 8; ++i) { run += Gf[(8 * seg + i) * GP + d]; bv[i] = run; }
          Tt[seg * 64 + d] = run;
          GBAR();
          float off = 0.f, bl = 0.f;
#pragma unroll
          for (int s = 0; s < 8; ++s) { const float tt = Tt[s * 64 + d]; bl += tt; off += (s < seg) ? tt : 0.f; }
          if (seg == 0) { DEC[d] = __expf(bl); BL[d] = bl; }
#pragma unroll
          for (int i = 0; i < 8; ++i) { const int c = 8 * seg + i; const float bc = bv[i] + off; Gf[c * GP + d] = bc;
              const float q = bf2f(Qr[c * LPQ + d]), k = bf2f(Kr[c * LPQ + d]);
              Qd[c * LPQ + d] = (bf16)f2bf(q * 0.125f * __expf(bc)); Ki[c * LPQ + d] = (bf16)f2bf(k * __expf(-bc)); } }
        GBAR();
        { const int c = tid & 63, dseg = tid >> 6;
#pragma unroll
          for (int i = 0; i < 8; ++i) { const int d = 8 * dseg + i; KdT[d * LPQ + c] = (bf16)f2bf(bf2f(KrT[d * LPQ + c]) * __expf(BL[d] - Gf[c * GP + d])); } }
        if (PASS == 2) { const int ti = w >> 1;
#pragma unroll
          for (int tjj = 0; tjj < 2; ++tjj) { const int tj = 2 * (w & 1) + tjj; const f32x4 a = mma16_k64(Qd + 16 * ti * LPQ, LPQ, Ki + 16 * tj * LPQ, LPQ, lane);
#pragma unroll
              for (int r = 0; r < 4; ++r) { const int i = 16 * ti + 4 * q4 + r, j = 16 * tj + r16; Am[i * LPQ + j] = (bf16)f2bf(i >= j ? a[r] : 0.f); } } }
        GBAR();
        f32x4 o[4];
        if (PASS == 2) { bf16x8 sb[2];
#pragma unroll
          for (int kk = 0; kk < 2; ++kk) { v4u pk; pk.x = pk2(S[2 * kk][0], S[2 * kk][1]); pk.y = pk2(S[2 * kk][2], S[2 * kk][3]); pk.z = pk2(S[2 * kk + 1][0], S[2 * kk + 1][1]); pk.w = pk2(S[2 * kk + 1][2], S[2 * kk + 1][3]); sb[kk] = __builtin_bit_cast(bf16x8, pk); }
#pragma unroll
          for (int ti = 0; ti < 4; ++ti) { f32x4 acc = mma16_k64(Am + 16 * ti * LPQ, LPQ, VT + 16 * w * LPQ, LPQ, lane);
#pragma unroll
              for (int kk = 0; kk < 2; ++kk) { const LAS bf16* qp = Qd + (16 * ti + r16) * LPQ + 32 * kk + 4 * q4;
                  const v2u lo = *(const LAS v2u*)qp, hi = *(const LAS v2u*)(qp + 16); v4u av; av.x = lo.x; av.y = lo.y; av.z = hi.x; av.w = hi.y;
                  acc = __builtin_amdgcn_mfma_f32_16x16x32_bf16(__builtin_bit_cast(bf16x8, av), sb[kk], acc, 0, 0, 0); }
              o[ti] = acc; } }
#pragma unroll
        for (int t = 0; t < 4; ++t) { const f32x4 dv = *(const LAS f32x4*)(DEC + 16 * t + 4 * q4); f32x4 acc = S[t] * dv;
            pd[t] = pd[t] * dv;
            const LAS bf16* ap = KdT + (16 * t + r16) * LPQ + 8 * q4; const LAS bf16* bp = VT + (16 * w + r16) * LPQ + 8 * q4;
#pragma unroll
            for (int kk = 0; kk < 2; ++kk) acc = __builtin_amdgcn_mfma_f32_16x16x32_bf16(*(const LAS bf16x8*)(ap + 32 * kk), *(const LAS bf16x8*)(bp + 32 * kk), acc, 0, 0, 0);
            S[t] = acc; }
        if (PASS == 1) { GBAR(); continue; }
#pragma unroll
        for (int ti = 0; ti < 4; ++ti)
#pragma unroll
            for (int r = 0; r < 4; ++r) { const float s = rowsum16(o[ti][r] * o[ti][r]); if (r16 == 0) SS[w * 64 + 16 * ti + 4 * q4 + r] = s; }
        GBAR();
#pragma unroll
        for (int ti = 0; ti < 4; ++ti) { f32x4 tot = {0.f, 0.f, 0.f, 0.f};
#pragma unroll
            for (int ww = 0; ww < 8; ++ww) tot += *(const LAS f32x4*)(SS + ww * 64 + 16 * ti + 4 * q4);
#pragma unroll
            for (int r = 0; r < 4; ++r) { const int c = 16 * ti + 4 * q4 + r; const float rs = __builtin_amdgcn_rsqf(tot[r] * (1.f / 128.f) + RMS_EPS);
                const float g = bf2f(GOs[c * LPG + 16 * w + r16]);
                Ost[c * LPG + 16 * w + r16] = (bf16)f2bf(o[ti][r] * rs * wg * (g * __builtin_amdgcn_rcpf(1.f + __expf(-g)))); } }
        GBAR();
    }
    if (PASS == 1) {
#pragma unroll
        for (int t = 0; t < 4; ++t) { *(GAS f32x4*)(USUM + ((size_t)run * 512 + tid) * 16 + 4 * t) = S[t]; if (w == 0 && r16 == 0) *(GAS f32x4*)(PDS + (size_t)run * 64 + 16 * t + 4 * q4) = pd[t]; }
    }
}
__device__ __forceinline__ Frame mkframe(unsigned char* lds) {
    Frame F; int tx = threadIdx.x, bx = blockIdx.x, G = gridDim.x;
    { volatile LAS unsigned* st = (volatile LAS unsigned*)((LAS unsigned char*)lds + MISC_OFF) + 8; if (st[3]) bx = (int)((xb_xcc_id() & 7u) + 8u * st[2]); }
    bx = __builtin_amdgcn_readfirstlane(bx);
    asm volatile("" : "+v"(tx)); asm volatile("" : "+s"(bx)); asm volatile("" : "+s"(G));
    F.lds = (LAS unsigned char*)lds; F.tid = tx; F.lane = tx & 63; F.wave = __builtin_amdgcn_readfirstlane(tx >> 6);
    F.G = G; F.bx = bx; F.vcu = (G % 8 == 0) ? (bx % 8) * (G / 8) + bx / 8 : bx; F.gw = bx * NWAVES + F.wave; F.NGW = G * NWAVES;
    return F;
}
__device__ __forceinline__ void seam(unsigned char* lds, int k) {
    KArgs A = kargs(); const int lo = A->ph_lo, hi = A->ph_hi;
    if (!(lo <= k && k + 1 < hi)) return;
    XcdBarrier b; b.bar = (unsigned*)(A->ws + WS_CTL) + CW_BAR; b.x = xb_xcc_id(); b.st = (volatile LAS unsigned*)((LAS unsigned char*)lds + MISC_OFF) + 8;
    xcd_barrier(b);
#ifdef PROBE_DUP_BAR
    xcd_barrier(b);
#endif
}
__device__ __forceinline__ void seam_local(unsigned char* lds, int k) {
    KArgs A = kargs(); const int lo = A->ph_lo, hi = A->ph_hi;
    if (!(lo <= k && k + 1 < hi)) return;
    XcdBarrier b; b.bar = (unsigned*)(A->ws + WS_CTL) + CW_BAR; b.x = xb_xcc_id(); b.st = (volatile LAS unsigned*)((LAS unsigned char*)lds + MISC_OFF) + 8;
    if (b.st[3]) xcd_local_barrier(b, (unsigned*)(A->ws + WS_CTL) + CW_LBAR); else xcd_barrier(b);
}
__device__ __forceinline__ bool phase_on(int k) { KArgs A = kargs(); return A->ph_lo <= k && k < A->ph_hi; }

__device__ __forceinline__ int probe_reps(bool on) { int n = on ? 2 : 1; asm volatile("" : "+s"(n)); return n; }
#ifdef PROBE_DUP_A1
#define REP_A1 true
#else
#define REP_A1 false
#endif
#ifdef PROBE_DUP_C1
#define REP_C1 true
#else
#define REP_C1 false
#endif
#ifdef PROBE_DUP_P0
#define REP_P0 true
#else
#define REP_P0 false
#endif
#ifdef PROBE_DUP_D1
#define REP_D1 true
#else
#define REP_D1 false
#endif
__device__ __forceinline__ bool attn_scores_bounded(int l) {
    KArgs A = kargs(); int tx = threadIdx.x; asm volatile("" : "+v"(tx)); const int lane = tx & 63;
    float mq = fabsf(A->in[I_QNW][l * 64 + lane]), mk = fabsf(A->in[I_KNW][l * 64 + lane]);
#pragma unroll
    for (int o = 1; o < 64; o <<= 1) { mq = fmaxf(mq, __shfl_xor(mq, o)); mk = fmaxf(mk, __shfl_xor(mk, o)); }
    return __builtin_amdgcn_readfirstlane((int)(8.f * 1.4426950408889634f * mq * mk < 60.f)) != 0;
}
template <int L> __device__ __forceinline__ void layer_fwd(unsigned char* lds) {
    constexpr int pb = 1 + 12 * L;
    if (phase_on(pb + 0)) {
        Frame F = mkframe(lds); KArgs A = kargs(); unsigned char* const ws = A->ws;
        pg8::Gemm g{(const bf16*)(ws + WS_XN8), (const bf16*)(ws + WS_WIN + (size_t)L * NIN * D), M, NIN, D / 2}; pg8::StaticOrder S; S.init(M, NIN, F.G, F.bx);
        pg8::EpiInProj E{ws, A->in[I_GB] + L * 256, A->in[I_QNW] + L * 64, A->in[I_KNW] + L * 64, attn_body::C2, (const float*)(ws + WS_AS), (const float*)(ws + WS_WCS) + L * NIN};
#ifdef PROBE_DUP_A1
        for (int rep = probe_reps(true); rep > 0; --rep)
#endif
        pg8::gemm_phase<pg8::EpiInProj, pg8::StaticOrder, true, true>(F.lds + RING_OFF, g, S, E);
    }
    if (phase_on(pb + 0)) {
        Frame F = mkframe(lds); const int nfull = ((M / 256) * (NIN / 256)) % F.G;
        if (nfull == 0) quant_tables(kargs(), L, F.gw, F.NGW, F.lane);
        else if (F.bx >= nfull) quant_tables(kargs(), L, (F.bx - nfull) * NWAVES + F.wave, (F.G - nfull) * NWAVES, F.lane);
    }
    seam_local(lds, pb + 0);
    if (phase_on(pb + 1)) { Frame F = mkframe(lds);
#ifdef PROBE_DUP_GLA1
        for (int rep = probe_reps(true); rep > 0; --rep)
#endif
        if (F.G == 256) { const int x = F.bx & 7, j = F.bx >> 3; gla_run<1>(F, L, (((x >> 1) * 4 + (j >> 3)) << 4) + 8 * (x & 1) + (j & 7)); }
        else for (int run = F.bx; run < 256; run += F.G) gla_run<1>(F, L, run); }
    seam(lds, pb + 1);
    if (phase_on(pb + 2)) { Frame F = mkframe(lds);
#ifdef PROBE_DUP_GLA2
        for (int rep = probe_reps(true); rep > 0; --rep)
#endif
        if (F.G == 256) { const int x = F.bx & 7, j = F.bx >> 3; gla_run<2>(F, L, (((x >> 1) * 4 + (j >> 3)) << 4) + 8 * (x & 1) + (j & 7)); }
        else for (int run = F.bx; run < 256; run += F.G) gla_run<2>(F, L, run); }
    if (phase_on(pb + 2) && attn_scores_bounded(L)) {
        Frame F = mkframe(lds); unsigned char* const ws = kargs()->ws;
        static_assert(attn_body::L2_BYTES <= RING_BYTES && attn_body::ATTN_LDS_BYTES <= RING_BYTES, "attention LDS");
        const attn_body::StaticOrder128 S(F.G, F.bx);
#ifdef PROBE_DUP_ATTN
        for (int rep = probe_reps(true); rep > 0; --rep)
#endif
        attn_body::attn_phase128((char*)lds + RING_OFF, (const attn_body::bf16*)(ws + WS_Q), (const attn_body::bf16*)(ws + WS_K), (const attn_body::bf16*)(ws + WS_DV), (attn_body::bf16*)(ws + WS_O), S);
    }
    if (phase_on(pb + 2) && !attn_scores_bounded(L)) {
        Frame F = mkframe(lds); unsigned char* const ws = kargs()->ws;
        const attn_body::AttnTensors AT{(const attn_body::bf16*)(ws + WS_Q), (const attn_body::bf16*)(ws + WS_K), (const attn_body::bf16*)(ws + WS_DV), (attn_body::bf16*)(ws + WS_O)};
        const attn_body::StaticOrder S(F.G, F.bx);
        attn_body::attn_phase<attn_body::StaticOrder>((char*)lds + RING_OFF, AT, S);
    }
    seam(lds, pb + 2);
    if (phase_on(pb + 3)) { Frame F = mkframe(lds);
#ifdef PROBE_DUP_DIFF
        for (int rep = probe_reps(true); rep > 0; --rep)
#endif
        diff_rows(F, L); }
    seam_local(lds, pb + 3);
    if (phase_on(pb + 4)) {
        Frame F = mkframe(lds); KArgs A = kargs(); unsigned char* const ws = A->ws;
        pg8::Gemm g{(const bf16*)((const unsigned char*)A->out + OUT_MIX8)  , (const bf16*)(ws + WS_WOUT + (size_t)L * D * D), M, D, D / 2}; pg8::StaticOrder S; S.init(M, D, F.G, F.bx);
        pg8::EpiResid<L == 0> E{A->in[I_X], (bf16*)(ws + WS_RES), (const float*)((const unsigned char*)A->out + OUT_MS), (const float*)(ws + WS_WOCS) + L * D};
#ifdef PROBE_DUP_C2
        for (int rep = probe_reps(L == 0); rep > 0; --rep)
#endif
        pg8::gemm_phase<pg8::EpiResid<L == 0>, pg8::StaticOrder, true, true>(F.lds + RING_OFF, g, S, E);
    }
    seam_local(lds, pb + 4);
    if (phase_on(pb + 5)) { Frame F = mkframe(lds); KArgs A = kargs(); unsigned char* const ws = A->ws;
        unsigned char* XR8 = (unsigned char*)A->out + OUT_MIX8; float* XS = (float*)((unsigned char*)A->out + OUT_MS);
        const int NX = (F.G & 7) == 0 ? 8 : 1, XI = F.bx % NX, RX = M / NX, xw = (F.bx / NX) * NWAVES + F.wave, WX = (F.G / NX) * NWAVES;
        const int mend = RX * (XI + 1), mstep = 4 * WX; int m0 = RX * XI + 4 * xw;
        v4u r[4][2];
#define R8_LOAD(R_, M_) do { _Pragma("unroll") for (int j = 0; j < 4; ++j) { const GAS v4u* rp = (const GAS v4u*)((const bf16*)(ws + WS_RES) + (size_t)((M_) + j) * D + 16 * F.lane); R_[j][0] = rp[0]; R_[j][1] = rp[1]; } } while (0)
        if (m0 < mend) R8_LOAD(r, m0);
        for (; m0 < mend; m0 += mstep) {
            const bool hn = m0 + mstep < mend; v4u rn[4][2];
            if (hn) R8_LOAD(rn, m0 + mstep);
#pragma unroll
            for (int j = 0; j < 4; ++j) { const v4u a0 = r[j][0], a1 = r[j][1]; f32x4 va[4];
                va[0] = (f32x4){bflo(a0.x), bfhi(a0.x), bflo(a0.y), bfhi(a0.y)}; va[1] = (f32x4){bflo(a0.z), bfhi(a0.z), bflo(a0.w), bfhi(a0.w)}; va[2] = (f32x4){bflo(a1.x), bfhi(a1.x), bflo(a1.y), bfhi(a1.y)}; va[3] = (f32x4){bflo(a1.z), bfhi(a1.z), bflo(a1.w), bfhi(a1.w)};
                row_to_i8(F.lane, va, nullptr, XR8 + (size_t)(m0 + j) * D, XS + m0 + j, (float*)(ws + WS_RS) + m0 + j); }
            if (hn) {
#pragma unroll
                for (int j = 0; j < 4; ++j) { r[j][0] = rn[j][0]; r[j][1] = rn[j][1]; } }
        }
#undef R8_LOAD
    }
    seam_local(lds, pb + 5);
    if (phase_on(pb + 6)) {
        Frame F = mkframe(lds); KArgs A = kargs(); unsigned char* const ws = A->ws;
        pg8::Gemm g{(const bf16*)((const unsigned char*)A->out + OUT_MIX8), (const bf16*)(ws + WS_WQ + (size_t)L * 2048 * D), M, 2048, D / 2}; pg8::StaticOrder S; S.init(M, 2048, F.G, F.bx);
        pg8::EpiRowScale E{(bf16*)(ws + WS_Q2), 2048, (const float*)((const unsigned char*)A->out + OUT_MS), (const float*)(ws + WS_WQCS) + L * 2048};
#ifdef PROBE_DUP_D1
        for (int rep = probe_reps(true); rep > 0; --rep)
#endif
        pg8::gemm_phase<pg8::EpiRowScale, pg8::StaticOrder, true, true>(F.lds + RING_OFF, g, S, E);
    }
    seam_local(lds, pb + 6);
    if (phase_on(pb + 7)) { Frame F = mkframe(lds);
#if defined(PROBE_DUP_D2)
        int nrep = 2; asm volatile("" : "+s"(nrep));
        for (int rep = 0; rep < nrep; ++rep)
#endif
        peer_select(F, L);
    }
    seam(lds, pb + 7);
    if (phase_on(pb + 8)) { Frame F = mkframe(lds); peer_sliced<false>(F, L);
#if defined(PROBE_DUP_U)
        peer_sliced<false, true>(F, L);
#endif
    }
    seam(lds, pb + 8);
    if (phase_on(pb + 9)) { Frame F = mkframe(lds);
#ifdef PROBE_DUP_W
        for (int rep = probe_reps(true); rep > 0; --rep)
#endif
        peer_w(F, L); }
    seam(lds, pb + 9);
    if (phase_on(pb + 10)) { Frame F = mkframe(lds);
#if defined(PROBE_DUP_V)
        peer_sliced<true, true, L + 1 == DEPTH>(F, L);
#endif
        peer_sliced<true, false, L + 1 == DEPTH>(F, L); }
    seam(lds, pb + 10);
    if (L + 1 < DEPTH) {
        if (phase_on(pb + 11)) { Frame F = mkframe(lds); KArgs A = kargs(); unsigned char* const ws = A->ws;
            const int NX = (F.G & 7) == 0 ? 8 : 1, XI = F.bx % NX, RX = M / NX, xw = (F.bx / NX) * NWAVES + F.wave, WX = (F.G / NX) * NWAVES;
            const int mend = RX * (XI + 1), mstep = 4 * WX; int m0 = RX * XI + 4 * xw;
            v4u r[4][2];
#define E8_LOAD(R_, M_) do { _Pragma("unroll") for (int j = 0; j < 4; ++j) { const GAS v4u* rp = (const GAS v4u*)((const bf16*)(ws + WS_RES) + (size_t)((M_) + j) * D + 16 * F.lane); R_[j][0] = rp[0]; R_[j][1] = rp[1]; } } while (0)
            if (m0 < mend) E8_LOAD(r, m0);
            for (; m0 < mend; m0 += mstep) {
                const bool hn = m0 + mstep < mend; v4u rn[4][2];
                if (hn) E8_LOAD(rn, m0 + mstep);
#pragma unroll
                for (int j = 0; j < 4; ++j) { const v4u a0 = r[j][0], a1 = r[j][1]; f32x4 va[4];
                    va[0] = (f32x4){bflo(a0.x), bfhi(a0.x), bflo(a0.y), bfhi(a0.y)}; va[1] = (f32x4){bflo(a0.z), bfhi(a0.z), bflo(a0.w), bfhi(a0.w)}; va[2] = (f32x4){bflo(a1.x), bfhi(a1.x), bflo(a1.y), bfhi(a1.y)}; va[3] = (f32x4){bflo(a1.z), bfhi(a1.z), bflo(a1.w), bfhi(a1.w)};
                    row_to_i8(F.lane, va, nullptr, ws + WS_XN8 + (size_t)(m0 + j) * D, (float*)(ws + WS_AS) + m0 + j); }
                if (hn) {
#pragma unroll
                    for (int j = 0; j < 4; ++j) { r[j][0] = rn[j][0]; r[j][1] = rn[j][1]; } }
            }
#undef E8_LOAD
        }
        seam_local(lds, pb + 11);
    }
}

__global__ void __launch_bounds__(NWAVES * 64, 2) mega_fwd(Args args) {
    extern __shared__ __attribute__((aligned(16))) unsigned char lds[];
    (void)args;
    { const int tx = threadIdx.x; for (int u = tx; u < (LDS_BYTES - LDSCTL_OFF) / 4; u += NWAVES * 64) ((LAS unsigned*)((LAS unsigned char*)lds + LDSCTL_OFF))[u] = 0u; }
    __syncthreads();
    { KArgs A = kargs(); if (A->ph_hi - A->ph_lo > 1) (void)xcd_barrier_post((unsigned*)(A->ws + WS_CTL) + CW_BAR, (volatile LAS unsigned*)((LAS unsigned char*)lds + MISC_OFF) + 8); }
    if (phase_on(0)) { Frame F = mkframe(lds);
#ifdef PROBE_DUP_P0
        for (int rep = probe_reps(true); rep > 0; --rep)
#endif
        p0_prologue(F); }
    seam(lds, 0);
    layer_fwd<0>(lds);
    layer_fwd<1>(lds);
}

extern "C" void kernel_launch(void* const* d_in, const int* in_sizes, int n_in, void* d_out, int out_size, void* d_ws, size_t ws_size, hipStream_t stream) {
    static int grid = 0;
    if (grid == 0) {
        if (n_in != 19 || in_sizes[0] != M * D || out_size != M * D || ws_size < WS_END) { fprintf(stderr, "kernel_launch: unexpected shapes (n_in %d, in0 %d, out %d, ws %zu)\n", n_in, n_in > 0 ? in_sizes[0] : -1, out_size, ws_size); grid = -1; return; }
        int dev = 0, cus = 0, per_cu = 0;
        if (hipGetDevice(&dev) != hipSuccess || hipDeviceGetAttribute(&cus, hipDeviceAttributeMultiprocessorCount, dev) != hipSuccess) { grid = -1; return; }
        if (hipFuncSetAttribute((const void*)mega_fwd, hipFuncAttributeMaxDynamicSharedMemorySize, LDS_BYTES) != hipSuccess) { fprintf(stderr, "kernel_launch: hipFuncSetAttribute failed\n"); grid = -1; return; }
        if (hipOccupancyMaxActiveBlocksPerMultiprocessor(&per_cu, (const void*)mega_fwd, NWAVES * 64, LDS_BYTES) != hipSuccess || per_cu < 1) fprintf(stderr, "kernel_launch: occupancy query reports %d\n", per_cu);
        (void)hipGetLastError();
        grid = cus;
    }
    if (grid < 0) return;
    if (hipMemsetAsync((char*)d_ws + WS_CTL, 0, CTL_ZERO_BYTES, stream) != hipSuccess) return;
    Args a{};
    for (int i = 0; i < 19; ++i) a.in[i] = (const float*)d_in[i];
    a.out = (float*)d_out; a.ws = (unsigned char*)d_ws;
#if MK_PER_PHASE
    for (int p = 0; p < NPHASE; ++p) { a.ph_lo = p; a.ph_hi = p + 1; hipLaunchKernelGGL(mega_fwd, dim3(grid), dim3(NWAVES * 64), LDS_BYTES, stream, a); }
#else
    a.ph_lo = 0; a.ph_hi = NPHASE; hipLaunchKernelGGL(mega_fwd, dim3(grid), dim3(NWAVES * 64), LDS_BYTES, stream, a);
#endif
}
```

```cpp
#include <hip/hip_runtime.h>
#include <cstdio>
#include <cstdint>
#include <utility>
namespace pg8 {
#define PG8_LAS __attribute__((address_space(3)))
typedef unsigned short bf16_t;
typedef short bf16x8 __attribute__((ext_vector_type(8)));
typedef float f32x4 __attribute__((ext_vector_type(4)));
typedef unsigned u32x4 __attribute__((ext_vector_type(4)));
__device__ __forceinline__ float xsum16(float v) { auto rr = __builtin_amdgcn_permlane16_swap(__float_as_uint(v), __float_as_uint(v), false, false); return __uint_as_float(rr[0]) + __uint_as_float(rr[1]); }
__device__ __forceinline__ float xsum32(float v) { auto rr = __builtin_amdgcn_permlane32_swap(__float_as_uint(v), __float_as_uint(v), false, false); return __uint_as_float(rr[0]) + __uint_as_float(rr[1]); }
constexpr int BM = 256, BK = 64, HALF = 128, HTB = HALF * BK * 2  , STAGE_BYTES = 8 * HTB, NXCD = 8, WGM = 8;

__host__ __device__ __forceinline__ int lds_byte(int r, int c) { const int st = (r >> 4) * 2 + (c >> 5), rr = r & 15, cc = c & 31, ob = rr * 64 + cc * 2; return st * 1024 + (ob ^ (((ob >> 9) & 1) << 5)); }
__host__ __device__ __forceinline__ void stage_rc(int b, int& R, int& C) { const int st = b / 1024, sb = b % 1024, swz = sb ^ (((sb >> 9) & 1) << 5); R = (st >> 1) * 16 + swz / 64; C = (st & 1) * 32 + (swz % 64) / 2; }
__host__ __device__ __forceinline__ int perm32(int rho) { const int n = rho >> 4, i = rho & 15; return 8 * (i >> 2) + 4 * n + (i & 3); }

typedef int i32x4 __attribute__((ext_vector_type(4)));
template <bool I8> __device__ __forceinline__ f32x4 pg8_mma(bf16x8 b, bf16x8 a, f32x4 c) {
    if constexpr (I8) return __builtin_bit_cast(f32x4, __builtin_amdgcn_mfma_i32_16x16x64_i8(__builtin_bit_cast(i32x4, b), __builtin_bit_cast(i32x4, a), __builtin_bit_cast(i32x4, c), 0, 0, 0));
    else return __builtin_amdgcn_mfma_f32_16x16x32_bf16(b, a, c, 0, 0, 0);
}
struct Unit { int pm, pn; };
struct Gemm { const bf16_t* A; const bf16_t* Bt; int M, N, K; };

struct StaticOrder {
    int nM, nN, nwg, G, c, wgm;
    __host__ __device__ void init(int M, int N, int G_, int c_, int wgm_ = WGM) { nM = M / BM; nN = N / BM; nwg = nM * nN; G = G_; c = c_; wgm = wgm_; }
    __host__ __device__ bool next(int i, Unit& u) const {
#ifdef PROBE_DUP_A1S
        const long L = (long)(nN == 13 ? (i >> 1) : i) * G + c; if (L >= nwg) return false;
#else
        const long L = (long)i * G + c; if (L >= nwg) return false;
#endif
        int wgid = (int)L; { const int q = nwg / NXCD, r = nwg % NXCD, xcd = wgid % NXCD, off = wgid / NXCD; wgid = (xcd < r ? xcd * (q + 1) : r * (q + 1) + (xcd - r) * q) + off; }
        const int nig = wgm * nN, gid = wgid / nig, fm = gid * wgm, gsz = (nM - fm) < wgm ? (nM - fm) : wgm;
        u.pm = fm + ((wgid % nig) % gsz); u.pn = (wgid % nig) / gsz; return true;
    }
    __device__ __forceinline__ void a_ready(const Unit&) const {}
    __device__ __forceinline__ void done(const Unit&) const {}
};

__device__ __forceinline__ unsigned cvt_pk_bf16(float lo, float hi) { unsigned r; asm volatile("v_cvt_pk_bf16_f32 %0, %1, %2" : "=v"(r) : "v"(lo), "v"(hi)); return r; }
constexpr size_t WSO_Q = 160u << 20, WSO_K = 192u << 20, WSO_DV = 224u << 20, WSO_GQ = 256u << 20, WSO_GO = 272u << 20, WSO_GK = 400u << 20, WSO_GV = 416u << 20, WSO_GLOG = 448u << 20;
__device__ __forceinline__ void store8_bf16(bf16_t* p, f32x4 v0, f32x4 v1) { u32x4 w; w.x = cvt_pk_bf16(v0[0], v0[1]); w.y = cvt_pk_bf16(v0[2], v0[3]); w.z = cvt_pk_bf16(v1[0], v1[1]); w.w = cvt_pk_bf16(v1[2], v1[3]); *(u32x4*)p = w; }
__device__ __forceinline__ u32x4 pack8_bf16(f32x4 v0, f32x4 v1) { u32x4 w; w.x = cvt_pk_bf16(v0[0], v0[1]); w.y = cvt_pk_bf16(v0[2], v0[3]); w.z = cvt_pk_bf16(v1[0], v1[1]); w.w = cvt_pk_bf16(v1[2], v1[3]); return w; }
__device__ __forceinline__ void store_pair_rows(bf16_t* rowp, int ld, u32x4 x0, u32x4 x1, bool odd) {
    const u32x4 snd = odd ? x0 : x1; u32x4 rcv;
    rcv.x = (unsigned)__builtin_amdgcn_update_dpp(0, (int)snd.x, 0xB1, 0xF, 0xF, true); rcv.y = (unsigned)__builtin_amdgcn_update_dpp(0, (int)snd.y, 0xB1, 0xF, 0xF, true);
    rcv.z = (unsigned)__builtin_amdgcn_update_dpp(0, (int)snd.z, 0xB1, 0xF, 0xF, true); rcv.w = (unsigned)__builtin_amdgcn_update_dpp(0, (int)snd.w, 0xB1, 0xF, 0xF, true);
    bf16_t* pa = odd ? rowp - ld + 32 : rowp; bf16_t* pb = odd ? rowp + 32 : rowp + ld;
    __builtin_nontemporal_store(odd ? rcv : x0, (u32x4*)pa); __builtin_nontemporal_store(odd ? x1 : rcv, (u32x4*)pb);
}
__device__ __forceinline__ float log_sigmoid_f(float x) { return fminf(x, 0.f) - __logf(1.f + __expf(-fabsf(x))); }
struct EpiPlain {
    static constexpr bool PERM = true, AFTER_DRAIN = false, IDEMPOTENT = true, I8 = false;
    bf16_t* O; int ldc;
    __device__ __forceinline__ void operator()(const f32x4 (&acc)[2][2][4][2], const Unit& u, int wr, int wc, int fr, int fq) const {
        const int row0 = u.pm * BM + wr * 64 + fr, col0 = u.pn * BM + wc * 32 + 8 * fq;
#pragma unroll
        for (int ai = 0; ai < 2; ++ai)
#pragma unroll
            for (int m = 0; m < 4; ++m) { bf16_t* rowp = O + (size_t)(row0 + ai * HALF + m * 16) * ldc + col0;
#pragma unroll
                for (int bj = 0; bj < 2; ++bj) store8_bf16(rowp + bj * HALF, acc[ai][bj][m][0], acc[ai][bj][m][1]); }
    }
};
__host__ __device__ __forceinline__ int inproj_phys_row(int n) { const int cl = n & 255; return (n & ~255) + 128 * ((cl >> 5) & 1) + 32 * (cl >> 6) + (cl & 31); }
struct EpiInProj {
    static constexpr bool PERM = true, AFTER_DRAIN = false, IDEMPOTENT = true, I8 = true;
    unsigned char* ws; const float* gate_b; const float* qn_w; const float* kn_w; float qscale;
    const float* arow; const float* wcol;
#ifdef PROBE_DUP_EPI8
    bool nostore = false;
    __device__ __forceinline__ void store8_bf16(bf16_t* p, f32x4 v0, f32x4 v1) const { if (!nostore) pg8::store8_bf16(p, v0, v1); else asm volatile("" :: "v"(v0[0] + v0[1] + v0[2] + v0[3] + v1[0] + v1[1] + v1[2] + v1[3])); }
#endif
    __device__ __forceinline__ static f32x4 cvt(const f32x4& a) { const i32x4 i = __builtin_bit_cast(i32x4, a); return (f32x4){(float)i[0], (float)i[1], (float)i[2], (float)i[3]}; }
    __device__ __forceinline__ void operator()(const f32x4 (&acc)[2][2][4][2], const Unit& u, int wr, int wc, int fr, int fq) const {
        const int pn = u.pn, row0 = u.pm * BM + wr * 64 + fr, cl = wc * 64 + 8 * fq;
        f32x4 cs[2][2];
#pragma unroll
        for (int bj = 0; bj < 2; ++bj)
#pragma unroll
            for (int n = 0; n < 2; ++n) cs[bj][n] = *(const f32x4*)(wcol + pn * 256 + cl + 32 * bj + 4 * n);
        float rrv[2][4];
#pragma unroll
        for (int ai = 0; ai < 2; ++ai)
#pragma unroll
            for (int m = 0; m < 4; ++m) rrv[ai][m] = arow[row0 + ai * HALF + m * 16];
        asm volatile("" : "+v"(rrv[0][0]), "+v"(rrv[0][1]), "+v"(rrv[0][2]), "+v"(rrv[0][3]), "+v"(rrv[1][0]), "+v"(rrv[1][1]), "+v"(rrv[1][2]), "+v"(rrv[1][3]));
        if (pn == 12) {
            f32x4 bv[2][2];
#pragma unroll
            for (int bj = 0; bj < 2; ++bj)
#pragma unroll
                for (int n = 0; n < 2; ++n) bv[bj][n] = *(const f32x4*)(gate_b + cl + 32 * bj + 4 * n);
#pragma unroll
            for (int ai = 0; ai < 2; ++ai)
#pragma unroll
                for (int m = 0; m < 4; ++m) { const int row = row0 + ai * HALF + m * 16; float* rowp = (float*)(ws + WSO_GLOG) + (size_t)row * 256 + cl; const float rr = rrv[ai][m];
#pragma unroll
                    for (int bj = 0; bj < 2; ++bj)
#pragma unroll
                        for (int n = 0; n < 2; ++n) { const f32x4 v = cvt(acc[ai][bj][m][n]) * (cs[bj][n] * rr) + bv[bj][n]; f32x4 o;
                            o[0] = log_sigmoid_f(v[0]) * 0.0625f; o[1] = log_sigmoid_f(v[1]) * 0.0625f; o[2] = log_sigmoid_f(v[2]) * 0.0625f; o[3] = log_sigmoid_f(v[3]) * 0.0625f;
#ifdef PROBE_DUP_EPI8
                            if (nostore) asm volatile("" :: "v"(o[0] + o[1] + o[2] + o[3])); else
#endif
                            *(f32x4*)(rowp + 32 * bj + 4 * n) = o; } }
            return;
        }
        if (pn < 4) {
            const bool isk = pn >= 2; const float* nw = isk ? kn_w : qn_w; const float sc = isk ? 1.f : qscale;
            f32x4 wv[2][2];
#pragma unroll
            for (int bj = 0; bj < 2; ++bj)
#pragma unroll
                for (int n = 0; n < 2; ++n) wv[bj][n] = *(const f32x4*)(nw + 8 * fq + 32 * bj + 4 * n) * sc;
            bf16_t* base = (bf16_t*)(ws + (isk ? WSO_K : WSO_Q)); const int c0 = (pn & 1) * 256;
#pragma unroll
            for (int ai = 0; ai < 2; ++ai)
#pragma unroll
                for (int m = 0; m < 4; ++m) { const int row = row0 + ai * HALF + m * 16; const float rr = rrv[ai][m];
                    f32x4 x[2][2]; float ss = 0.f;
#pragma unroll
                    for (int bj = 0; bj < 2; ++bj)
#pragma unroll
                        for (int n = 0; n < 2; ++n) { x[bj][n] = cvt(acc[ai][bj][m][n]) * (cs[bj][n] * rr); ss += (x[bj][n][0] * x[bj][n][0] + x[bj][n][1] * x[bj][n][1]) + (x[bj][n][2] * x[bj][n][2] + x[bj][n][3] * x[bj][n][3]); }
                    ss = xsum32(xsum16(ss));
                    const float rs = __builtin_amdgcn_rsqf(ss * (1.f / 64.f) + 1e-6f);
                    bf16_t* rowp = base + (size_t)row * 512 + c0 + cl;
                    store_pair_rows(rowp, 512, pack8_bf16(x[0][0] * rs * wv[0][0], x[0][1] * rs * wv[0][1]), pack8_bf16(x[1][0] * rs * wv[1][0], x[1][1] * rs * wv[1][1]), fr & 1);
                }
            return;
        }
        size_t bo; int ldc, c0;
        if (pn < 6) { bo = WSO_DV; ldc = 512; c0 = (pn - 4) * 256; }
        else if (pn == 6) { bo = WSO_GQ; ldc = 256; c0 = 0; }
        else if (pn == 7) { bo = WSO_GK; ldc = 256; c0 = 0; }
        else if (pn < 10) { bo = WSO_GV; ldc = 512; c0 = (pn - 8) * 256; }
        else { bo = WSO_GO; ldc = 512; c0 = (pn - 10) * 256; }
        bf16_t* base = (bf16_t*)(ws + bo);
#pragma unroll
        for (int ai = 0; ai < 2; ++ai)
#pragma unroll
            for (int m = 0; m < 4; ++m) { const int row = row0 + ai * HALF + m * 16; bf16_t* rowp = base + (size_t)row * ldc + c0 + cl; const float rr = rrv[ai][m];
                store_pair_rows(rowp, ldc, pack8_bf16(cvt(acc[ai][0][m][0]) * (cs[0][0] * rr), cvt(acc[ai][0][m][1]) * (cs[0][1] * rr)), pack8_bf16(cvt(acc[ai][1][m][0]) * (cs[1][0] * rr), cvt(acc[ai][1][m][1]) * (cs[1][1] * rr)), fr & 1); }
    }
};
template <bool FIRST> struct EpiResid {
    static constexpr bool PERM = true, AFTER_DRAIN = false, IDEMPOTENT = FIRST, I8 = true;
    const float* x; bf16_t* res; const float* arow; const float* wcol;
    __device__ __forceinline__ static f32x4 cvt(const f32x4& a) { const i32x4 i = __builtin_bit_cast(i32x4, a); return (f32x4){(float)i[0], (float)i[1], (float)i[2], (float)i[3]}; }
    __device__ __forceinline__ void operator()(const f32x4 (&acc)[2][2][4][2], const Unit& u, int wr, int wc, int fr, int fq) const {
        const int row0 = u.pm * BM + wr * 64 + fr, col0 = u.pn * BM + wc * 32 + 8 * fq;
        f32x4 cs[2][2];
#pragma unroll
        for (int bj = 0; bj < 2; ++bj)
#pragma unroll
            for (int n = 0; n < 2; ++n) cs[bj][n] = *(const f32x4*)(wcol + col0 + bj * HALF + 4 * n);
        float rrv[2][4];
#pragma unroll
        for (int ai = 0; ai < 2; ++ai)
#pragma unroll
            for (int m = 0; m < 4; ++m) rrv[ai][m] = arow[row0 + ai * HALF + m * 16];
        asm volatile("" : "+v"(rrv[0][0]), "+v"(rrv[0][1]), "+v"(rrv[0][2]), "+v"(rrv[0][3]), "+v"(rrv[1][0]), "+v"(rrv[1][1]), "+v"(rrv[1][2]), "+v"(rrv[1][3]));
#pragma unroll
        for (int ai = 0; ai < 2; ++ai)
#pragma unroll
            for (int m = 0; m < 4; ++m) { const int row = row0 + ai * HALF + m * 16; const size_t off = (size_t)row * 1024 + col0; const float rr = rrv[ai][m];
#pragma unroll
                for (int bj = 0; bj < 2; ++bj) { f32x4 r0, r1;
                    if (FIRST) { r0 = *(const f32x4*)(x + off + bj * HALF); r1 = *(const f32x4*)(x + off + bj * HALF + 4); }
                    else { const u32x4 w = *(const u32x4*)(res + off + bj * HALF);
                        r0 = (f32x4){__builtin_bit_cast(float, w.x << 16), __builtin_bit_cast(float, w.x & 0xffff0000u), __builtin_bit_cast(float, w.y << 16), __builtin_bit_cast(float, w.y & 0xffff0000u)};
                        r1 = (f32x4){__builtin_bit_cast(float, w.z << 16), __builtin_bit_cast(float, w.z & 0xffff0000u), __builtin_bit_cast(float, w.w << 16), __builtin_bit_cast(float, w.w & 0xffff0000u)}; }
                    r0 = r0 + cvt(acc[ai][bj][m][0]) * (cs[bj][0] * rr); r1 = r1 + cvt(acc[ai][bj][m][1]) * (cs[bj][1] * rr);
                    store8_bf16(res + off + bj * HALF, r0, r1); }
            }
    }
};
struct EpiRowScale {
    static constexpr bool PERM = true, AFTER_DRAIN = false, IDEMPOTENT = true, I8 = true;
    bf16_t* O; int ldc; const float* arow; const float* wcol;
    __device__ __forceinline__ static f32x4 cvt(const f32x4& a) { const i32x4 i = __builtin_bit_cast(i32x4, a); return (f32x4){(float)i[0], (float)i[1], (float)i[2], (float)i[3]}; }
    __device__ __forceinline__ void operator()(const f32x4 (&acc)[2][2][4][2], const Unit& u, int wr, int wc, int fr, int fq) const {
        const int row0 = u.pm * BM + wr * 64 + fr, col0 = u.pn * BM + wc * 32 + 8 * fq;
        f32x4 cs[2][2];
#pragma unroll
        for (int bj = 0; bj < 2; ++bj)
#pragma unroll
            for (int n = 0; n < 2; ++n) cs[bj][n] = *(const f32x4*)(wcol + col0 + bj * HALF + 4 * n);
        float rrv[2][4];
#pragma unroll
        for (int ai = 0; ai < 2; ++ai)
#pragma unroll
            for (int m = 0; m < 4; ++m) rrv[ai][m] = arow[row0 + ai * HALF + m * 16];
        asm volatile("" : "+v"(rrv[0][0]), "+v"(rrv[0][1]), "+v"(rrv[0][2]), "+v"(rrv[0][3]), "+v"(rrv[1][0]), "+v"(rrv[1][1]), "+v"(rrv[1][2]), "+v"(rrv[1][3]));
#pragma unroll
        for (int ai = 0; ai < 2; ++ai)
#pragma unroll
            for (int m = 0; m < 4; ++m) { const int row = row0 + ai * HALF + m * 16; const float rr = rrv[ai][m];
                bf16_t* rowp = O + (size_t)row * ldc + col0;
#pragma unroll
                for (int bj = 0; bj < 2; ++bj) store8_bf16(rowp + bj * HALF, cvt(acc[ai][bj][m][0]) * (cs[bj][0] * rr), cvt(acc[ai][bj][m][1]) * (cs[bj][1] * rr)); }
    }
};
template <class Epi, class Sched, bool ALIGN_EPI = false, bool SP2 = false>
__device__ __forceinline__ void gemm_phase(PG8_LAS unsigned char* lds, const Gemm g, const Sched& S, const Epi& E) {
    const int tid = threadIdx.x, wid = __builtin_amdgcn_readfirstlane(tid >> 6), lane = tid & 63, wr = wid >> 2, wc = wid & 3, fr = lane & 15, fq = lane >> 4;
    const int K = g.K, nt = K / BK;
    unsigned voffA[2], voffB[2];
#pragma unroll
    for (int i = 0; i < 2; ++i) { int R, C; stage_rc(tid * 16 + i * 8192, R, C); const int Rb = Epi::PERM ? ((R & ~31) + perm32(R & 31)) : R;
        voffA[i] = (unsigned)(R * K + C) * 2u; voffB[i] = (unsigned)(Rb * K + C) * 2u; }
    const size_t kstep = (size_t)(BK * 2);
    const size_t hstep = (size_t)HALF * K * 2;
    const size_t tstep = 2 * hstep;
    const unsigned ldsw = (unsigned)wid * 1024u;
    const int aoff = lds_byte(wr * 64 + fr, fq * 8), boff = lds_byte(wc * 32 + fr, fq * 8);
#define PG8_SA(b, h) (((b) * 2 + (h)) * HTB)
#define PG8_SB(b, h) ((4 + (b) * 2 + (h)) * HTB)
#define PG8_STAGE(bufoff, gbase, voff) do { _Pragma("unroll") for (int _i = 0; _i < 2; ++_i) \
        __builtin_amdgcn_global_load_lds((const unsigned*)((const char*)(gbase) + (voff)[_i]), (PG8_LAS unsigned*)(lds + (bufoff) + ldsw + _i * 8192), 16, 0, 0); } while (0)
#define PG8_LDA(dst, b, h) do { _Pragma("unroll") for (int m = 0; m < 4; ++m) _Pragma("unroll") for (int k = 0; k < 2; ++k) dst[m][k] = *(const PG8_LAS bf16x8*)(lds + PG8_SA(b, h) + aoff + m * 2048 + k * 1024); } while (0)
#define PG8_LDB(dst, b, h) do { _Pragma("unroll") for (int n = 0; n < 2; ++n) _Pragma("unroll") for (int k = 0; k < 2; ++k) dst[n][k] = *(const PG8_LAS bf16x8*)(lds + PG8_SB(b, h) + boff + n * 2048 + k * 1024); } while (0)
#define PG8_MMA(ai, bj, At, Bt) do { __builtin_amdgcn_s_setprio(1); _Pragma("unroll") for (int k = 0; k < 2; ++k) _Pragma("unroll") for (int m = 0; m < 4; ++m) _Pragma("unroll") for (int n = 0; n < 2; ++n)   \
        acc[ai][bj][m][n] = pg8_mma<Epi::I8>(Bt[n][k], At[m][k], acc[ai][bj][m][n]); __builtin_amdgcn_s_setprio(0); } while (0)
#define PG8_WAIT_V(n) asm volatile("s_waitcnt vmcnt(" #n ")" ::: "memory")
#define PG8_WAIT_L(n) asm volatile("s_waitcnt lgkmcnt(" #n ")" ::: "memory")
#define PG8_BAR __builtin_amdgcn_s_barrier()
#define PG8_SCHED __builtin_amdgcn_sched_barrier(0)
    Unit cur, nxt; int ui = 0;
    if (!S.next(0, cur)) return;
    f32x4 acc[2][2][4][2];
#pragma unroll
    for (int a = 0; a < 2; ++a)
#pragma unroll
        for (int b = 0; b < 2; ++b)
#pragma unroll
            for (int m = 0; m < 4; ++m)
#pragma unroll
                for (int n = 0; n < 2; ++n) acc[a][b][m][n] = (f32x4){0.f, 0.f, 0.f, 0.f};
    bf16x8 At[4][2], B0[2][2], B1[2][2];
    const char* cA = (const char*)g.A + (size_t)cur.pm * tstep; const char* cB = (const char*)g.Bt + (size_t)cur.pn * tstep;
    S.a_ready(cur);
    if constexpr (SP2) {
        PG8_STAGE(PG8_SB(0, 0), cB, voffB); PG8_STAGE(PG8_SB(0, 1), cB + hstep, voffB); PG8_STAGE(PG8_SA(0, 0), cA, voffA); PG8_STAGE(PG8_SA(0, 1), cA + hstep, voffA);
        if (wr == 1) PG8_BAR;
        PG8_WAIT_V(2); PG8_BAR;
        PG8_STAGE(PG8_SB(1, 0), cB + kstep, voffB); PG8_STAGE(PG8_SA(1, 0), cA + kstep, voffA); PG8_STAGE(PG8_SB(1, 1), cB + hstep + kstep, voffB);
        PG8_WAIT_V(6); PG8_BAR;
    } else {
        PG8_STAGE(PG8_SB(0, 0), cB, voffB); PG8_STAGE(PG8_SA(0, 0), cA, voffA); PG8_STAGE(PG8_SB(0, 1), cB + hstep, voffB); PG8_STAGE(PG8_SA(0, 1), cA + hstep, voffA);
        if (wr == 1) PG8_BAR;
        PG8_WAIT_V(4); PG8_BAR;
        PG8_STAGE(PG8_SB(1, 0), cB + kstep, voffB); PG8_STAGE(PG8_SA(1, 0), cA + kstep, voffA); PG8_STAGE(PG8_SB(1, 1), cB + hstep + kstep, voffB);
        PG8_WAIT_V(6); PG8_BAR;
    }
    for (;;) {
        const bool has_next = S.next(ui + 1, nxt);
        const char* nA = has_next ? (const char*)g.A + (size_t)nxt.pm * tstep : cA; const char* nB = has_next ? (const char*)g.Bt + (size_t)nxt.pn * tstep : cB;
        for (int t = 0; t < nt; t += 2) {
            const bool last = (t == nt - 2);
            const char* a1 = cA + (size_t)(t + 1) * kstep;
            const char* a2 = last ? nA : cA + (size_t)(t + 2) * kstep; const char* b2 = last ? nB : cB + (size_t)(t + 2) * kstep;
            const char* a3 = a2 + kstep; const char* b3 = b2 + kstep;
            if (last && has_next) S.a_ready(nxt);
            if constexpr (SP2) {
            PG8_LDB(B0, 0, 0); PG8_LDB(B1, 0, 1); PG8_SCHED; PG8_LDA(At, 0, 0); PG8_STAGE(PG8_SA(1, 1), a1 + hstep, voffA);
            PG8_WAIT_V(8); PG8_WAIT_L(0); PG8_BAR; PG8_MMA(0, 0, At, B0); PG8_MMA(0, 1, At, B1); PG8_BAR; PG8_SCHED;
            PG8_LDA(At, 0, 1); PG8_STAGE(PG8_SB(0, 0), b2, voffB); PG8_STAGE(PG8_SB(0, 1), b2 + hstep, voffB); PG8_STAGE(PG8_SA(0, 0), a2, voffA);
            PG8_WAIT_V(8); PG8_WAIT_L(0); PG8_BAR; PG8_MMA(1, 0, At, B0); PG8_MMA(1, 1, At, B1); PG8_BAR; PG8_SCHED;
            PG8_LDB(B0, 1, 0); PG8_LDB(B1, 1, 1); PG8_SCHED; PG8_LDA(At, 1, 0); PG8_STAGE(PG8_SA(0, 1), a2 + hstep, voffA);
            PG8_WAIT_V(8); PG8_WAIT_L(0); PG8_BAR; PG8_MMA(0, 0, At, B0); PG8_MMA(0, 1, At, B1); PG8_BAR; PG8_SCHED;
            PG8_LDA(At, 1, 1); PG8_STAGE(PG8_SB(1, 0), b3, voffB); PG8_STAGE(PG8_SB(1, 1), b3 + hstep, voffB); PG8_STAGE(PG8_SA(1, 0), a3, voffA);
            PG8_WAIT_V(8); PG8_WAIT_L(0); PG8_BAR; PG8_MMA(1, 0, At, B0); PG8_MMA(1, 1, At, B1); PG8_BAR; PG8_SCHED;
            } else {
            PG8_LDB(B0, 0, 0); PG8_SCHED; PG8_LDA(At, 0, 0); PG8_STAGE(PG8_SA(1, 1), a1 + hstep, voffA);
            PG8_WAIT_L(8); PG8_BAR; PG8_WAIT_L(0); PG8_MMA(0, 0, At, B0); PG8_BAR; PG8_SCHED;
            PG8_LDB(B1, 0, 1); PG8_STAGE(PG8_SB(0, 0), b2, voffB);
            PG8_BAR; PG8_WAIT_L(0); PG8_MMA(0, 1, At, B1); PG8_BAR;
            PG8_LDA(At, 0, 1); PG8_STAGE(PG8_SA(0, 0), a2, voffA);
            PG8_BAR; PG8_WAIT_L(0); PG8_MMA(1, 0, At, B0); PG8_BAR; PG8_SCHED;
            PG8_STAGE(PG8_SB(0, 1), b2 + hstep, voffB);
            PG8_WAIT_V(6); PG8_BAR; PG8_MMA(1, 1, At, B1); PG8_BAR;
            PG8_LDB(B0, 1, 0); PG8_SCHED; PG8_LDA(At, 1, 0); PG8_STAGE(PG8_SA(0, 1), a2 + hstep, voffA);
            PG8_WAIT_L(8); PG8_BAR; PG8_WAIT_L(0); PG8_MMA(0, 0, At, B0); PG8_BAR; PG8_SCHED;
            PG8_LDB(B1, 1, 1); PG8_STAGE(PG8_SB(1, 0), b3, voffB);
            PG8_BAR; PG8_WAIT_L(0); PG8_MMA(0, 1, At, B1); PG8_BAR;
            PG8_LDA(At, 1, 1); PG8_STAGE(PG8_SA(1, 0), a3, voffA);
            PG8_BAR; PG8_WAIT_L(0); PG8_MMA(1, 0, At, B0); PG8_BAR; PG8_SCHED;
            PG8_STAGE(PG8_SB(1, 1), b3 + hstep, voffB);
            PG8_WAIT_V(6); PG8_BAR; PG8_MMA(1, 1, At, B1); PG8_BAR;
            }
        }
        if constexpr (ALIGN_EPI) { if (wr == 0) PG8_BAR; }
        if constexpr (!Epi::AFTER_DRAIN) { E(acc, cur, wr, wc, fr, fq);
#ifdef PROBE_DUP_EPI
            if constexpr (Epi::IDEMPOTENT) { asm volatile("" ::: "memory"); E(acc, cur, wr, wc, fr, fq); }
#endif
#ifdef PROBE_DUP_EPI8
            if constexpr (Epi::IDEMPOTENT && Epi::I8) { asm volatile("" ::: "memory"); Epi E2 = E;
#ifdef PROBE_NOSTORE
                E2.nostore = true;
#endif
                E2(acc, cur, wr, wc, fr, fq); }
#endif
            S.done(cur); }
        if (!has_next) break;
#pragma unroll
        for (int a = 0; a < 2; ++a)
#pragma unroll
            for (int b = 0; b < 2; ++b)
#pragma unroll
                for (int m = 0; m < 4; ++m)
#pragma unroll
                    for (int n = 0; n < 2; ++n) acc[a][b][m][n] = (f32x4){0.f, 0.f, 0.f, 0.f};
        cur = nxt; cA = nA; cB = nB; ++ui;
        if constexpr (ALIGN_EPI) { if (wr == 1) PG8_BAR; }
    }
    PG8_WAIT_V(0);
    if constexpr (!ALIGN_EPI) { if (wr == 0) PG8_BAR; }
    PG8_BAR;
    if constexpr (Epi::AFTER_DRAIN) { E.fused(acc, cur, wr, wc, fr, fq, lds, wid, lane); S.done(cur); }
#undef PG8_SA
#undef PG8_SB
#undef PG8_STAGE
#undef PG8_LDA
#undef PG8_LDB
#undef PG8_MMA
#undef PG8_WAIT_V
#undef PG8_WAIT_L
#undef PG8_BAR
#undef PG8_SCHED
}
}

#include <hip/hip_bf16.h>
#include <cmath>
namespace attn_body {
using bf16=__hip_bfloat16;
using bf16x8=__attribute__((ext_vector_type(8)))short;
using s16x4=__attribute__((ext_vector_type(4)))short;
using f32x16=__attribute__((ext_vector_type(16)))float;
using u32x4=__attribute__((ext_vector_type(4)))unsigned;
constexpr int BATCH=4,NHEAD=16,SEQ=8192,D=64,DM=NHEAD*D;
constexpr int QP=512,KP=512,VP=512,OP=1024;
constexpr int NW=8,QBLK=32,QB=QBLK*NW,KVBLK=64,NQB=SEQ/QB;
constexpr int ATTN_PITCH=DM, ATTN_UNIT_ROWS=QB;
__device__ __forceinline__ int crow(int r,int hi){return (r&3)+8*(r>>2)+4*hi;}
#define SBAR() __builtin_amdgcn_sched_barrier(0)
__device__ __forceinline__ void cmask(f32x16&p0,f32x16&p1,int jb,int qrel,int hi){
  const float NEG=-INFINITY; int kb=64*jb+4*hi;
  #pragma unroll
  for(int r=0;r<16;++r){int kv=kb+(r&3)+8*(r>>2); if(kv>qrel)p0[r]=NEG; if(kv+32>qrel)p1[r]=NEG;}
}

constexpr int NSLOT=3, SLOTB=8192;
constexpr int LDS_K=0, LDS_V=NSLOT*SLOTB, LDS_WS=2*NSLOT*SLOTB, LDS_OST=LDS_WS+NW*64*4, LDS_BYTES=LDS_OST+NW*4096;
constexpr float C2=0.125f*1.4426950408889634f;
__device__ __forceinline__ void glds16(const void*gsrc,unsigned lds_dst){unsigned keep;
  asm volatile("s_mov_b32 %0, m0\n\ts_mov_b32 m0, %2\n\ts_nop 0\n\tglobal_load_lds_dwordx4 %1, off\n\ts_mov_b32 m0, %0":"=&s"(keep):"v"(gsrc),"s"(lds_dst):"memory");}
__device__ __forceinline__ float max3f(float a,float b,float c){float r;asm("v_max3_f32 %0, %1, %2, %3":"=v"(r):"v"(a),"v"(b),"v"(c));return r;}
__device__ __forceinline__ float max2f(float a,float b){float r;asm("v_max_f32_e32 %0, %1, %2":"=v"(r):"v"(a),"v"(b));return r;}
__device__ __forceinline__ float fadd_s(float a,float b){float r;asm("v_add_f32_e32 %0, %1, %2":"=v"(r):"v"(a),"v"(b));return r;}
__device__ __forceinline__ float fsub_s(float a,float b){float r;asm("v_sub_f32_e32 %0, %1, %2":"=v"(r):"v"(a),"v"(b));return r;}
typedef float f32x2_t __attribute__((ext_vector_type(2))); typedef __bf16 bf16x2_t __attribute__((ext_vector_type(2)));
__device__ __forceinline__ unsigned cvtpk_s(float lo,float hi){f32x2_t v={lo,hi};bf16x2_t b=__builtin_convertvector(v,bf16x2_t);return __builtin_bit_cast(unsigned,b);}
#define WAIT_BAR(N) asm volatile("s_waitcnt vmcnt(" #N ") lgkmcnt(0)\n\ts_barrier":::"memory")

__device__ __forceinline__ void qkt(f32x16&p0,f32x16&p1,const char*Kslot,const bf16x8*qr,const f32x16&negm,int r32,int hi){
  const char*kb=Kslot+hi*1024+r32*16;
  #pragma unroll
  for(int d0=0;d0<4;++d0){
    const bf16x8 b0=*reinterpret_cast<const bf16x8*>(kb+d0*2048);
    const bf16x8 b1=*reinterpret_cast<const bf16x8*>(kb+d0*2048+512);
    if(d0==0){p0=__builtin_amdgcn_mfma_f32_32x32x16_bf16(b0,qr[0],negm,0,0,0);p1=__builtin_amdgcn_mfma_f32_32x32x16_bf16(b1,qr[0],negm,0,0,0);}
    else{p0=__builtin_amdgcn_mfma_f32_32x32x16_bf16(b0,qr[d0],p0,0,0,0);p1=__builtin_amdgcn_mfma_f32_32x32x16_bf16(b1,qr[d0],p1,0,0,0);}}
}
typedef __attribute__((address_space(3))) const char* lds_cptr;
typedef short v4i16_t __attribute__((ext_vector_type(4)));
__device__ __forceinline__ void kload8(bf16x8*kf,lds_cptr kp){
  kf[0]=*(const __attribute__((address_space(3))) bf16x8*)(kp);      kf[1]=*(const __attribute__((address_space(3))) bf16x8*)(kp+512);
  kf[2]=*(const __attribute__((address_space(3))) bf16x8*)(kp+2048); kf[3]=*(const __attribute__((address_space(3))) bf16x8*)(kp+2560);
  kf[4]=*(const __attribute__((address_space(3))) bf16x8*)(kp+4096); kf[5]=*(const __attribute__((address_space(3))) bf16x8*)(kp+4608);
  kf[6]=*(const __attribute__((address_space(3))) bf16x8*)(kp+6144); kf[7]=*(const __attribute__((address_space(3))) bf16x8*)(kp+6656);
}
__device__ __forceinline__ void kload2(bf16x8*kf,lds_cptr kp,int j){ kf[2*j]=*(const __attribute__((address_space(3))) bf16x8*)(kp+j*2048); kf[2*j+1]=*(const __attribute__((address_space(3))) bf16x8*)(kp+j*2048+512); }
__device__ __forceinline__ s16x4 vtr(lds_cptr p){ return __builtin_bit_cast(s16x4,__builtin_amdgcn_ds_read_tr16_b64_v4i16((__attribute__((address_space(3))) v4i16_t*)p)); }
__device__ __forceinline__ float rowmax(const f32x16&p0,const f32x16&p1){
  float a=max3f(p0[0],p0[1],p1[0]),b=max3f(p0[2],p0[3],p1[1]);a=max3f(a,p1[2],p1[3]);
  #pragma unroll
  for(int r=4;r<16;r+=4){a=max3f(a,p0[r],p0[r+1]);b=max3f(b,p0[r+2],p0[r+3]);a=max3f(a,p1[r],p1[r+1]);b=max3f(b,p1[r+2],p1[r+3]);}
  const float m=max2f(a,b);
  auto rr=__builtin_amdgcn_permlane32_swap(__float_as_uint(m),__float_as_uint(m),false,false);
  return max2f(__uint_as_float(rr[0]),__uint_as_float(rr[1]));
}
__device__ __forceinline__ void pv(f32x16*o,int vb,bf16x8 pa0,bf16x8 pa1,bf16x8 pa2,bf16x8 pa3){
  #pragma unroll
  for(int d0=0;d0<2;++d0){s16x4 lo[4],hi[4];
    #pragma unroll
    for(int ks=0;ks<4;++ks){
      asm volatile("ds_read_b64_tr_b16 %0,%1 offset:%c2":"=&v"(lo[ks]):"v"(vb),"i"(d0*4096+ks*1024):"memory");
      asm volatile("ds_read_b64_tr_b16 %0,%1 offset:%c2":"=&v"(hi[ks]):"v"(vb),"i"(d0*4096+ks*1024+512):"memory");}
    asm volatile("s_waitcnt lgkmcnt(0)":::"memory");SBAR();
    #define PK(k) (bf16x8){lo[k][0],lo[k][1],lo[k][2],lo[k][3],hi[k][0],hi[k][1],hi[k][2],hi[k][3]}
    o[d0]=__builtin_amdgcn_mfma_f32_32x32x16_bf16(pa0,PK(0),o[d0],0,0,0);
    o[d0]=__builtin_amdgcn_mfma_f32_32x32x16_bf16(pa1,PK(1),o[d0],0,0,0);
    o[d0]=__builtin_amdgcn_mfma_f32_32x32x16_bf16(pa2,PK(2),o[d0],0,0,0);
    o[d0]=__builtin_amdgcn_mfma_f32_32x32x16_bf16(pa3,PK(3),o[d0],0,0,0);
    #undef PK
  }
}

#ifndef ATTN_STORE16
#define ATTN_STORE16(p,v) (*(u32x4*)(p)=(v))
#endif
template<int THRL> __device__ __forceinline__ void attn_unit(int b,int h,int qb,const bf16*Q,const bf16*__restrict__ K,const bf16*__restrict__ V,bf16*O,char*shm){
  const int tid=threadIdx.x,lane=tid&63,r32=lane&31,hi=lane>>5; const int wid=__builtin_amdgcn_readfirstlane(tid>>6);
  const long rowbase=(long)b*SEQ; const int q0=qb*QB;
  const bf16*Qw=Q+(rowbase+q0+wid*QBLK)*QP+(h>>1)*D;
  const bf16*Kh=K+rowbase*KP+(h>>1)*D,*Vh=V+rowbase*VP+(h>>2)*128+(h&1)*D;
  const unsigned lds0=(unsigned)(uintptr_t)shm;
  float*wsf=(float*)(shm+LDS_WS)+wid*64;
  const bf16*ksrc=Kh+(long)lane*KP+wid*8;
  const bf16*vsrc=Vh+(long)(16*(wid&3)+(lane>>2))*VP+(wid>>2)*32+(lane&3)*8;
  const unsigned kdst=lds0+LDS_K+wid*1024, vdst=lds0+LDS_V+wid*1024;
  #define DMA_K(t,slot) glds16(ksrc+(long)(t)*KVBLK*KP,(unsigned)__builtin_amdgcn_readfirstlane(kdst+(slot)))
  #define DMA_V(t,slot) glds16(vsrc+(long)(t)*KVBLK*VP,(unsigned)__builtin_amdgcn_readfirstlane(vdst+(slot)))
  const int vb0=(int)(lds0+LDS_V)+((lane>>4)&1)*32+(lane&3)*8+(4*hi+((lane&15)>>2))*64;
  const char*Kbase=shm+LDS_K; bf16x8 kf[8];
  const lds_cptr shm3=(lds_cptr)shm; const lds_cptr kp0=shm3+LDS_K+hi*1024+r32*16; const lds_cptr vp0=shm3+LDS_V+((lane>>4)&1)*32+(lane&3)*8+(4*hi+((lane&15)>>2))*64;
  const int NT=(q0+QB)/KVBLK;
  DMA_K(0,0);DMA_V(0,0);DMA_K(1,SLOTB);
  bf16x8 qr[4];
  #pragma unroll
  for(int d0=0;d0<4;++d0)qr[d0]=*reinterpret_cast<const bf16x8*>(&Qw[(long)r32*QP+d0*16+hi*8]);
  float mhat=0.f,l_reg=0.f;f32x16 o[2];o[0]=f32x16{};o[1]=f32x16{};f32x16 negm=f32x16{};asm volatile("":"+v"(negm));
  const int qrel=wid*QBLK+r32;
  #define CMASK(P0,P1,t) do{int jb_=(t)-(NT-4); if(jb_>=0)cmask(P0,P1,jb_,qrel,hi);}while(0)
  bool resc=false;
  #define START(P0,P1) do{ const float rm=rowmax(P0,P1); resc=false; \
    { const float dl=rm; mhat=fadd_s(mhat,dl); \
      _Pragma("unroll") for(int r=0;r<16;++r){P0[r]=fsub_s(P0[r],dl);P1[r]=fsub_s(P1[r],dl);} \
      _Pragma("unroll") for(int r=0;r<16;++r)negm[r]=-mhat; asm volatile("":"+v"(negm)); } \
    _Pragma("unroll") for(int r=0;r<16;++r)P0[r]=__builtin_amdgcn_exp2f(P0[r]); }while(0)
  #define RESC() do{ if(resc){ asm volatile("s_waitcnt lgkmcnt(0)":::"memory"); \
      _Pragma("unroll") for(int d_=0;d_<2;++d_) _Pragma("unroll") for(int r=0;r<16;++r)o[d_][r]*=wsf[crow(r,hi)]; } }while(0)
  f32x16 pA0,pA1,pB0,pB1;
  int sl_prev=0,sl_cur=0,sl_next=SLOTB;
  #define ROT() do{sl_prev=sl_cur;sl_cur=sl_next;sl_next=(sl_next==(NSLOT-1)*SLOTB)?0:sl_next+SLOTB;}while(0)
  DMA_K(2,2*SLOTB);
  WAIT_BAR(3);
  qkt(pA0,pA1,Kbase,qr,negm,r32,hi);asm volatile("s_nop 15\n\ts_nop 7":"+v"(pA0),"+v"(pA1));CMASK(pA0,pA1,0);
  START(pA0,pA1);
  _Pragma("unroll") for(int r=0;r<16;++r)pA1[r]=__builtin_amdgcn_exp2f(pA1[r]);
  WAIT_BAR(0);
  DMA_K(3,0);DMA_V(1,SLOTB);
  ROT();
  kload8(kf,kp0+sl_cur);
  WAIT_BAR(2);
  s16x4 vlo[8],vhi[8]; u32x4 pw0,pw1,pw2,pw3;
  #define PKW(P,B) cvtpk_s(P[B],P[B+1])
  #define PAF(k) __builtin_bit_cast(bf16x8,pw##k)
  #define VFR(i) (bf16x8){vlo[i][0],vlo[i][1],vlo[i][2],vlo[i][3],vhi[i][0],vhi[i][1],vhi[i][2],vhi[i][3]}
  #define PIN(x) asm volatile("":"+v"(x))
  #define MX3(a,b,c) __builtin_fmaxf(__builtin_fmaxf((a),(b)),(c))
  #define GAPA(MF,A0,A1,A2,A3,W0,W1,PW) do{ MF; sacc+=A0; sacc+=A1; sacc+=A2; sacc+=A3; PIN(sacc); W0; W1; PIN(PW); SBAR(); }while(0)
  #define EX(v) __builtin_amdgcn_exp2f(v)
  #define GAPB(MF,X,B) do{ MF; X[B]=EX(X[B]); X[B+1]=EX(X[B+1]); X[B+2]=EX(X[B+2]); X[B+3]=EX(X[B+3]); PIN(X); SBAR(); }while(0)
  #define VRD(i) do{ vlo[i]=vtr(vp_+(((i)>>2)*4096+((i)&3)*1024)); vhi[i]=vtr(vp_+(((i)>>2)*4096+((i)&3)*1024+512)); }while(0)
  #define KRD(G,j) do{ if(G){ kload2(kf,kp0+sl_next,j); SBAR(); } }while(0)
  #define STEP(C0,C1,P0,P1,t,GK,GV,GL) do{ SBAR(); \
    const lds_cptr vp_=vp0+sl_prev; \
    VRD(0); SBAR(); float sacc=(P0[0]+P0[1]); \
    GAPA(C0=__builtin_amdgcn_mfma_f32_32x32x16_bf16(kf[0],qr[0],negm,0,0,0), P0[2],P0[3],P0[4],P0[5],     pw0[0]=PKW(P0,0), pw0[1]=PKW(P0,2), pw0); \
    VRD(4); SBAR(); GAPA(C1=__builtin_amdgcn_mfma_f32_32x32x16_bf16(kf[1],qr[0],negm,0,0,0), P0[6],P0[7],P0[8],P0[9],     pw0[2]=PKW(P0,4), pw0[3]=PKW(P0,6), pw0); \
    VRD(1); SBAR(); GAPA(C0=__builtin_amdgcn_mfma_f32_32x32x16_bf16(kf[2],qr[1],C0,0,0,0),   P0[10],P0[11],P0[12],P0[13], pw1[0]=PKW(P0,8), pw1[1]=PKW(P0,10), pw1); \
    VRD(5); SBAR(); GAPA(C1=__builtin_amdgcn_mfma_f32_32x32x16_bf16(kf[3],qr[1],C1,0,0,0),   P0[14],P0[15],P1[0],P1[1],   pw1[2]=PKW(P0,12),pw1[3]=PKW(P0,14), pw1); \
    VRD(2); SBAR(); GAPA(C0=__builtin_amdgcn_mfma_f32_32x32x16_bf16(kf[4],qr[2],C0,0,0,0),   P1[2],P1[3],P1[4],P1[5],     pw2[0]=PKW(P1,0), pw2[1]=PKW(P1,2), pw2); \
    VRD(6); SBAR(); GAPA(C1=__builtin_amdgcn_mfma_f32_32x32x16_bf16(kf[5],qr[2],C1,0,0,0),   P1[6],P1[7],P1[8],P1[9],     pw2[2]=PKW(P1,4), pw2[3]=PKW(P1,6), pw2); \
    VRD(3); SBAR(); GAPA(C0=__builtin_amdgcn_mfma_f32_32x32x16_bf16(kf[6],qr[3],C0,0,0,0),   P1[10],P1[11],P1[12],P1[13], pw3[0]=PKW(P1,8), pw3[1]=PKW(P1,10), pw3); \
    VRD(7); SBAR(); GAPA(C1=__builtin_amdgcn_mfma_f32_32x32x16_bf16(kf[7],qr[3],C1,0,0,0),   P1[14],P1[15],0.f,0.f,       pw3[2]=PKW(P1,12),pw3[3]=PKW(P1,14), pw3); \
    l_reg+=sacc; \
    if(GK){DMA_K((t)+3,sl_cur);} if(GV){DMA_V((t)+1,sl_next);} \
    CMASK(C0,C1,t); \
    { float a=MX3(C0[0],C0[1],C1[0]),b=MX3(C0[2],C0[3],C1[1]); a=MX3(a,C1[2],C1[3]); \
      _Pragma("unroll") for(int r=4;r<16;r+=4){a=MX3(a,C0[r],C0[r+1]);b=MX3(b,C0[r+2],C0[r+3]);a=MX3(a,C1[r],C1[r+1]);b=MX3(b,C1[r+2],C1[r+3]);} \
      float rm=__builtin_fmaxf(a,b); { auto rr=__builtin_amdgcn_permlane32_swap(__float_as_uint(rm),__float_as_uint(rm),false,false); rm=__builtin_fmaxf(__uint_as_float(rr[0]),__uint_as_float(rr[1])); } \
      resc=false; \
      if(__builtin_expect(__any(rm>(float)THRL),0)){ const float dl=__builtin_fmaxf(rm,0.f); mhat+=dl; \
        _Pragma("unroll") for(int r=0;r<16;++r){C0[r]-=dl;C1[r]-=dl;} \
        _Pragma("unroll") for(int r=0;r<16;++r)negm[r]=-mhat; asm volatile("":"+v"(negm)); \
        const float f=__builtin_amdgcn_exp2f(-dl); l_reg*=f; if(hi==0)wsf[r32]=f; resc=true; } } \
    SBAR(); \
    GAPB(o[0]=__builtin_amdgcn_mfma_f32_32x32x16_bf16(PAF(0),VFR(0),o[0],0,0,0), C0,0); \
    GAPB(o[1]=__builtin_amdgcn_mfma_f32_32x32x16_bf16(PAF(0),VFR(4),o[1],0,0,0), C0,4); \
    KRD(GL,0); GAPB(o[0]=__builtin_amdgcn_mfma_f32_32x32x16_bf16(PAF(1),VFR(1),o[0],0,0,0), C0,8); \
    KRD(GL,1); GAPB(o[1]=__builtin_amdgcn_mfma_f32_32x32x16_bf16(PAF(1),VFR(5),o[1],0,0,0), C0,12); \
    KRD(GL,2); GAPB(o[0]=__builtin_amdgcn_mfma_f32_32x32x16_bf16(PAF(2),VFR(2),o[0],0,0,0), C1,0); \
    KRD(GL,3); GAPB(o[1]=__builtin_amdgcn_mfma_f32_32x32x16_bf16(PAF(2),VFR(6),o[1],0,0,0), C1,4); \
    GAPB(o[0]=__builtin_amdgcn_mfma_f32_32x32x16_bf16(PAF(3),VFR(3),o[0],0,0,0), C1,8); \
    GAPB(o[1]=__builtin_amdgcn_mfma_f32_32x32x16_bf16(PAF(3),VFR(7),o[1],0,0,0), C1,12); \
    }while(0)
  int t=1;
  #undef CMASK
  #define CMASK(P0,P1,t) do{}while(0)
  for(;t+5<NT;t+=2){
    STEP(pB0,pB1,pA0,pA1,t,true,true,true);     WAIT_BAR(2); RESC(); ROT();
    STEP(pA0,pA1,pB0,pB1,t+1,true,true,true);   WAIT_BAR(2); RESC(); ROT();
  }
  #undef CMASK
  #define CMASK(P0,P1,t) do{int jb_=(t)-(NT-4); if(jb_>=0)cmask(P0,P1,jb_,qrel,hi);}while(0)
  #define ENDW(tt) do{ if((tt)+3<NT){WAIT_BAR(2);} else if((tt)+2<NT){WAIT_BAR(1);} else {WAIT_BAR(0);} }while(0)
  for(;t+1<NT;t+=2){
    STEP(pB0,pB1,pA0,pA1,t,(t+3<NT),(t+1<NT),(t+1<NT));       ENDW(t);   RESC(); ROT();
    STEP(pA0,pA1,pB0,pB1,t+1,(t+4<NT),(t+2<NT),(t+2<NT));     ENDW(t+1); RESC(); ROT();
  }
  STEP(pB0,pB1,pA0,pA1,NT-1,false,false,false); RESC();
  { float sacc=pB0[0]+pB0[1]; _Pragma("unroll") for(int r=2;r<16;++r)sacc+=pB0[r]; _Pragma("unroll") for(int r=0;r<16;++r)sacc+=pB1[r]; l_reg+=sacc;
    pw0=(u32x4){PKW(pB0,0),PKW(pB0,2),PKW(pB0,4),PKW(pB0,6)};pw1=(u32x4){PKW(pB0,8),PKW(pB0,10),PKW(pB0,12),PKW(pB0,14)};pw2=(u32x4){PKW(pB1,0),PKW(pB1,2),PKW(pB1,4),PKW(pB1,6)};pw3=(u32x4){PKW(pB1,8),PKW(pB1,10),PKW(pB1,12),PKW(pB1,14)};
    SBAR(); pv(o,vb0+sl_cur,PAF(0),PAF(1),PAF(2),PAF(3)); }
  #undef PKW
  #undef PAF
  #undef VFR
  #undef PIN
  #undef MX3
  #undef GAPA
  #undef GAPB
  #undef EX
  #undef VRD
  #undef KRD
  #undef STEP
  #undef ENDW
  {auto rr=__builtin_amdgcn_permlane32_swap(__float_as_uint(l_reg),__float_as_uint(l_reg),false,false);l_reg=__uint_as_float(rr[0])+__uint_as_float(rr[1]);}
  if(hi==0)wsf[32+r32]=l_reg;asm volatile("s_waitcnt lgkmcnt(0)":::"memory");
  float rli[16];
  #pragma unroll
  for(int r=0;r<16;++r)rli[r]=__builtin_amdgcn_rcpf(wsf[32+crow(r,hi)]);
  bf16*Ow=O+(rowbase+q0+wid*QBLK)*OP+h*D;
  { bf16*stg=(bf16*)(shm+LDS_OST)+wid*2048;
    #pragma unroll
    for(int r=0;r<16;++r){const int orow=crow(r,hi);
      #pragma unroll
      for(int d0=0;d0<2;++d0)stg[orow*64+d0*32+r32]=__float2bfloat16(o[d0][r]*rli[r]);}
    asm volatile("s_waitcnt lgkmcnt(0)":::"memory");
    #pragma unroll
    for(int i=0;i<4;++i){const int row=i*8+(lane>>3),ch=lane&7; const u32x4 v=*(const u32x4*)(stg+row*64+ch*8); ATTN_STORE16(Ow+(long)row*OP+ch*8,v);} }
  asm volatile("s_waitcnt lgkmcnt(0)\n\ts_barrier":::"memory");
  #undef DMA_K
  #undef DMA_V
  #undef CMASK
  #undef START
  #undef RESC
  #undef ROT
}
constexpr int SLOTK=8192, SLOTV=16384;
constexpr int L2_K=0, L2_V=NSLOT*SLOTK, L2_WS=L2_V+NSLOT*SLOTV, L2_OST=L2_WS+NW*64*4, L2_BYTES=L2_OST+NW*4096;
__device__ __forceinline__ void pv128(f32x16*o,int vb,bf16x8 pa0,bf16x8 pa1,bf16x8 pa2,bf16x8 pa3){
  #pragma unroll
  for(int d0=0;d0<4;++d0){s16x4 lo[4],hi[4];
    #pragma unroll
    for(int ks=0;ks<4;++ks){
      asm volatile("ds_read_b64_tr_b16 %0,%1 offset:%c2":"=&v"(lo[ks]):"v"(vb),"i"(d0*4096+ks*1024):"memory");
      asm volatile("ds_read_b64_tr_b16 %0,%1 offset:%c2":"=&v"(hi[ks]):"v"(vb),"i"(d0*4096+ks*1024+512):"memory");}
    asm volatile("s_waitcnt lgkmcnt(0)":::"memory");SBAR();
    #define PK(k) (bf16x8){lo[k][0],lo[k][1],lo[k][2],lo[k][3],hi[k][0],hi[k][1],hi[k][2],hi[k][3]}
    o[d0]=__builtin_amdgcn_mfma_f32_32x32x16_bf16(pa0,PK(0),o[d0],0,0,0);
    o[d0]=__builtin_amdgcn_mfma_f32_32x32x16_bf16(pa1,PK(1),o[d0],0,0,0);
    o[d0]=__builtin_amdgcn_mfma_f32_32x32x16_bf16(pa2,PK(2),o[d0],0,0,0);
    o[d0]=__builtin_amdgcn_mfma_f32_32x32x16_bf16(pa3,PK(3),o[d0],0,0,0);
    #undef PK
  }
}
__device__ __forceinline__ void attn_unit128(int b,int hm,int qb,const bf16*Q,const bf16*__restrict__ K,const bf16*__restrict__ V,bf16*O,char*shm){
  const int tid=threadIdx.x,lane=tid&63,r32=lane&31,hi=lane>>5; const int wid=__builtin_amdgcn_readfirstlane(tid>>6);
  const long rowbase=(long)b*SEQ; const int q0=qb*QB;
  const bf16*Qw=Q+(rowbase+q0+wid*QBLK)*QP+hm*D;
  const bf16*Kh=K+rowbase*KP+hm*D,*Vh=V+rowbase*VP+(hm>>1)*128;
  const unsigned lds0=(unsigned)(uintptr_t)shm;
  float*wsf=(float*)(shm+L2_WS)+wid*64;
  const bf16*ksrc=Kh+(long)lane*KP+wid*8;
  const bf16*vsrc=Vh+(long)(16*(wid&3)+(lane>>2))*VP+(wid>>2)*32+(lane&3)*8;
  const unsigned kdst=lds0+L2_K+wid*1024, vdst=lds0+L2_V+(wid>>2)*4096+(wid&3)*1024;
  #define DMA_K(t,slot) glds16(ksrc+(long)(t)*KVBLK*KP,(unsigned)__builtin_amdgcn_readfirstlane(kdst+(slot)))
  #define DMA_V(t,slot) do{ glds16(vsrc+(long)(t)*KVBLK*VP,(unsigned)__builtin_amdgcn_readfirstlane(vdst+2*(slot))); glds16(vsrc+(long)(t)*KVBLK*VP+64,(unsigned)__builtin_amdgcn_readfirstlane(vdst+2*(slot)+8192)); }while(0)
  const int vb0=(int)(lds0+L2_V)+((lane>>4)&1)*32+(lane&3)*8+(4*hi+((lane&15)>>2))*64;
  const char*Kbase=shm+L2_K; bf16x8 kf[8];
  const lds_cptr shm3=(lds_cptr)shm; const lds_cptr kp0=shm3+L2_K+hi*1024+r32*16; const lds_cptr vp0=shm3+L2_V+((lane>>4)&1)*32+(lane&3)*8+(4*hi+((lane&15)>>2))*64;
  const int NT=(q0+QB)/KVBLK;
  DMA_K(0,0);DMA_V(0,0);DMA_K(1,SLOTK);
  bf16x8 qr[4];
  #pragma unroll
  for(int d0=0;d0<4;++d0)qr[d0]=*reinterpret_cast<const bf16x8*>(&Qw[(long)r32*QP+d0*16+hi*8]);
  float l_reg=0.f;f32x16 o[4];o[0]=f32x16{};o[1]=f32x16{};o[2]=f32x16{};o[3]=f32x16{};
  const f32x16 zero=f32x16{};
  const int qrel=wid*QBLK+r32;
  #define CMASK(P0,P1,t) do{int jb_=(t)-(NT-4); if(jb_>=0)cmask(P0,P1,jb_,qrel,hi);}while(0)
  f32x16 pA0,pA1,pB0,pB1;
  int sl_prev=0,sl_cur=0,sl_next=SLOTK;
  #define ROT() do{sl_prev=sl_cur;sl_cur=sl_next;sl_next=(sl_next==(NSLOT-1)*SLOTK)?0:sl_next+SLOTK;}while(0)
  DMA_K(2,2*SLOTK);
  WAIT_BAR(4);
  qkt(pA0,pA1,Kbase,qr,zero,r32,hi);asm volatile("s_nop 15\n\ts_nop 7":"+v"(pA0),"+v"(pA1));CMASK(pA0,pA1,0);
  _Pragma("unroll") for(int r=0;r<16;++r){pA0[r]=__builtin_amdgcn_exp2f(pA0[r]);pA1[r]=__builtin_amdgcn_exp2f(pA1[r]);}
  WAIT_BAR(0);
  DMA_K(3,0);DMA_V(1,SLOTK);
  ROT();
  kload8(kf,kp0+sl_cur);
  WAIT_BAR(3);
  s16x4 vlo[4],vhi[4]; u32x4 pw0,pw1,pw2,pw3;
  #define PKW(P,B) cvtpk_s(P[B],P[B+1])
  #define PAF(k) __builtin_bit_cast(bf16x8,pw##k)
  #define VFR(i) (bf16x8){vlo[i][0],vlo[i][1],vlo[i][2],vlo[i][3],vhi[i][0],vhi[i][1],vhi[i][2],vhi[i][3]}
  #define PIN(x) asm volatile("":"+v"(x))
  #define GAPA(MF,A0,A1,A2,A3,W0,W1,PW) do{ MF; sacc+=A0; sacc+=A1; sacc+=A2; sacc+=A3; PIN(sacc); W0; W1; PIN(PW); SBAR(); }while(0)
  #define EX(v) __builtin_amdgcn_exp2f(v)
  #define DB(j) ((((j)&1))+2*((j)>>3))
  #define KS(j) (((j)>>1)&3)
  #define VRDJ(j) do{ vlo[(j)&3]=vtr(vp_+(DB(j)*4096+KS(j)*1024)); vhi[(j)&3]=vtr(vp_+(DB(j)*4096+KS(j)*1024+512)); SBAR(); }while(0)
  #define GAPB2(j,PF,X,B) do{ o[DB(j)]=__builtin_amdgcn_mfma_f32_32x32x16_bf16(PF,VFR((j)&3),o[DB(j)],0,0,0); X[B]=EX(X[B]); X[B+1]=EX(X[B+1]); PIN(X); SBAR(); }while(0)
  #define KRD(G,j) do{ if(G){ kload2(kf,kp0+sl_next,j); SBAR(); } }while(0)
  #define MF32(a,b,c) __builtin_amdgcn_mfma_f32_32x32x16_bf16(a,b,c,0,0,0)
  #define STEP(C0,C1,P0,P1,t,GK,GV,GL) do{ SBAR(); \
    const lds_cptr vp_=vp0+2*sl_prev; \
    float sacc=(P0[0]+P0[1]); \
    GAPA(C0=MF32(kf[0],qr[0],zero), P0[2],P0[3],P0[4],P0[5],     pw0[0]=PKW(P0,0), pw0[1]=PKW(P0,2), pw0); \
    GAPA(C1=MF32(kf[1],qr[0],zero), P0[6],P0[7],P0[8],P0[9],     pw0[2]=PKW(P0,4), pw0[3]=PKW(P0,6), pw0); \
    GAPA(C0=MF32(kf[2],qr[1],C0),   P0[10],P0[11],P0[12],P0[13], pw1[0]=PKW(P0,8), pw1[1]=PKW(P0,10), pw1); \
    GAPA(C1=MF32(kf[3],qr[1],C1),   P0[14],P0[15],P1[0],P1[1],   pw1[2]=PKW(P0,12),pw1[3]=PKW(P0,14), pw1); \
    GAPA(C0=MF32(kf[4],qr[2],C0),   P1[2],P1[3],P1[4],P1[5],     pw2[0]=PKW(P1,0), pw2[1]=PKW(P1,2), pw2); \
    VRDJ(0); GAPA(C1=MF32(kf[5],qr[2],C1),   P1[6],P1[7],P1[8],P1[9],     pw2[2]=PKW(P1,4), pw2[3]=PKW(P1,6), pw2); \
    VRDJ(1); GAPA(C0=MF32(kf[6],qr[3],C0),   P1[10],P1[11],P1[12],P1[13], pw3[0]=PKW(P1,8), pw3[1]=PKW(P1,10), pw3); \
    VRDJ(2); GAPA(C1=MF32(kf[7],qr[3],C1),   P1[14],P1[15],0.f,0.f,       pw3[2]=PKW(P1,12),pw3[3]=PKW(P1,14), pw3); \
    l_reg+=sacc; \
    if(GK){DMA_K((t)+3,sl_cur);} if(GV){DMA_V((t)+1,sl_next);} \
    CMASK(C0,C1,t); \
    SBAR(); \
    GAPB2(0,PAF(0),C0,0);  VRDJ(3); \
    GAPB2(1,PAF(0),C0,2);  VRDJ(4); \
    KRD(GL,0); GAPB2(2,PAF(1),C0,4);  VRDJ(5); \
    KRD(GL,1); GAPB2(3,PAF(1),C0,6);  VRDJ(6); \
    KRD(GL,2); GAPB2(4,PAF(2),C0,8);  VRDJ(7); \
    KRD(GL,3); GAPB2(5,PAF(2),C0,10); VRDJ(8); \
    GAPB2(6,PAF(3),C0,12); VRDJ(9); \
    GAPB2(7,PAF(3),C0,14); VRDJ(10); \
    GAPB2(8,PAF(0),C1,0);  VRDJ(11); \
    GAPB2(9,PAF(0),C1,2);  VRDJ(12); \
    GAPB2(10,PAF(1),C1,4); VRDJ(13); \
    GAPB2(11,PAF(1),C1,6); VRDJ(14); \
    GAPB2(12,PAF(2),C1,8); VRDJ(15); \
    GAPB2(13,PAF(2),C1,10); \
    GAPB2(14,PAF(3),C1,12); \
    GAPB2(15,PAF(3),C1,14); \
    }while(0)
  int t=1;
  #undef CMASK
  #define CMASK(P0,P1,t) do{}while(0)
  for(;t+5<NT;t+=2){
    STEP(pB0,pB1,pA0,pA1,t,true,true,true);     WAIT_BAR(3); ROT();
    STEP(pA0,pA1,pB0,pB1,t+1,true,true,true);   WAIT_BAR(3); ROT();
  }
  #undef CMASK
  #define CMASK(P0,P1,t) do{int jb_=(t)-(NT-4); if(jb_>=0)cmask(P0,P1,jb_,qrel,hi);}while(0)
  #define ENDW(tt) do{ if((tt)+3<NT){WAIT_BAR(3);} else if((tt)+2<NT){WAIT_BAR(2);} else {WAIT_BAR(0);} }while(0)
  for(;t+1<NT;t+=2){
    STEP(pB0,pB1,pA0,pA1,t,(t+3<NT),(t+1<NT),(t+1<NT));       ENDW(t);   ROT();
    STEP(pA0,pA1,pB0,pB1,t+1,(t+4<NT),(t+2<NT),(t+2<NT));     ENDW(t+1); ROT();
  }
  STEP(pB0,pB1,pA0,pA1,NT-1,false,false,false);
  { float sacc=pB0[0]+pB0[1]; _Pragma("unroll") for(int r=2;r<16;++r)sacc+=pB0[r]; _Pragma("unroll") for(int r=0;r<16;++r)sacc+=pB1[r]; l_reg+=sacc;
    pw0=(u32x4){PKW(pB0,0),PKW(pB0,2),PKW(pB0,4),PKW(pB0,6)};pw1=(u32x4){PKW(pB0,8),PKW(pB0,10),PKW(pB0,12),PKW(pB0,14)};pw2=(u32x4){PKW(pB1,0),PKW(pB1,2),PKW(pB1,4),PKW(pB1,6)};pw3=(u32x4){PKW(pB1,8),PKW(pB1,10),PKW(pB1,12),PKW(pB1,14)};
    SBAR(); pv128(o,vb0+2*sl_cur,PAF(0),PAF(1),PAF(2),PAF(3)); }
  #undef PKW
  #undef PAF
  #undef VFR
  #undef PIN
  #undef GAPA
  #undef GAPB2
  #undef EX
  #undef VRDJ
  #undef DB
  #undef KS
  #undef KRD
  #undef MF32
  #undef STEP
  #undef ENDW
  {auto rr=__builtin_amdgcn_permlane32_swap(__float_as_uint(l_reg),__float_as_uint(l_reg),false,false);l_reg=__uint_as_float(rr[0])+__uint_as_float(rr[1]);}
  if(hi==0)wsf[32+r32]=l_reg;asm volatile("s_waitcnt lgkmcnt(0)":::"memory");
  float rli[16];
  #pragma unroll
  for(int r=0;r<16;++r)rli[r]=__builtin_amdgcn_rcpf(wsf[32+crow(r,hi)]);
  bf16*Ow=O+(rowbase+q0+wid*QBLK)*OP+hm*128;
  { bf16*stg=(bf16*)(shm+L2_OST)+wid*2048;
    #pragma unroll
    for(int dh=0;dh<2;++dh){
      #pragma unroll
      for(int r=0;r<16;++r){const int orow=crow(r,hi);
        #pragma unroll
        for(int d0=0;d0<2;++d0)stg[orow*64+d0*32+r32]=__float2bfloat16(o[2*dh+d0][r]*rli[r]);}
      asm volatile("s_waitcnt lgkmcnt(0)":::"memory");
      #pragma unroll
      for(int i=0;i<4;++i){const int row=i*8+(lane>>3),ch=lane&7; const u32x4 v=*(const u32x4*)(stg+row*64+ch*8); ATTN_STORE16(Ow+(long)row*OP+dh*64+ch*8,v);}
      asm volatile("s_waitcnt lgkmcnt(0)":::"memory"); } }
  asm volatile("s_waitcnt lgkmcnt(0)\n\ts_barrier":::"memory");
  #undef DMA_K
  #undef DMA_V
  #undef CMASK
  #undef ROT
}
struct AttnUnit128 { int bh; int qb; };
struct StaticOrder128 {
  int vcu;
  __device__ __forceinline__ explicit StaticOrder128(int grid,int block):vcu((block%8)*(grid/8)+block/8){}
#ifdef PROBE_DUP_ATTN2
  __device__ __forceinline__ bool next(int ii,AttnUnit128&u)const{ if(ii>=8)return false; const int i=ii>>1; const int s=vcu&7; u.bh=vcu>>3; u.qb=(i==0)?s:(i==1)?15-s:(i==2)?16+s:31-s; return true; }
#else
  __device__ __forceinline__ bool next(int i,AttnUnit128&u)const{ if(i>=4)return false; const int s=vcu&7; u.bh=vcu>>3; u.qb=(i==0)?s:(i==1)?15-s:(i==2)?16+s:31-s; return true; }
#endif
};
__device__ __forceinline__ void attn_phase128(char*lds,const bf16*Q,const bf16*K,const bf16*V,bf16*O,const StaticOrder128&S){
  AttnUnit128 u;
  for(int i=0;S.next(i,u);++i) attn_unit128(u.bh>>3,u.bh&7,u.qb,Q,K,V,O,lds);
}
constexpr int ATTN_LDS_BYTES=LDS_BYTES;
struct AttnTensors { const bf16* Q; const bf16* K; const bf16* V; bf16* O; };
struct AttnUnit { int bh; int qb; };
struct StaticOrder {
  int vcu;
  __device__ __forceinline__ explicit StaticOrder(int grid,int block):vcu((block%8)*(grid/8)+block/8){}
  __device__ __forceinline__ bool next(int i,AttnUnit&u)const{ if(i>=8)return false; const int s=vcu&7,j=i&3; u.bh=2*(vcu>>3)+(i>>2); u.qb=(j==0)?s:(j==1)?15-s:(j==2)?16+s:31-s; return true; }
  __device__ __forceinline__ void a_ready(const AttnUnit&)const{}
  __device__ __forceinline__ void done(const AttnUnit&)const{}
};
template<class Sched,int THRL=8> __device__ __forceinline__ void attn_phase(char*lds,const AttnTensors&T,const Sched&S){
  AttnUnit u;
  for(int i=0;S.next(i,u);++i){ S.a_ready(u); attn_unit<THRL>(u.bh/NHEAD,u.bh%NHEAD,u.qb,T.Q,T.K,T.V,T.O,lds); S.done(u); }
}
#undef SBAR
#undef WAIT_BAR
}

constexpr int NWAVES = 8;
constexpr int BATCH = 4, T = 8192, D = 1024, M = BATCH * T, DEPTH = 2;
constexpr int IN_COLS = 3088, NIN = 3328;
constexpr int NEXP = 16384;
constexpr float RMS_EPS = 1e-6f;
constexpr int NPHASE = 24;
#ifndef MK_PER_PHASE
#define MK_PER_PHASE 0
#endif

constexpr size_t MiB = 1u << 20;
constexpr size_t WS_CTL = 0, CTL_ZERO_BYTES = 1 * MiB;
constexpr size_t WS_WIN = 2 * MiB;
constexpr size_t WS_WOUT = 16 * MiB;
constexpr size_t WS_WQ = 20 * MiB;
constexpr size_t WS_SK = 28 * MiB;
constexpr size_t WS_USC = 30 * MiB, WS_VSC = 30 * MiB + 256 * 1024;
constexpr size_t WS_TU = 32 * MiB, WS_TV = 64 * MiB;
constexpr size_t WS_XN8 = 96 * MiB;
constexpr size_t WS_XN = 96 * MiB;
constexpr size_t WS_Q = 160 * MiB, WS_K = 192 * MiB, WS_DV = 224 * MiB;
constexpr size_t WS_GQ = 256 * MiB;
constexpr size_t WS_GO = 272 * MiB;
constexpr size_t WS_OI = 304 * MiB;
constexpr size_t WS_UT = 336 * MiB;
constexpr size_t WS_GK = 400 * MiB, WS_GV = 416 * MiB, WS_GLOG = 448 * MiB;
constexpr size_t WS_O = 96 * MiB;
constexpr size_t WS_RES = 336 * MiB;
constexpr size_t WS_USUM = 304 * MiB, WS_PDS = 312 * MiB;
constexpr size_t WS_Q2 = 160 * MiB;
constexpr size_t WS_IDX = 288 * MiB, WS_GATE = 304 * MiB;
constexpr size_t WS_EW8 = 320 * MiB, WS_EWSC = 324 * MiB;
constexpr size_t WS_PART = 400 * MiB;
constexpr size_t WS_SSQ = 18 * MiB;
constexpr size_t WS_AS = 29 * MiB;
constexpr size_t WS_WCS = 29 * MiB + 512 * 1024;
constexpr size_t WS_RS = 30 * MiB + 512 * 1024;
constexpr size_t WS_END = 480 * MiB;
static_assert(WS_GLOG + (size_t)M * 256 * 4 <= WS_END && WS_PART + (size_t)8 * M * 128 * 2 <= WS_END, "workspace map");
constexpr size_t WS_WQCS = 29 * MiB + 640 * 1024;
constexpr int CW_BAR = 4096;
constexpr int CW_LBAR = 13312;
constexpr size_t WS_WOCS = 29 * MiB + 576 * 1024;
constexpr size_t OUT_MIX8 = 64 * MiB, OUT_MS = 96 * MiB;
static_assert(pg8::WSO_Q == WS_Q && pg8::WSO_K == WS_K && pg8::WSO_DV == WS_DV && pg8::WSO_GQ == WS_GQ && pg8::WSO_GO == WS_GO && pg8::WSO_GK == WS_GK && pg8::WSO_GV == WS_GV && pg8::WSO_GLOG == WS_GLOG, "epilogue offsets");

constexpr int RING_OFF = 0, RING_BYTES = 131072;
constexpr int LDSCTL_OFF = RING_BYTES, MISC_OFF = LDSCTL_OFF + 320;
constexpr int LDS_BYTES = 147456;

#define GAS __attribute__((address_space(1)))
#define LAS __attribute__((address_space(3)))
typedef unsigned short bf16;
typedef unsigned v4u __attribute__((ext_vector_type(4)));
typedef unsigned v2u __attribute__((ext_vector_type(2)));
typedef float f32x4 __attribute__((ext_vector_type(4)));
typedef float f32x16 __attribute__((ext_vector_type(16)));
typedef short bf16x8 __attribute__((ext_vector_type(8)));
typedef GAS unsigned gu32;
#define RLX_AGENT __ATOMIC_RELAXED, __HIP_MEMORY_SCOPE_AGENT
#define LDS_WAIT() asm volatile("s_waitcnt lgkmcnt(0)" ::: "memory")
__device__ __forceinline__ unsigned f2bf(float f) { unsigned u = __builtin_bit_cast(unsigned, f); return (u + 0x7fffu + ((u >> 16) & 1u)) >> 16; }
__device__ __forceinline__ unsigned pk2(float lo, float hi) { return f2bf(lo) | (f2bf(hi) << 16); }
__device__ __forceinline__ float bf2f(unsigned short h) { return __builtin_bit_cast(float, (unsigned)h << 16); }
__device__ __forceinline__ float bflo(unsigned w) { return __builtin_bit_cast(float, w << 16); }
__device__ __forceinline__ float bfhi(unsigned w) { return __builtin_bit_cast(float, w & 0xffff0000u); }

#define XB_TMO      128
#define XB_XCNT(j)  (256  + 64 * (j))
#define XB_XSUB(j)  (1280 + 64 * (j))
#define XB_XGEN(j)  (2304 + 64 * (j))
#define XB_TOP      3328
#define XB_TOPGEN   3392
#define XCD_BAR_WORDS 3456
#define XB_SPIN_CAP (1u << 18)

__device__ __forceinline__ unsigned xb_ld(unsigned* p)              { return __hip_atomic_load(p, __ATOMIC_RELAXED, __HIP_MEMORY_SCOPE_AGENT); }
__device__ __forceinline__ unsigned xb_add(unsigned* p, unsigned v) { return __hip_atomic_fetch_add(p, v, __ATOMIC_RELAXED, __HIP_MEMORY_SCOPE_AGENT); }
__device__ __forceinline__ unsigned xb_xcc_id() { return (unsigned)__builtin_amdgcn_s_getreg((3 << 11) | 20) & 0xFu; }
#define XB_SPIN(cond, bar) do { unsigned _sp = 0; while (cond) { __builtin_amdgcn_s_sleep(1); \
    if ((++_sp & 255u) == 0u) { if (xb_ld(&(bar)[XB_TMO])) break; if (_sp > XB_SPIN_CAP) { atomicAdd(&(bar)[XB_TMO], 1u); break; } } } } while (0)

struct XcdBarrier {
    unsigned* bar; unsigned x;
    volatile LAS unsigned* st;
};

__device__ __forceinline__ XcdBarrier xcd_barrier_post(unsigned* bar, volatile LAS unsigned* st) {
    XcdBarrier b; b.bar = bar; b.x = xb_xcc_id(); b.st = st;
    if (threadIdx.x == 0) st[2] = xb_add(&bar[XB_XCNT(b.x)], 1u);
    return b;
}
__device__ __forceinline__ void xcd_barrier_complete(unsigned* bar, unsigned x, unsigned& nloc, unsigned& nx) {
    const unsigned G = gridDim.x * gridDim.y * gridDim.z;
    unsigned sum, cnt, mine, sp = 0u;
    for (;;) {
        sum = 0u; cnt = 0u; mine = 0u;
#pragma unroll
        for (unsigned j = 0; j < 16; ++j) { const unsigned c = xb_ld(&bar[XB_XCNT(j)]); sum += c; cnt += (c > 0u) ? 1u : 0u; mine = (j == x) ? c : mine; }
        if (sum == G) break;
        __builtin_amdgcn_s_sleep(1);
        if ((++sp & 255u) == 0u) { if (xb_ld(&bar[XB_TMO])) break; if (sp > XB_SPIN_CAP) { atomicAdd(&bar[XB_TMO], 1u); break; } }
    }
    nloc = mine > 0u ? mine : 1u; nx = cnt > 0u ? cnt : 1u;
}

__device__ __forceinline__ void xcd_barrier(const XcdBarrier& b) {
    asm volatile("s_waitcnt vmcnt(0)" ::: "memory");
    __syncthreads();
    if (threadIdx.x == 0) {
        unsigned* bar = b.bar;
        __builtin_amdgcn_s_waitcnt(0);
        unsigned nloc = b.st[0], nx = b.st[1];
        if (nloc == 0u) { xcd_barrier_complete(bar, b.x, nloc, nx); b.st[0] = nloc; b.st[1] = nx;
            const unsigned G = gridDim.x * gridDim.y * gridDim.z; unsigned okc = (G == 256u) ? 1u : 0u;
#pragma unroll
            for (unsigned j = 0; j < 16; ++j) { const unsigned c = xb_ld(&bar[XB_XCNT(j)]); okc &= (c == (j < 8u ? G / 8u : 0u)) ? 1u : 0u; }
            b.st[3] = okc; }
        const unsigned old = xb_add(&bar[XB_XSUB(b.x)], 1u);
        const unsigned gen = old / nloc;
        if (old + 1u == (gen + 1u) * nloc) {
            __builtin_amdgcn_fence(__ATOMIC_RELEASE, "agent");
            asm volatile("s_waitcnt vmcnt(0)" ::: "memory");
            const unsigned og = xb_add(&bar[XB_TOP], 1u);
            const unsigned tg = og / nx;
            if (og + 1u == (tg + 1u) * nx) xb_add(&bar[XB_TOPGEN], 1u);
            else XB_SPIN(xb_ld(&bar[XB_TOPGEN]) == tg, bar);
            __builtin_amdgcn_fence(__ATOMIC_ACQUIRE, "agent");
            xb_add(&bar[XB_XGEN(b.x)], 1u);
            asm volatile("s_waitcnt vmcnt(0)" ::: "memory");
        } else {
            XB_SPIN(xb_ld(&bar[XB_XGEN(b.x)]) == gen, bar);
            __builtin_amdgcn_fence(__ATOMIC_ACQUIRE, "agent");
            asm volatile("s_waitcnt vmcnt(0)" ::: "memory");
        }
    }
    __syncthreads();
}

__device__ __forceinline__ void xcd_local_barrier(const XcdBarrier& b, unsigned* lbar) {
    asm volatile("s_waitcnt vmcnt(0)" ::: "memory");
    __syncthreads();
    if (threadIdx.x == 0) {
        __builtin_amdgcn_s_waitcnt(0);
        const unsigned nloc = b.st[0], gen = b.st[4]; b.st[4] = gen + 1u;
        unsigned* ctr = &lbar[64 * b.x];
        (void)xb_add(ctr, 1u);
        const unsigned target = (gen + 1u) * nloc;
        XB_SPIN(xb_ld(ctr) < target, b.bar);
        __builtin_amdgcn_fence(__ATOMIC_ACQUIRE, "agent");
        asm volatile("s_waitcnt vmcnt(0)" ::: "memory");
    }
    __syncthreads();
}

struct Args {
    const float* in[19]; float* out; unsigned char* ws; int ph_lo, ph_hi;
};
struct Frame {
    LAS unsigned char* lds;
    int tid, lane, wave, vcu, G, bx, gw, NGW;
};
enum { I_X = 0, I_ANW, I_WIN, I_QNW, I_KNW, I_LQ1, I_LK1, I_LQ2, I_LK2, I_DONW, I_GW2, I_GB, I_GONW, I_WOUT, I_FNW, I_PWQ, I_PSK, I_PU, I_PV };
typedef const __attribute__((address_space(4))) Args* KArgs;
__device__ __forceinline__ KArgs kargs() { KArgs p = (KArgs)__builtin_amdgcn_kernarg_segment_ptr(); asm volatile("" : "+s"(p)); return p; }
__device__ __forceinline__ float row16_sum(float v) {
    v += __builtin_bit_cast(float, __builtin_amdgcn_update_dpp(0, __builtin_bit_cast(int, v), 0xB1, 0xf, 0xf, true)); v += __builtin_bit_cast(float, __builtin_amdgcn_update_dpp(0, __builtin_bit_cast(int, v), 0x4E, 0xf, 0xf, true));
    v += __builtin_bit_cast(float, __builtin_amdgcn_update_dpp(0, __builtin_bit_cast(int, v), 0x141, 0xf, 0xf, true)); v += __builtin_bit_cast(float, __builtin_amdgcn_update_dpp(0, __builtin_bit_cast(int, v), 0x140, 0xf, 0xf, true));
    return v;
}
__device__ __forceinline__ float wave_max_nn(float v) {
    v = fmaxf(v, __builtin_bit_cast(float, __builtin_amdgcn_update_dpp(0, __builtin_bit_cast(int, v), 0xB1, 0xf, 0xf, true))); v = fmaxf(v, __builtin_bit_cast(float, __builtin_amdgcn_update_dpp(0, __builtin_bit_cast(int, v), 0x4E, 0xf, 0xf, true)));
    v = fmaxf(v, __builtin_bit_cast(float, __builtin_amdgcn_update_dpp(0, __builtin_bit_cast(int, v), 0x141, 0xf, 0xf, true))); v = fmaxf(v, __builtin_bit_cast(float, __builtin_amdgcn_update_dpp(0, __builtin_bit_cast(int, v), 0x140, 0xf, 0xf, true)));
    { auto rr = __builtin_amdgcn_permlane16_swap(__float_as_uint(v), __float_as_uint(v), false, false); v = fmaxf(__uint_as_float(rr[0]), __uint_as_float(rr[1])); }
    { auto rr = __builtin_amdgcn_permlane32_swap(__float_as_uint(v), __float_as_uint(v), false, false); v = fmaxf(__uint_as_float(rr[0]), __uint_as_float(rr[1])); }
    return v;
}
__device__ __forceinline__ float wave_sum(float v) { return pg8::xsum32(pg8::xsum16(row16_sum(v))); }
__device__ __forceinline__ void p0_transpose_item(const float* W, int K, int ld, int nblk, bf16* WT, int row_off, LAS float* scr, int item, int lane, const float* kscale = nullptr) {
    const int kb = item / nblk, nb = item % nblk, k0 = 64 * kb, n0 = 32 * nb;
    float tv[32];
#pragma unroll
    for (int i = 0; i < 32; ++i) tv[i] = W[(size_t)(k0 + 2 * i + (lane >> 5)) * ld + n0 + (lane & 31)];
#pragma unroll
    for (int i = 0; i < 32; ++i) scr[(2 * i + (lane >> 5)) * 33 + (lane & 31)] = tv[i];
    LDS_WAIT(); asm volatile("" ::: "memory");
    const int c = lane & 7;
    float ks[8];
#pragma unroll
    for (int i = 0; i < 8; ++i) ks[i] = kscale ? kscale[k0 + 8 * c + i] : 1.f;
#pragma unroll
    for (int j = 0; j < 4; ++j) { const int n = (lane >> 3) + 8 * j; const LAS float* s = scr + (8 * c) * 33 + n;
        v4u o; o.x = pk2(s[0 * 33] * ks[0], s[1 * 33] * ks[1]); o.y = pk2(s[2 * 33] * ks[2], s[3 * 33] * ks[3]); o.z = pk2(s[4 * 33] * ks[4], s[5 * 33] * ks[5]); o.w = pk2(s[6 * 33] * ks[6], s[7 * 33] * ks[7]);
        *(GAS v4u*)(WT + (size_t)(row_off + n0 + n) * K + k0 + 8 * c) = o; }
    LDS_WAIT(); asm volatile("" ::: "memory");
}
__device__ __forceinline__ void rms_row_to_bf16(int lane, const float* xrow, const float* w, bf16* orow) {
    const GAS f32x4* xr = (const GAS f32x4*)xrow + lane; const GAS f32x4* wr = (const GAS f32x4*)w + lane;
    f32x4 v[4]; float s = 0.f;
#pragma unroll
    for (int j = 0; j < 4; ++j) { v[j] = xr[64 * j]; s += (v[j].x * v[j].x + v[j].y * v[j].y) + (v[j].z * v[j].z + v[j].w * v[j].w); }
    const float rs = 1.f / sqrtf(wave_sum(s) * (1.f / 1024.f) + RMS_EPS);
    GAS unsigned long long* o8 = (GAS unsigned long long*)orow + lane;
#pragma unroll
    for (int j = 0; j < 4; ++j) { const f32x4 ww = wr[64 * j]; o8[64 * j] = (unsigned long long)pk2(v[j].x * rs * ww.x, v[j].y * rs * ww.y) | ((unsigned long long)pk2(v[j].z * rs * ww.z, v[j].w * rs * ww.w) << 32); }
}
__device__ __forceinline__ void rms_regs_to_bf16(int lane, const f32x4 (&v)[4], const float* w, bf16* orow) {
    const GAS f32x4* wr = (const GAS f32x4*)w + lane; float s = 0.f;
#pragma unroll
    for (int j = 0; j < 4; ++j) s += (v[j].x * v[j].x + v[j].y * v[j].y) + (v[j].z * v[j].z + v[j].w * v[j].w);
    const float rs = 1.f / sqrtf(wave_sum(s) * (1.f / 1024.f) + RMS_EPS);
    GAS unsigned long long* o8 = (GAS unsigned long long*)orow + lane;
#pragma unroll
    for (int j = 0; j < 4; ++j) { const f32x4 ww = wr[64 * j]; o8[64 * j] = (unsigned long long)pk2(v[j].x * rs * ww.x, v[j].y * rs * ww.y) | ((unsigned long long)pk2(v[j].z * rs * ww.z, v[j].w * rs * ww.w) << 32); }
}
__device__ __forceinline__ void rms_row16_to_bf16(int lane, const bf16* xrow, const float* w, bf16* orow) {
    const v4u a = ((const GAS v4u*)(xrow + 16 * lane))[0], b = ((const GAS v4u*)(xrow + 16 * lane))[1]; const unsigned ww[8] = {a.x, a.y, a.z, a.w, b.x, b.y, b.z, b.w};
    float x[16]; float s = 0.f;
#pragma unroll
    for (int q = 0; q < 8; ++q) { x[2 * q] = bflo(ww[q]); x[2 * q + 1] = bfhi(ww[q]); s += x[2 * q] * x[2 * q] + x[2 * q + 1] * x[2 * q + 1]; }
    const float rs = 1.f / sqrtf(wave_sum(s) * (1.f / 1024.f) + RMS_EPS);
    const float* wp = w + 16 * lane; v4u oa, ob;
    oa.x = pk2(x[0] * rs * wp[0], x[1] * rs * wp[1]); oa.y = pk2(x[2] * rs * wp[2], x[3] * rs * wp[3]); oa.z = pk2(x[4] * rs * wp[4], x[5] * rs * wp[5]); oa.w = pk2(x[6] * rs * wp[6], x[7] * rs * wp[7]);
    ob.x = pk2(x[8] * rs * wp[8], x[9] * rs * wp[9]); ob.y = pk2(x[10] * rs * wp[10], x[11] * rs * wp[11]); ob.z = pk2(x[12] * rs * wp[12], x[13] * rs * wp[13]); ob.w = pk2(x[14] * rs * wp[14], x[15] * rs * wp[15]);
    ((GAS v4u*)(orow + 16 * lane))[0] = oa; ((GAS v4u*)(orow + 16 * lane))[1] = ob;
}
__device__ __forceinline__ void conv_bf16(const float* src, bf16* dst, size_t n8, size_t gtid, size_t nthr) {
    for (size_t i = gtid; i < n8; i += nthr) { const f32x4 a = ((const GAS f32x4*)src)[2 * i], b = ((const GAS f32x4*)src)[2 * i + 1];
        v4u o; o.x = pk2(a.x, a.y); o.y = pk2(a.z, a.w); o.z = pk2(b.x, b.y); o.w = pk2(b.z, b.w); ((GAS v4u*)dst)[i] = o; }
}
template <bool OFFS> __device__ __forceinline__ void quant_row(int lane, const float* src, unsigned char* dst, float* scale_out) {
    const GAS f32x4* p = (const GAS f32x4*)(src + 16 * lane); f32x4 v[4]; float am = 0.f;
#pragma unroll
    for (int j = 0; j < 4; ++j) { v[j] = p[j]; am = fmaxf(fmaxf(am, fmaxf(fabsf(v[j].x), fabsf(v[j].y))), fmaxf(fabsf(v[j].z), fabsf(v[j].w))); }
    am = wave_max_nn(am);
    const float inv = am > 0.f ? 127.f / am : 0.f; const int off = OFFS ? 128 : 0;
    v4u o4; unsigned w[4];
#pragma unroll
    for (int j = 0; j < 4; ++j) { const int b0 = (int)rintf(v[j].x * inv) + off, b1 = (int)rintf(v[j].y * inv) + off, b2 = (int)rintf(v[j].z * inv) + off, b3 = (int)rintf(v[j].w * inv) + off;
        w[j] = (unsigned)(b0 & 0xff) | ((unsigned)(b1 & 0xff) << 8) | ((unsigned)(b2 & 0xff) << 16) | ((unsigned)(b3 & 0xff) << 24); }
    o4.x = w[0]; o4.y = w[1]; o4.z = w[2]; o4.w = w[3];
    *(GAS v4u*)(dst + (size_t)(lane >> 3) * NEXP * 128 + 16 * (lane & 7)) = o4;
    if (lane == 0) *scale_out = am * (1.f / 127.f);
}
__device__ __forceinline__ void quant_row_regs(int lane, const f32x4 (&v)[4], unsigned char* dst, float* scale_out) {
    float am = 0.f;
#pragma unroll
    for (int j = 0; j < 4; ++j) am = fmaxf(fmaxf(am, fmaxf(fabsf(v[j].x), fabsf(v[j].y))), fmaxf(fabsf(v[j].z), fabsf(v[j].w)));
    am = wave_max_nn(am);
    const float inv = am > 0.f ? 127.f / am : 0.f;
    v4u o4; unsigned w[4];
#pragma unroll
    for (int j = 0; j < 4; ++j) { const int b0 = (int)rintf(v[j].x * inv), b1 = (int)rintf(v[j].y * inv), b2 = (int)rintf(v[j].z * inv), b3 = (int)rintf(v[j].w * inv);
        w[j] = (unsigned)(b0 & 0xff) | ((unsigned)(b1 & 0xff) << 8) | ((unsigned)(b2 & 0xff) << 16) | ((unsigned)(b3 & 0xff) << 24); }
    o4.x = w[0]; o4.y = w[1]; o4.z = w[2]; o4.w = w[3];
    *(GAS v4u*)(dst + (size_t)(lane >> 3) * NEXP * 128 + 16 * (lane & 7)) = o4;
    if (lane == 0) *scale_out = am * (1.f / 127.f);
}
__device__ __forceinline__ void quant_tables(KArgs A, int layer, int gw0, int ngw, int lane, int rlo = 0, int rhi = 2 * NEXP) {
    unsigned char* const ws = A->ws;
    f32x4 wfv[4];
#pragma unroll
    for (int j = 0; j < 4; ++j) wfv[j] = ((const GAS f32x4*)(A->in[I_FNW] + layer * D + 16 * lane))[j];
    for (int r0 = rlo + gw0; r0 < rhi; r0 += 2 * ngw) {
        f32x4 va[4], vb[4]; const int r1 = r0 + ngw; const bool has1 = r1 < rhi;
        const int isv0 = r0 >= NEXP, isv1 = r1 >= NEXP; const int row0 = layer * NEXP + (isv0 ? r0 - NEXP : r0), row1 = layer * NEXP + (isv1 ? r1 - NEXP : r1);
        const GAS f32x4* p0 = (const GAS f32x4*)((isv0 ? A->in[I_PV] : A->in[I_PU]) + (size_t)row0 * D + 16 * lane); const GAS f32x4* p1 = (const GAS f32x4*)((isv1 ? A->in[I_PV] : A->in[I_PU]) + (size_t)(has1 ? row1 : row0) * D + 16 * lane);
#pragma unroll
        for (int j = 0; j < 4; ++j) { va[j] = p0[j]; vb[j] = p1[j]; }
        if (!isv0) {
#pragma unroll
            for (int j = 0; j < 4; ++j) va[j] = va[j] * wfv[j]; }
        if (!isv1) {
#pragma unroll
            for (int j = 0; j < 4; ++j) vb[j] = vb[j] * wfv[j]; }
        const size_t sl0 = ((size_t)layer * 8 * NEXP + (row0 & (NEXP - 1))) * 128, sl1 = ((size_t)layer * 8 * NEXP + (row1 & (NEXP - 1))) * 128;
        quant_row_regs(lane, va, ws + (isv0 ? WS_TV : WS_TU) + sl0, (float*)(ws + (isv0 ? WS_VSC : WS_USC)) + row0);
        if (has1) quant_row_regs(lane, vb, ws + (isv1 ? WS_TV : WS_TU) + sl1, (float*)(ws + (isv1 ? WS_VSC : WS_USC)) + row1);
    }
}
__device__ __forceinline__ void row_to_i8(int lane, const f32x4 (&v)[4], const float* w, unsigned char* dst, float* fac, float* rs_out = nullptr) {
    float x[16]; float s = 0.f;
#pragma unroll
    for (int j = 0; j < 4; ++j) { x[4 * j] = v[j].x; x[4 * j + 1] = v[j].y; x[4 * j + 2] = v[j].z; x[4 * j + 3] = v[j].w; }
#pragma unroll
    for (int i = 0; i < 16; ++i) s += x[i] * x[i];
    const float rs = __builtin_amdgcn_rsqf(wave_sum(s) * (1.f / 1024.f) + RMS_EPS);
    float am = 0.f;
#pragma unroll
    for (int i = 0; i < 16; ++i) { if (w) x[i] = x[i] * rs * w[16 * lane + i]; am = fmaxf(am, fabsf(x[i])); }
    am = wave_max_nn(am);
    const float inv = am > 0.f ? 127.f / am : 0.f;
    unsigned q[4];
#pragma unroll
    for (int j = 0; j < 4; ++j) { const int b0 = (int)rintf(x[4 * j] * inv), b1 = (int)rintf(x[4 * j + 1] * inv), b2 = (int)rintf(x[4 * j + 2] * inv), b3 = (int)rintf(x[4 * j + 3] * inv);
        q[j] = (unsigned)(b0 & 0xff) | ((unsigned)(b1 & 0xff) << 8) | ((unsigned)(b2 & 0xff) << 16) | ((unsigned)(b3 & 0xff) << 24); }
    *(GAS v4u*)(dst + 16 * lane) = (v4u){q[0], q[1], q[2], q[3]};
    if (lane == 0) { *fac = am * (1.f / 127.f) * (w ? 1.f : rs); if (rs_out) *rs_out = rs; }
}
constexpr int P0_WBLOCKS = DEPTH * (104 + 32 + 64);
__device__ __forceinline__ void p0_wblock(KArgs A, Frame& F, int item) {
    const int lane = F.lane, w = F.wave, kh = lane >> 5, c = lane & 31;
    const bool isin = item < DEPTH * 104, isq = item >= DEPTH * (104 + 32); const int r = isin ? item : isq ? item - DEPTH * (104 + 32) : item - DEPTH * 104, l = isin ? r / 104 : isq ? r / 64 : r / 32, nb = isin ? r % 104 : isq ? r % 64 : r % 32, n = 32 * nb + c;
    LAS float* scr = (LAS float*)(F.lds + RING_OFF + w * 16384); LAS float* XCH = (LAS float*)(F.lds + RING_OFF + 7 * 16384 + 12288);
    float v[2][32];
    if (isin && nb >= 96) {
        const float* wbase = A->in[I_WIN] + (size_t)l * D * IN_COLS + 3072; const int j = n - 3072; float g2[16];
#pragma unroll
        for (int q = 0; q < 16; ++q) g2[q] = A->in[I_GW2][(size_t)l * 16 * 256 + q * 256 + j];
        { f32x4 t[8];
#pragma unroll
          for (int q = 0; q < 8; ++q) { const int e = q * 64 + lane; t[q] = *(const GAS f32x4*)(wbase + (size_t)(128 * w + (e >> 2)) * IN_COLS + 4 * (e & 3)); }
#pragma unroll
          for (int q = 0; q < 8; ++q) ((LAS f32x4*)scr)[q * 64 + lane] = t[q]; }
        LDS_WAIT(); asm volatile("" ::: "memory");
#pragma unroll
        for (int sb = 0; sb < 2; ++sb)
#pragma unroll
            for (int i = 0; i < 32; ++i) { const LAS f32x4* wr = (const LAS f32x4*)scr + (64 * sb + 2 * i + kh) * 4; float s = 0.f;
#pragma unroll
                for (int q = 0; q < 4; ++q) { const f32x4 w4 = wr[q]; s += w4.x * g2[4 * q] + w4.y * g2[4 * q + 1] + w4.z * g2[4 * q + 2] + w4.w * g2[4 * q + 3]; }
                v[sb][i] = s; if ((i & 3) == 3) __builtin_amdgcn_sched_barrier(0); }
        LDS_WAIT(); asm volatile("" ::: "memory");
    } else {
        const float* src = isin ? A->in[I_WIN] + (size_t)l * D * IN_COLS + n : isq ? A->in[I_PWQ] + (size_t)l * D * 2048 + n : A->in[I_WOUT] + (size_t)l * D * D + n; const size_t ld = isin ? IN_COLS : isq ? 2048 : D;
#pragma unroll
        for (int sb = 0; sb < 2; ++sb)
#pragma unroll
            for (int i = 0; i < 32; ++i) v[sb][i] = src[(size_t)(128 * w + 64 * sb + 2 * i + kh) * ld];
    }
    if ((isin && l > 0) || isq) { const float* an = (isq ? A->in[I_FNW] : A->in[I_ANW]) + l * D + 128 * w + kh;
#pragma unroll
        for (int sb = 0; sb < 2; ++sb)
#pragma unroll
            for (int i = 0; i < 32; ++i) v[sb][i] *= an[64 * sb + 2 * i];
    }
    float am = 0.f;
#pragma unroll
    for (int sb = 0; sb < 2; ++sb)
#pragma unroll
        for (int i = 0; i < 32; ++i) am = fmaxf(am, fabsf(v[sb][i]));
    { auto rr = __builtin_amdgcn_permlane32_swap(__float_as_uint(am), __float_as_uint(am), false, false); am = fmaxf(__uint_as_float(rr[0]), __uint_as_float(rr[1])); }
    if (kh == 0) XCH[w * 32 + c] = am;
    __syncthreads();
    float cm = 0.f;
#pragma unroll
    for (int q = 0; q < 8; ++q) cm = fmaxf(cm, XCH[q * 32 + c]);
    __syncthreads();
    const float inv = cm > 0.f ? 127.f / cm : 0.f;
    if (w == 0 && kh == 0) (isin ? (float*)(A->ws + WS_WCS) + l * NIN : isq ? (float*)(A->ws + WS_WQCS) + l * 2048 : (float*)(A->ws + WS_WOCS) + l * D)[n] = cm * (1.f / 127.f);
    unsigned char* WT = isin ? A->ws + WS_WIN + ((size_t)l * NIN + pg8::inproj_phys_row(32 * nb)) * D : isq ? A->ws + WS_WQ + ((size_t)l * 2048 + 32 * nb) * D : A->ws + WS_WOUT + ((size_t)l * D + 32 * nb) * D;
    LAS int* sq = (LAS int*)scr;
#pragma unroll
    for (int sb = 0; sb < 2; ++sb) {
#pragma unroll
        for (int i = 0; i < 32; ++i) sq[(2 * i + kh) * 33 + c] = (int)rintf(v[sb][i] * inv);
        LDS_WAIT(); asm volatile("" ::: "memory");
        { const int nn = lane >> 1, hf = lane & 1; unsigned q[8];
#pragma unroll
          for (int j = 0; j < 8; ++j) { const LAS int* s = sq + (32 * hf + 4 * j) * 33 + nn; q[j] = (unsigned)(s[0] & 0xff) | ((unsigned)(s[33] & 0xff) << 8) | ((unsigned)(s[66] & 0xff) << 16) | ((unsigned)(s[99] & 0xff) << 24); }
          unsigned char* dst = WT + (size_t)nn * D + 128 * w + 64 * sb + 32 * hf;
          ((GAS v4u*)dst)[0] = (v4u){q[0], q[1], q[2], q[3]}; ((GAS v4u*)dst)[1] = (v4u){q[4], q[5], q[6], q[7]}; }
        LDS_WAIT(); asm volatile("" ::: "memory");
    }
}
__device__ __forceinline__ void p0_prologue(Frame& F) {
    KArgs A = kargs(); unsigned char* const ws = A->ws;
    LAS float* scr = (LAS float*)(F.lds + RING_OFF + F.wave * 16384);
    for (int item = F.bx; item < P0_WBLOCKS; item += F.G) p0_wblock(A, F, item);
    const size_t gtid = (size_t)F.gw * 64 + F.lane, nthr = (size_t)F.NGW * 64;
    conv_bf16(A->in[I_PSK], (bf16*)(ws + WS_SK), (size_t)DEPTH * 8 * 2 * 128 * 128 / 8, gtid, nthr);
    const int NX = (F.G & 7) == 0 ? 8 : 1, XI = F.bx % NX, RX = M / NX, xw = (F.bx / NX) * NWAVES + F.wave, WX = (F.G / NX) * NWAVES;
    for (int m = RX * XI + xw; m < RX * (XI + 1); m += 2 * WX) {
        const int m1 = m + WX < RX * (XI + 1) ? m + WX : m;
        const GAS f32x4* xa = (const GAS f32x4*)(A->in[I_X] + (size_t)m * D + 16 * F.lane); const GAS f32x4* xb = (const GAS f32x4*)(A->in[I_X] + (size_t)m1 * D + 16 * F.lane);
        f32x4 va[4], vb[4];
#pragma unroll
        for (int j = 0; j < 4; ++j) { va[j] = xa[j]; vb[j] = xb[j]; }
        row_to_i8(F.lane, va, A->in[I_ANW], ws + WS_XN8 + (size_t)m * D, (float*)(ws + WS_AS) + m);
        if (m1 != m) row_to_i8(F.lane, vb, A->in[I_ANW], ws + WS_XN8 + (size_t)m1 * D, (float*)(ws + WS_AS) + m1);
    }
}

__device__ __forceinline__ f32x4 mma16_k64(const LAS bf16* A, int lda, const LAS bf16* B, int ldb, int lane) {
    f32x4 acc = {0.f, 0.f, 0.f, 0.f};
    const LAS bf16* ap = A + (lane & 15) * lda + 8 * (lane >> 4); const LAS bf16* bp = B + (lane & 15) * ldb + 8 * (lane >> 4);
#pragma unroll
    for (int kk = 0; kk < 2; ++kk) { const bf16x8 a = *(const LAS bf16x8*)(ap + kk * 32), b = *(const LAS bf16x8*)(bp + kk * 32); acc = __builtin_amdgcn_mfma_f32_16x16x32_bf16(a, b, acc, 0, 0, 0); }
    return acc;
}
constexpr int LP = 72;
__device__ __forceinline__ void diff_rows(Frame& F, int l) {
    KArgs A = kargs(); unsigned char* const ws = A->ws;
    const int lane = F.lane;
    const float lam_init = 0.8f - 0.6f * expf(-0.3f * (float)l);
    const float s1 = wave_sum(A->in[I_LQ1][l * 64 + lane] * A->in[I_LK1][l * 64 + lane]), s2 = wave_sum(A->in[I_LQ2][l * 64 + lane] * A->in[I_LK2][l * 64 + lane]);
    const float lam = expf(s1) - expf(s2) + lam_init;
    const int hh = lane >> 4, c0 = 8 * (lane & 15);
    float wv[8];
#pragma unroll
    for (int i = 0; i < 8; ++i) wv[i] = A->in[I_DONW][l * 128 + c0 + i] * (1.f - lam_init);
    const bf16* O = (const bf16*)(ws + WS_O); const bf16* MIX = (const bf16*)A->out;
    unsigned char* MIX8 = (unsigned char*)A->out + OUT_MIX8; float* MS = (float*)((unsigned char*)A->out + OUT_MS);
    const int NX = (F.G & 7) == 0 ? 8 : 1, XI = F.bx % NX, RX = M / NX, xw = (F.bx / NX) * NWAVES + F.wave, WX = (F.G / NX) * NWAVES;
    const int tend = RX * (XI + 1), tstep = 4 * WX;
    v4u a[4], b[4], g[4];
#define DR_LOAD(A_, B_, G_, T_) do { _Pragma("unroll") for (int j = 0; j < 4; ++j) { const bf16* orow = O + (size_t)((T_) + j) * 1024 + 256 * hh + c0; \
            A_[j] = *(const GAS v4u*)orow; B_[j] = *(const GAS v4u*)(orow + 128); G_[j] = *(const GAS v4u*)(MIX + (size_t)((T_) + j) * 1024 + 512 + 8 * lane); } } while (0)
    int t0 = RX * XI + 4 * xw;
    if (t0 < tend) DR_LOAD(a, b, g, t0);
    for (; t0 < tend; t0 += tstep) {
        const bool hn = t0 + tstep < tend; v4u an[4], bn[4], gn[4];
        if (hn) DR_LOAD(an, bn, gn, t0 + tstep);
#pragma unroll
        for (int j = 0; j < 4; ++j) {
            const unsigned aw[4] = {a[j].x, a[j].y, a[j].z, a[j].w}, bw[4] = {b[j].x, b[j].y, b[j].z, b[j].w}, gw[4] = {g[j].x, g[j].y, g[j].z, g[j].w};
            float d[8], gv[8]; float ss = 0.f;
#pragma unroll
            for (int i = 0; i < 4; ++i) { d[2 * i] = bflo(aw[i]) - lam * bflo(bw[i]); d[2 * i + 1] = bfhi(aw[i]) - lam * bfhi(bw[i]); ss += d[2 * i] * d[2 * i] + d[2 * i + 1] * d[2 * i + 1]; gv[2 * i] = bflo(gw[i]); gv[2 * i + 1] = bfhi(gw[i]); }
            const float rs = 1.f / sqrtf(row16_sum(ss) * (1.f / 128.f) + RMS_EPS);
            float am = 0.f;
#pragma unroll
            for (int i = 0; i < 8; ++i) { d[i] = bf2f((unsigned short)f2bf(d[i] * rs * wv[i])); am = fmaxf(am, fmaxf(fabsf(d[i]), fabsf(gv[i]))); }
            am = wave_max_nn(am);
            const float inv = am > 0.f ? 127.f / am : 0.f;
            unsigned wd[2], wg[2];
#pragma unroll
            for (int q = 0; q < 2; ++q) {
                const int b0 = (int)rintf(d[4 * q] * inv), b1 = (int)rintf(d[4 * q + 1] * inv), b2 = (int)rintf(d[4 * q + 2] * inv), b3 = (int)rintf(d[4 * q + 3] * inv);
                wd[q] = (unsigned)(b0 & 0xff) | ((unsigned)(b1 & 0xff) << 8) | ((unsigned)(b2 & 0xff) << 16) | ((unsigned)(b3 & 0xff) << 24);
                const int e0 = (int)rintf(gv[4 * q] * inv), e1 = (int)rintf(gv[4 * q + 1] * inv), e2 = (int)rintf(gv[4 * q + 2] * inv), e3 = (int)rintf(gv[4 * q + 3] * inv);
                wg[q] = (unsigned)(e0 & 0xff) | ((unsigned)(e1 & 0xff) << 8) | ((unsigned)(e2 & 0xff) << 16) | ((unsigned)(e3 & 0xff) << 24); }
            unsigned char* mrow = MIX8 + (size_t)(t0 + j) * 1024;
            *(GAS v2u*)(mrow + 128 * hh + c0) = (v2u){wd[0], wd[1]};
            *(GAS v2u*)(mrow + 512 + 8 * lane) = (v2u){wg[0], wg[1]};
            if (lane == 0) MS[t0 + j] = am * (1.f / 127.f);
        }
        if (hn) {
#pragma unroll
            for (int j = 0; j < 4; ++j) { a[j] = an[j]; b[j] = bn[j]; g[j] = gn[j]; } }
    }
#undef DR_LOAD
}
namespace psel {
constexpr int cand_count() { int n = 0; for (int a = 0; a < 16; ++a) for (int b = 0; b < 16; ++b) if ((a + 1) * (b + 1) <= 16) ++n; return n; }
static_assert(cand_count() == 50, "candidate frontier");
constexpr int cand_ab(int idx) { int n = 0; for (int a = 0; a < 16; ++a) for (int b = 0; b < 16; ++b) if ((a + 1) * (b + 1) <= 16) { if (n == idx) return a * 16 + b; ++n; } return 0; }
__device__ __forceinline__ float pmax32(float m) { auto rr = __builtin_amdgcn_permlane32_swap(__float_as_uint(m), __float_as_uint(m), false, false); return fmaxf(__uint_as_float(rr[0]), __uint_as_float(rr[1])); }
__device__ __forceinline__ void ce_desc(float& a, float& b) { const float hi = fmaxf(a, b), lo = fminf(a, b); a = hi; b = lo; }
constexpr unsigned char OE16[63][2] = {{0, 1}, {2, 3}, {0, 2}, {1, 3}, {1, 2}, {4, 5}, {6, 7}, {4, 6}, {5, 7}, {5, 6}, {0, 4}, {2, 6}, {2, 4}, {1, 5}, {3, 7}, {3, 5}, {1, 2}, {3, 4}, {5, 6}, {8, 9}, {10, 11}, {8, 10}, {9, 11}, {9, 10}, {12, 13}, {14, 15}, {12, 14}, {13, 15}, {13, 14}, {8, 12}, {10, 14}, {10, 12}, {9, 13}, {11, 15}, {11, 13}, {9, 10}, {11, 12}, {13, 14}, {0, 8}, {4, 12}, {4, 8}, {2, 10}, {6, 14}, {6, 10}, {2, 4}, {6, 8}, {10, 12}, {1, 9}, {5, 13}, {5, 9}, {3, 11}, {7, 15}, {7, 11}, {3, 5}, {7, 9}, {11, 13}, {1, 2}, {3, 4}, {5, 6}, {7, 8}, {9, 10}, {11, 12}, {13, 14}};
template <int OFF, int NA> __device__ __forceinline__ void sort16_desc(float (&v)[NA]) {
#pragma unroll
    for (int i = 0; i < 63; ++i) ce_desc(v[OFF + OE16[i][0]], v[OFF + OE16[i][1]]);
}
template <int OFF, int NA> __device__ __forceinline__ void merge16_desc(float (&v)[NA]) {
#pragma unroll
    for (int lj = 3; lj >= 0; --lj)
#pragma unroll
        for (int i = 0; i < 16; ++i) { const int l = i ^ (1 << lj); if (l > i) ce_desc(v[OFF + i], v[OFF + l]); }
}
template <int A, int B, int NA> __device__ __forceinline__ void top16_merge(float (&v)[NA]) {
#pragma unroll
    for (int i = 0; i < 16; ++i) v[A + i] = fmaxf(v[A + i], v[B + 15 - i]);
    merge16_desc<A, NA>(v);
}
template <int NA> __device__ __forceinline__ void top16_cross(float (&v)[NA], float (&out)[16]) {
    float lo[16], hi[16];
#pragma unroll
    for (int i = 0; i < 16; ++i) { auto rr = __builtin_amdgcn_permlane32_swap(__float_as_uint(v[i]), __float_as_uint(v[i]), false, false); lo[i] = __uint_as_float(rr[0]); hi[i] = __uint_as_float(rr[1]); }
#pragma unroll
    for (int i = 0; i < 16; ++i) out[i] = fmaxf(lo[i], hi[15 - i]);
    merge16_desc<0, 16>(out);
}
__device__ __forceinline__ void top16_of_128(float (&sc)[64], float (&out)[16]) {
    sort16_desc<0, 64>(sc); sort16_desc<16, 64>(sc); sort16_desc<32, 64>(sc); sort16_desc<48, 64>(sc);
    top16_merge<0, 16, 64>(sc); top16_merge<32, 48, 64>(sc); top16_merge<0, 32, 64>(sc);
    top16_cross<64>(sc, out);
}
template <int S> __device__ __forceinline__ void cand_one(float (&cand)[25], const float (&v0)[16], const float (&v1)[16], bool hi) {
    constexpr int ab0 = cand_ab(2 * S), ab1 = cand_ab(2 * S + 1);
    const float s0 = v0[ab0 >> 4] + v1[ab0 & 15], s1 = v0[ab1 >> 4] + v1[ab1 & 15];
    const float s = hi ? s1 : s0; const unsigned id = hi ? (unsigned)ab1 : (unsigned)ab0;
    cand[S] = __uint_as_float((__float_as_uint(s) & ~0xFFu) | id);
}
template <int... S> __device__ __forceinline__ void cand_all(float (&cand)[25], const float (&v0)[16], const float (&v1)[16], bool hi, std::integer_sequence<int, S...>) { (cand_one<S>(cand, v0, v1, hi), ...); }
__device__ __forceinline__ unsigned lookup7(const unsigned (&tab)[4], unsigned a) {
    const unsigned sel = 0x0c0c0c00u | (a & 7u); const unsigned lo = __builtin_amdgcn_perm(tab[1], tab[0], sel), hi = __builtin_amdgcn_perm(tab[3], tab[2], sel); return (a & 8u) ? hi : lo; }
}
__device__ __forceinline__ void peer_select(Frame& F, int l) {
    KArgs A = kargs(); unsigned char* const ws = A->ws;
    const int lane = F.lane, r32 = lane & 31, hi = lane >> 5;
    const bf16* Q2 = (const bf16*)(ws + WS_Q2); const bf16* SK = (const bf16*)(ws + WS_SK) + (size_t)l * 8 * 2 * 128 * 128;
    unsigned short* IDX = (unsigned short*)(ws + WS_IDX); float* GATE = (float*)(ws + WS_GATE);
    const bool aff = F.G == 256; const int h = aff ? (F.bx >> 3) & 7 : F.bx & 7, jb = F.bx >> 3; constexpr int KP = 136;
    LAS bf16* KL = (LAS bf16*)F.lds;
#pragma unroll
    for (int i = 0; i < 8; ++i) { const int p = F.tid + 512 * i, row = p >> 4, j = p & 15; *(LAS v4u*)(KL + row * KP + 8 * j) = *(const GAS v4u*)(SK + ((size_t)h * 256 + row) * 128 + 8 * j); }
    __syncthreads();
    const int tg0 = aff ? 128 * (F.bx & 7) + 32 * (F.bx >> 6) + F.wave : jb * 8 + F.wave, tg1 = aff ? 128 * (F.bx & 7) + 32 * (F.bx >> 6) + 32 : M / 32, tgs = aff ? 8 : (F.G >> 3) * 8;
    for (int tg = tg0; tg < tg1; tg += tgs) {
        const size_t tok = (size_t)tg * 32 + r32;
        bf16x8 bq[2][8];
#pragma unroll
        for (int c = 0; c < 2; ++c)
#pragma unroll
            for (int ks = 0; ks < 8; ++ks) bq[c][ks] = *(const GAS bf16x8*)(Q2 + tok * 2048 + (h * 2 + c) * 128 + ks * 16 + 8 * hi);
        float ts[2][16];
#pragma unroll
        for (int c = 0; c < 2; ++c) {
            f32x16 acc[4];
#pragma unroll
            for (int mt = 0; mt < 4; ++mt) acc[mt] = f32x16{};
            const LAS bf16* kp = KL + (c * 128 + r32) * KP + 8 * hi;
#pragma unroll
            for (int ks = 0; ks < 8; ++ks)
#pragma unroll
                for (int mt = 0; mt < 4; ++mt) { const bf16x8 ak = *(const LAS bf16x8*)(kp + mt * 32 * KP + ks * 16); acc[mt] = __builtin_amdgcn_mfma_f32_32x32x16_bf16(ak, bq[c][ks], acc[mt], 0, 0, 0); }
            float sc[64];
#pragma unroll
            for (int mt = 0; mt < 4; ++mt)
#pragma unroll
                for (int r = 0; r < 16; ++r) { const unsigned key = (unsigned)(32 * mt + (r & 3) + 8 * (r >> 2) + 4 * hi); sc[mt * 16 + r] = __uint_as_float((__float_as_uint(acc[mt][r]) & ~0x7Fu) | key); }
            __builtin_amdgcn_sched_barrier(0);
            psel::top16_of_128(sc, ts[c]);
            __builtin_amdgcn_sched_barrier(0);
        }
        unsigned kt0[4], kt1[4]; float v0[16], v1[16];
#pragma unroll
        for (int q = 0; q < 4; ++q) { kt0[q] = 0u; kt1[q] = 0u;
#pragma unroll
            for (int j = 0; j < 4; ++j) { kt0[q] |= (__float_as_uint(ts[0][4 * q + j]) & 0x7Fu) << (8 * j); kt1[q] |= (__float_as_uint(ts[1][4 * q + j]) & 0x7Fu) << (8 * j); } }
#pragma unroll
        for (int i = 0; i < 16; ++i) { v0[i] = __uint_as_float(__float_as_uint(ts[0][i]) & ~0x7Fu); v1[i] = __uint_as_float(__float_as_uint(ts[1][i]) & ~0x7Fu); }
        float cand[25];
        psel::cand_all(cand, v0, v1, hi != 0, std::make_integer_sequence<int, 25>{});
        float c32[32];
#pragma unroll
        for (int i = 0; i < 25; ++i) c32[i] = cand[i];
#pragma unroll
        for (int i = 25; i < 32; ++i) c32[i] = -INFINITY;
        psel::sort16_desc<0, 32>(c32); psel::sort16_desc<16, 32>(c32); psel::top16_merge<0, 16, 32>(c32);
        float best[16];
        psel::top16_cross<32>(c32, best);
        int ex[16];
#pragma unroll
        for (int k = 0; k < 16; ++k) { const unsigned bb = __float_as_uint(best[k]); ex[k] = (int)(psel::lookup7(kt0, (bb >> 4) & 15u) * 128u + psel::lookup7(kt1, bb & 15u)); }
        if (hi == 0) { GAS v4u* o = (GAS v4u*)(IDX + tok * 128 + h * 16);
#pragma unroll
            for (int q = 0; q < 2; ++q) o[q] = (v4u){(unsigned)ex[8 * q] | ((unsigned)ex[8 * q + 1] << 16), (unsigned)ex[8 * q + 2] | ((unsigned)ex[8 * q + 3] << 16), (unsigned)ex[8 * q + 4] | ((unsigned)ex[8 * q + 5] << 16), (unsigned)ex[8 * q + 6] | ((unsigned)ex[8 * q + 7] << 16)}; }
        else {
            float mx = __uint_as_float(__float_as_uint(best[0]) & ~0xFFu); float g[16]; float sum = 0.f;
#pragma unroll
            for (int k = 0; k < 16; ++k) { g[k] = __expf(__uint_as_float(__float_as_uint(best[k]) & ~0xFFu) - mx); sum += g[k]; }
            const float inv = 1.f / sum; GAS f32x4* o = (GAS f32x4*)(GATE + tok * 128 + h * 16);
#pragma unroll
            for (int q = 0; q < 4; ++q) o[q] = (f32x4){g[4 * q] * inv, g[4 * q + 1] * inv, g[4 * q + 2] * inv, g[4 * q + 3] * inv}; }
    }
}
__device__ __forceinline__ float gelu_erf(float x) { return 0.5f * x * (1.f + erff(x * 0.70710678118654752f)); }
__device__ __forceinline__ float dppf(float v, const int ctrl_sel) {
    const int x = __builtin_bit_cast(int, v);
    int r;
    if (ctrl_sel == 0) r = __builtin_amdgcn_update_dpp(0, x, 0xB1, 0xf, 0xf, true);
    else if (ctrl_sel == 1) r = __builtin_amdgcn_update_dpp(0, x, 0x4E, 0xf, 0xf, true);
    else if (ctrl_sel == 2) r = __builtin_amdgcn_update_dpp(0, x, 0x141, 0xf, 0xf, true);
    else r = __builtin_amdgcn_update_dpp(0, x, 0x128, 0xf, 0xf, true);
    return __builtin_bit_cast(float, r);
}
__device__ __forceinline__ float swap_add32(float a, float b) { auto rr = __builtin_amdgcn_permlane32_swap(__float_as_uint(a), __float_as_uint(b), false, false); return __uint_as_float(rr[0]) + __uint_as_float(rr[1]); }
__device__ __forceinline__ float swap_add16(float a, float b) { auto rr = __builtin_amdgcn_permlane16_swap(__float_as_uint(a), __float_as_uint(b), false, false); return __uint_as_float(rr[0]) + __uint_as_float(rr[1]); }
__device__ __forceinline__ float reduce8(const float (&p)[8], int lane) {
    const float r0 = swap_add32(p[0], p[4]), r1 = swap_add32(p[1], p[5]), r2 = swap_add32(p[2], p[6]), r3 = swap_add32(p[3], p[7]);
    const float s0 = swap_add16(r0, r2), s1 = swap_add16(r1, r3);
    const bool b3 = (lane & 8) != 0;
    const float keep = b3 ? s1 : s0, send = b3 ? s0 : s1;
    float z = keep + dppf(send, 3);
    z += dppf(z, 0); z += dppf(z, 1); z += dppf(z, 2);
    return z;
}
__device__ __forceinline__ float ub(unsigned w, int k) { return (float)((w >> (8 * k)) & 0xffu); }
constexpr int PEER_TG = 4, PEER_NGRP = M / PEER_TG;
constexpr int CW_PEER = 8192;
__device__ __forceinline__ int peer_dequeue(gu32* ctr, int lane) {
    unsigned v = 0u; if (lane == 0) v = __hip_atomic_fetch_add(ctr, 1u, __ATOMIC_RELAXED, __HIP_MEMORY_SCOPE_AGENT);
    return __builtin_amdgcn_readfirstlane((int)v);
}
__device__ __forceinline__ unsigned peer_dequeue_issue(gu32* ctr, int lane) { unsigned v = 0u, off = 0u; asm volatile("" : "+v"(off));
    if (lane == 0) v = __hip_atomic_fetch_add(ctr + off, 1u, __ATOMIC_RELAXED, __HIP_MEMORY_SCOPE_AGENT); return v; }
__device__ __forceinline__ int peer_dequeue_get(unsigned v) { asm volatile("" : "+v"(v) :: "memory"); return __builtin_amdgcn_readfirstlane((int)v); }
struct HalfBuf { v4u p[8]; };
struct IdSet { v4u id[2]; };
struct TokAux { v4u a[2]; };
__device__ __forceinline__ void ps_ids(IdSet& I, const unsigned short* idrow) {
#pragma unroll
    for (int q = 0; q < 2; ++q) I.id[q] = ((const GAS v4u*)idrow)[q];
}
template <int HALF_> __device__ __forceinline__ void ps_gather(HalfBuf& B, const unsigned char* tab_slice, const IdSet& I, int c) {
    const unsigned c16 = 16u * (unsigned)c;
#pragma unroll
    for (int i = 0; i < 8; ++i) { const unsigned w = I.id[HALF_][i >> 1]; const unsigned e = (i & 1) ? w >> 16 : w & 0xffffu; B.p[i] = *(const GAS v4u*)(tab_slice + (e * 128u + c16)); }
}
__device__ __forceinline__ int dppi(int x, const int sel) {
    if (sel == 0) return __builtin_amdgcn_update_dpp(0, x, 0xB1, 0xf, 0xf, true);
    if (sel == 1) return __builtin_amdgcn_update_dpp(0, x, 0x4E, 0xf, 0xf, true);
    return __builtin_amdgcn_update_dpp(0, x, 0x141, 0xf, 0xf, true);
}
struct UState { int hq[4]; float sc; };
template <int HALF_> __device__ __forceinline__ void ps_compute_u(const HalfBuf& B, const TokAux& X, UState& U, bf16* part_row, int g, int c) {
    if (HALF_ == 0) {
        const unsigned rw[8] = {X.a[0].x, X.a[0].y, X.a[0].z, X.a[0].w, X.a[1].x, X.a[1].y, X.a[1].z, X.a[1].w};
        float a[16]; float mx = 0.f;
#pragma unroll
        for (int q = 0; q < 8; ++q) { a[2 * q] = bflo(rw[q]); a[2 * q + 1] = bfhi(rw[q]); mx = fmaxf(mx, fmaxf(fabsf(a[2 * q]), fabsf(a[2 * q + 1]))); }
        mx = fmaxf(mx, dppf(mx, 0)); mx = fmaxf(mx, dppf(mx, 1)); mx = fmaxf(mx, dppf(mx, 2));
        const float inv = mx > 0.f ? 127.f / mx : 0.f; U.sc = mx * (1.f / 127.f);
#pragma unroll
        for (int q = 0; q < 4; ++q) { const int b0 = (int)rintf(a[4 * q] * inv), b1 = (int)rintf(a[4 * q + 1] * inv), b2 = (int)rintf(a[4 * q + 2] * inv), b3 = (int)rintf(a[4 * q + 3] * inv);
            U.hq[q] = (int)((unsigned)(b0 & 0xff) | ((unsigned)(b1 & 0xff) << 8) | ((unsigned)(b2 & 0xff) << 16) | ((unsigned)(b3 & 0xff) << 24)); }
    }
    int d[8];
#pragma unroll
    for (int i = 0; i < 8; ++i) { int x = __builtin_amdgcn_sdot4((int)B.p[i].x, U.hq[0], 0, false); x = __builtin_amdgcn_sdot4((int)B.p[i].y, U.hq[1], x, false);
        x = __builtin_amdgcn_sdot4((int)B.p[i].z, U.hq[2], x, false); x = __builtin_amdgcn_sdot4((int)B.p[i].w, U.hq[3], x, false);
        x += dppi(x, 0); x += dppi(x, 1); x += dppi(x, 2); d[i] = x; }
    const float sc = U.sc;
    if (c == 0) *(GAS v4u*)(part_row + 16 * g + 8 * HALF_) = (v4u){pk2((float)d[0] * sc, (float)d[1] * sc), pk2((float)d[2] * sc, (float)d[3] * sc), pk2((float)d[4] * sc, (float)d[5] * sc), pk2((float)d[6] * sc, (float)d[7] * sc)};
}
struct VState { int acc[16]; };
template <int HALF_, bool LAST> __device__ __forceinline__ void ps_compute_v(const HalfBuf& B, const TokAux& X, VState& S, const bf16* res_cols, bf16* res_w, float* out_cols  , int lane) {
    if (HALF_ == 0) {
#pragma unroll
        for (int j = 0; j < 16; ++j) S.acc[j] = 0; }
    const unsigned wq[4] = {X.a[0].x, X.a[0].y, X.a[0].z, X.a[0].w};
#pragma unroll
    for (int q = 0; q < 2; ++q) {
        const unsigned pa[4] = {B.p[4 * q].x, B.p[4 * q].y, B.p[4 * q].z, B.p[4 * q].w}, pb[4] = {B.p[4 * q + 1].x, B.p[4 * q + 1].y, B.p[4 * q + 1].z, B.p[4 * q + 1].w};
        const unsigned pc[4] = {B.p[4 * q + 2].x, B.p[4 * q + 2].y, B.p[4 * q + 2].z, B.p[4 * q + 2].w}, pd[4] = {B.p[4 * q + 3].x, B.p[4 * q + 3].y, B.p[4 * q + 3].z, B.p[4 * q + 3].w};
        const int wv = (int)wq[2 * HALF_ + q];
#pragma unroll
        for (int p = 0; p < 4; ++p) {
            const unsigned ab_lo = __builtin_amdgcn_perm(pb[p], pa[p], 0x05010400u), ab_hi = __builtin_amdgcn_perm(pb[p], pa[p], 0x07030602u);
            const unsigned cd_lo = __builtin_amdgcn_perm(pd[p], pc[p], 0x05010400u), cd_hi = __builtin_amdgcn_perm(pd[p], pc[p], 0x07030602u);
            const unsigned t0 = __builtin_amdgcn_perm(cd_lo, ab_lo, 0x05040100u), t1 = __builtin_amdgcn_perm(cd_lo, ab_lo, 0x07060302u);
            const unsigned t2 = __builtin_amdgcn_perm(cd_hi, ab_hi, 0x05040100u), t3 = __builtin_amdgcn_perm(cd_hi, ab_hi, 0x07060302u);
            S.acc[4 * p] = __builtin_amdgcn_sdot4((int)t0, wv, S.acc[4 * p], false); S.acc[4 * p + 1] = __builtin_amdgcn_sdot4((int)t1, wv, S.acc[4 * p + 1], false);
            S.acc[4 * p + 2] = __builtin_amdgcn_sdot4((int)t2, wv, S.acc[4 * p + 2], false); S.acc[4 * p + 3] = __builtin_amdgcn_sdot4((int)t3, wv, S.acc[4 * p + 3], false);
        }
    }
    if (HALF_ == 1) {
        const float sc = __uint_as_float(X.a[1].x);
        float fa[16];
#pragma unroll
        for (int j = 0; j < 16; ++j) fa[j] = (float)S.acc[j] * sc;
        float r[8];
#pragma unroll
        for (int j = 0; j < 8; ++j) r[j] = swap_add32(fa[j], fa[j + 8]);
        float s4[4];
#pragma unroll
        for (int j = 0; j < 4; ++j) s4[j] = swap_add16(r[j], r[j + 4]);
        const bool b3 = (lane & 8) != 0;
        float z[2];
#pragma unroll
        for (int j = 0; j < 2; ++j) { const float keep = b3 ? s4[j + 2] : s4[j], send = b3 ? s4[j] : s4[j + 2]; z[j] = keep + dppf(send, 3); }
        const int col = 16 * (lane & 7) + 2 * (lane >> 3);
        const unsigned rw = *(const GAS unsigned*)(res_cols + col);
        const float y0 = bflo(rw) + z[0], y1 = bfhi(rw) + z[1];
        if (LAST) { typedef float f32x2v __attribute__((ext_vector_type(2))); *(GAS f32x2v*)(out_cols + col) = (f32x2v){y0, y1}; }
        else *(GAS unsigned*)(res_w + col) = pk2(y0, y1);
    }
}
template <bool IS_V, bool DRY = false, bool LAST = false> __device__ __forceinline__ void peer_sliced(Frame& F, int l) {
    KArgs A = kargs(); unsigned char* const ws = A->ws;
    const int lane = F.lane, g = lane >> 3, c = lane & 7;
    const int xcc = (int)(xb_xcc_id() & 7u);
    gu32* ctr0 = (gu32*)(ws + WS_CTL) + CW_PEER + 64 * ((l * 4 + (IS_V ? 1 : 0) + (DRY ? 2 : 0)) * 8);
    const unsigned short* IDX = (const unsigned short*)(ws + WS_IDX);
    for (int s = 0; s < 8; ++s) {
        const int k = (xcc + s) & 7; gu32* ctr = ctr0 + 64 * k;
        const unsigned char* tab = ws + (IS_V ? WS_TV : WS_TU) + ((size_t)(l * 8 + k) * NEXP) * 128;
        int cur = peer_dequeue(ctr, lane);
        if (cur < PEER_NGRP) {
            size_t t0 = (size_t)cur * PEER_TG;
            HalfBuf H0, H1, H2, H3; IdSet I0, I1; TokAux X0, X1, X2, X3; UState US; VState VS;
#define PS_IDS(IS, t) ps_ids(IS, IDX + (t) * 128 + 16 * g)
#define PS_AUX(XS, t) do { if (IS_V) { XS.a[0] = *(const GAS v4u*)(ws + WS_EW8 + (t) * 128 + 16 * g); XS.a[1].x = __float_as_uint(((const float*)(ws + WS_EWSC))[(t) * 8 + g]); } \
                           else { const GAS v4u* rp_ = (const GAS v4u*)((const bf16*)(ws + WS_RES) + (t) * D + 128 * k + 16 * c); XS.a[0] = rp_[0]; XS.a[1] = rp_[1]; } } while (0)
#define PS_G(HB, IS, hf) ps_gather<hf>(HB, tab, IS, c)
#define PS_C(HB, XS, t, hf) do { if (IS_V) ps_compute_v<hf, LAST>(HB, XS, VS, (const bf16*)(ws + WS_RES) + (t) * D + 128 * k, (bf16*)(ws + (DRY ? WS_Q2 : WS_RES)) + (t) * D + 128 * k, (DRY ? (float*)(ws + WS_Q2) : A->out) + (t) * D + 128 * k, lane); \
                                 else ps_compute_u<hf>(HB, XS, US, (bf16*)(ws + WS_PART) + ((size_t)k * M + (t)) * 128, g, c); } while (0)
            PS_IDS(I0, t0); PS_IDS(I1, t0 + 1); PS_AUX(X0, t0); PS_G(H0, I0, 0); PS_G(H1, I0, 1); PS_AUX(X1, t0 + 1); PS_G(H2, I1, 0);
            for (;;) {
                const unsigned nxt_v = peer_dequeue_issue(ctr, lane);
                PS_IDS(I0, t0 + 2);                    PS_G(H3, I1, 1); PS_C(H0, X0, t0, 0);
                PS_AUX(X2, t0 + 2);                    PS_G(H0, I0, 0); PS_C(H1, X0, t0, 1);
                PS_IDS(I1, t0 + 3);                    PS_G(H1, I0, 1); PS_C(H2, X1, t0 + 1, 0);
                PS_AUX(X3, t0 + 3);                    PS_G(H2, I1, 0); PS_C(H3, X1, t0 + 1, 1);
                const int nxt = peer_dequeue_get(nxt_v);
                const bool more = nxt < PEER_NGRP; const size_t t1 = (size_t)nxt * PEER_TG;
                if (more) PS_IDS(I0, t1);              PS_G(H3, I1, 1); PS_C(H0, X2, t0 + 2, 0);
                if (more) { PS_AUX(X0, t1);            PS_G(H0, I0, 0); } PS_C(H1, X2, t0 + 2, 1);
                if (more) { PS_IDS(I1, t1 + 1);        PS_G(H1, I0, 1); } PS_C(H2, X3, t0 + 3, 0);
                if (more) { PS_AUX(X1, t1 + 1);        PS_G(H2, I1, 0); } PS_C(H3, X3, t0 + 3, 1);
                if (!more) break;
                t0 = t1;
            }
#undef PS_IDS
#undef PS_AUX
#undef PS_G
#undef PS_C
        }
    }
}
__device__ __forceinline__ void peer_w(Frame& F, int l) {
    KArgs A = kargs(); unsigned char* const ws = A->ws;
    const unsigned short* IDX = (const unsigned short*)(ws + WS_IDX); const float* GATE = (const float*)(ws + WS_GATE); const bf16* PART = (const bf16*)(ws + WS_PART);
    const float* USC = (const float*)(ws + WS_USC) + l * NEXP; const float* VSC = (const float*)(ws + WS_VSC) + l * NEXP; const float* HS = (const float*)(ws + WS_RS);
    signed char* WQ = (signed char*)(ws + WS_EW8); float* WSC = (float*)(ws + WS_EWSC);
    LAS float* UL = (LAS float*)F.lds; LAS float* VL = UL + NEXP;
    for (int i = F.tid; i < NEXP / 4; i += NWAVES * 64) { ((LAS f32x4*)UL)[i] = ((const GAS f32x4*)USC)[i]; ((LAS f32x4*)VL)[i] = ((const GAS f32x4*)VSC)[i]; }
    __syncthreads();
    const size_t nthr = (size_t)F.NGW * 64;
    const size_t iend = (size_t)M * 128, istep = 4 * nthr; size_t i0 = (size_t)F.gw * 64 + F.lane;
    unsigned pr[4][8]; int e[4]; float gt[4], hs[4];
#define W_LOAD(PR_, E_, GT_, HS_, I_) do { _Pragma("unroll") for (int j = 0; j < 4; ++j) { const size_t i = (I_) + j * nthr; \
            _Pragma("unroll") for (int k = 0; k < 8; ++k) PR_[j][k] = PART[(size_t)k * M * 128 + i]; \
            E_[j] = IDX[i]; GT_[j] = GATE[i]; HS_[j] = HS[i >> 7]; } } while (0)
    if (i0 < iend) W_LOAD(pr, e, gt, hs, i0);
    for (; i0 < iend; i0 += istep) {
        const bool hn = i0 + istep < iend; unsigned prn[4][8]; int en[4]; float gtn[4], hsn[4];
        if (hn) W_LOAD(prn, en, gtn, hsn, i0 + istep);
#pragma unroll
        for (int j = 0; j < 4; ++j) { const size_t i = i0 + j * nthr; float p = 0.f;
#pragma unroll
            for (int k = 0; k < 8; ++k) p += bf2f((unsigned short)pr[j][k]);
            const float dot = p * UL[e[j]] * hs[j];
            const float w = gt[j] * gelu_erf(dot) * VL[e[j]];
            float m = fabsf(w);
            m = fmaxf(m, dppf(m, 0)); m = fmaxf(m, dppf(m, 1)); m = fmaxf(m, dppf(m, 2));
            m = fmaxf(m, __builtin_bit_cast(float, __builtin_amdgcn_update_dpp(0, __builtin_bit_cast(int, m), 0x140, 0xf, 0xf, true)));
            const float inv = m > 0.f ? 127.f / m : 0.f;
            WQ[i] = (signed char)(int)rintf(w * inv);
            if ((F.lane & 15) == 0) WSC[i >> 4] = m * (1.f / 127.f); }
        if (hn) {
#pragma unroll
            for (int j = 0; j < 4; ++j) { e[j] = en[j]; gt[j] = gtn[j]; hs[j] = hsn[j];
#pragma unroll
                for (int k = 0; k < 8; ++k) pr[j][k] = prn[j][k]; } }
    }
#undef W_LOAD
}

#define GBAR() asm volatile("s_waitcnt lgkmcnt(0)\n\ts_barrier" ::: "memory")
namespace glas {
constexpr int LPQ = 72, LPG = 136, GP = 65;
constexpr int O_GF = 0, O_TT = 64 * GP * 4, O_BL = O_TT + 2048, O_KR = O_BL + 256, O_KRT = O_KR + 9216, O_QR = O_KRT + 9216, O_QD = O_QR  , O_KI = O_KR  , O_KDT = O_QR + 9216, O_VT = O_KDT + 9216,
              O_AM = O_VT + 18432, O_GO = O_AM + 9216, O_OST = O_GO + 64 * LPG * 2, O_DEC = O_OST + 64 * LPG * 2, O_SS = O_DEC + 256, O_RS = O_SS + 2048  , O_END = O_RS + 2048;
static_assert(O_END <= 131072 && O_TT % 16 == 0 && O_KR % 16 == 0 && O_DEC % 16 == 0 && O_SS % 16 == 0, "gla LDS");
struct Pre { v4u g[2], go[2], q, v[2], k; };
template <int PASS> __device__ __forceinline__ void prefetch(Pre& P, const unsigned char* ws, size_t t0, int hh, int tid) {
    const float* GLOG = (const float*)(ws + WS_GLOG); const bf16* GQ = (const bf16*)(ws + WS_GQ); const bf16* GK = (const bf16*)(ws + WS_GK); const bf16* GV = (const bf16*)(ws + WS_GV); const bf16* GO = (const bf16*)(ws + WS_GO);
#pragma unroll
    for (int i = 0; i < 2; ++i) { const int p = tid + 512 * i, c = p >> 4, j = p & 15;
        P.g[i] = *(const GAS v4u*)(GLOG + (t0 + c) * 256 + hh * 64 + 4 * j);
        if (PASS == 2) P.go[i] = *(const GAS v4u*)(GO + (t0 + c) * 512 + hh * 128 + 8 * j);
        const int cv = tid & 63, jv = (tid >> 6) + 8 * i;
        P.v[i] = *(const GAS v4u*)(GV + (t0 + cv) * 512 + hh * 128 + 8 * jv); }
    if (PASS == 2) { const int c = tid >> 3, j = tid & 7; P.q = *(const GAS v4u*)(GQ + (t0 + c) * 256 + hh * 64 + 8 * j); }
    { const int c = tid & 63, j = tid >> 6; P.k = *(const GAS v4u*)(GK + (t0 + c) * 256 + hh * 64 + 8 * j); }
}
__device__ __forceinline__ float rowsum16(float v) {
    v += dppf(v, 0); v += dppf(v, 1); v += dppf(v, 2);
    v += __builtin_bit_cast(float, __builtin_amdgcn_update_dpp(0, __builtin_bit_cast(int, v), 0x140, 0xf, 0xf, true));
    return v;
}
}
template <int PASS> __device__ __forceinline__ void gla_run(Frame& F, int l, int run) {
    using namespace glas;
    KArgs A = kargs(); unsigned char* const ws = A->ws;
    const int bh = run >> 4, n0 = (run & 15) * 8, b = bh >> 2, hh = bh & 3, tid = F.tid, lane = F.lane, w = F.wave, q4 = lane >> 4, r16 = lane & 15;
    LAS float* Gf = (LAS float*)(F.lds + O_GF); LAS float* Tt = (LAS float*)(F.lds + O_TT); LAS float* BL = (LAS float*)(F.lds + O_BL);
    LAS bf16* Kr = (LAS bf16*)(F.lds + O_KR); LAS bf16* KrT = (LAS bf16*)(F.lds + O_KRT); LAS bf16* Qr = (LAS bf16*)(F.lds + O_QR); LAS bf16* Qd = (LAS bf16*)(F.lds + O_QD); LAS bf16* Ki = (LAS bf16*)(F.lds + O_KI);
    LAS bf16* KdT = (LAS bf16*)(F.lds + O_KDT); LAS bf16* VT = (LAS bf16*)(F.lds + O_VT); LAS bf16* Am = (LAS bf16*)(F.lds + O_AM); LAS bf16* GOs = (LAS bf16*)(F.lds + O_GO); LAS bf16* Ost = (LAS bf16*)(F.lds + O_OST);
    LAS float* DEC = (LAS float*)(F.lds + O_DEC); LAS float* SS = (LAS float*)(F.lds + O_SS); LAS float* RSL = (LAS float*)(F.lds + O_RS) + 64 * F.wave;
    bf16* MIX = (bf16*)A->out;
    float* USUM = (float*)(ws + WS_USUM); float* PDS = (float*)(ws + WS_PDS);
    const float wg = A->in[I_GONW][l * 128 + 16 * w + r16];
    f32x4 S[4], pd[4];
#pragma unroll
    for (int t = 0; t < 4; ++t) { S[t] = (f32x4){0.f, 0.f, 0.f, 0.f}; pd[t] = (f32x4){1.f, 1.f, 1.f, 1.f}; }
    Pre P; prefetch<PASS>(P, ws, (size_t)b * T + (size_t)n0 * 64, hh, tid);
    if (PASS == 2) {
        int rp = run & ~15;
        for (; rp + 2 <= run; rp += 2) {
            f32x4 us[2][4], ps[2][4];
#pragma unroll
            for (int j = 0; j < 2; ++j)
#pragma unroll
                for (int t = 0; t < 4; ++t) { us[j][t] = *(const GAS f32x4*)(USUM + ((size_t)(rp + j) * 512 + tid) * 16 + 4 * t); ps[j][t] = *(const GAS f32x4*)(PDS + (size_t)(rp + j) * 64 + 16 * t + 4 * q4); }
#pragma unroll
            for (int j = 0; j < 2; ++j)
#pragma unroll
                for (int t = 0; t < 4; ++t) S[t] = S[t] * ps[j][t] + us[j][t];
        }
        for (; rp < run; ++rp) {
#pragma unroll
            for (int t = 0; t < 4; ++t) { const f32x4 us = *(const GAS f32x4*)(USUM + ((size_t)rp * 512 + tid) * 16 + 4 * t), ps = *(const GAS f32x4*)(PDS + (size_t)rp * 64 + 16 * t + 4 * q4); S[t] = S[t] * ps + us; }
        }
    }
    for (int nn = 0; nn <= 8; ++nn) {
        const int n = n0 + nn;
        const size_t t0 = (size_t)b * T + (size_t)n * 64;
        if (nn == 8) {
            if (PASS == 2 && nn > 0) {
#pragma unroll
                for (int i = 0; i < 2; ++i) { const int p = tid + 512 * i, c = p >> 4, j = p & 15;
                    *(GAS v4u*)(MIX + (t0 - 64 + c) * 1024 + 512 + hh * 128 + 8 * j) = *(const LAS v4u*)(Ost + c * LPG + 8 * j); }
            }
            break;
        }
#pragma unroll
        for (int i = 0; i < 2; ++i) { const int p = tid + 512 * i, c = p >> 4, j = p & 15;
            Gf[c * GP + 4 * j] = __uint_as_float(P.g[i].x); Gf[c * GP + 4 * j + 1] = __uint_as_float(P.g[i].y); Gf[c * GP + 4 * j + 2] = __uint_as_float(P.g[i].z); Gf[c * GP + 4 * j + 3] = __uint_as_float(P.g[i].w);
            if (PASS == 2) *(LAS v4u*)(GOs + c * LPG + 8 * j) = P.go[i];
            const int cv = tid & 63, jv = (tid >> 6) + 8 * i; const unsigned vv[4] = {P.v[i].x, P.v[i].y, P.v[i].z, P.v[i].w};
#pragma unroll
            for (int e = 0; e < 4; ++e) { VT[(8 * jv + 2 * e) * LPQ + cv] = (bf16)(vv[e] & 0xffffu); VT[(8 * jv + 2 * e + 1) * LPQ + cv] = (bf16)(vv[e] >> 16); } }
        if (PASS == 2) { const int c = tid >> 3, j = tid & 7; *(LAS v4u*)(Qr + c * LPQ + 8 * j) = P.q; }
        { const int c = tid & 63, j = tid >> 6; *(LAS v4u*)(Kr + c * LPQ + 8 * j) = P.k; const unsigned kk[4] = {P.k.x, P.k.y, P.k.z, P.k.w};
#pragma unroll
          for (int e = 0; e < 4; ++e) { KrT[(8 * j + 2 * e) * LPQ + c] = (bf16)(kk[e] & 0xffffu); KrT[(8 * j + 2 * e + 1) * LPQ + c] = (bf16)(kk[e] >> 16); } }
        if (PASS == 2 && nn > 0) {
#pragma unroll
            for (int i = 0; i < 2; ++i) { const int p = tid + 512 * i, c = p >> 4, j = p & 15;
                *(GAS v4u*)(MIX + (t0 - 64 + c) * 1024 + 512 + hh * 128 + 8 * j) = *(const LAS v4u*)(Ost + c * LPG + 8 * j); }
        }
        if (nn + 1 < 8) prefetch<PASS>(P, ws, t0 + 64, hh, tid);
        GBAR();
        { const int d = tid & 63, seg = tid >> 6; float bv[8]; float run = 0.f;
#pragma unroll
          for (int i = 0; i < 8; ++i) { run += Gf[(8 * seg + i) * GP + d]; bv[i] = run; }
          Tt[seg * 64 + d] = run;
          GBAR();
          float off = 0.f, bl = 0.f;
#pragma unroll
          for (int s = 0; s < 8; ++s) { const float tt = Tt[s * 64 + d]; bl += tt; off += (s < seg) ? tt : 0.f; }
          if (seg == 0) { DEC[d] = __expf(bl); BL[d] = bl; }
#pragma unroll
          for (int i = 0; i < 8; ++i) { const int c = 8 * seg + i; const float bc = bv[i] + off; Gf[c * GP + d] = bc;
              if (PASS == 2) { const float q = bf2f(Qr[c * LPQ + d]), k = bf2f(Kr[c * LPQ + d]);
                  Qd[c * LPQ + d] = (bf16)f2bf(q * 0.125f * __expf(bc)); Ki[c * LPQ + d] = (bf16)f2bf(k * __expf(-bc)); } } }
        GBAR();
        { const int c = tid & 63, dseg = tid >> 6;
#pragma unroll
          for (int i = 0; i < 8; ++i) { const int d = 8 * dseg + i; KdT[d * LPQ + c] = (bf16)f2bf(bf2f(KrT[d * LPQ + c]) * __expf(BL[d] - Gf[c * GP + d])); } }
        if (PASS == 2) { const int ti = w >> 1;
#pragma unroll
          for (int tjj = 0; tjj < 2; ++tjj) { const int tj = 2 * (w & 1) + tjj; const f32x4 a = mma16_k64(Qd + 16 * ti * LPQ, LPQ, Ki + 16 * tj * LPQ, LPQ, lane);
#pragma unroll
              for (int r = 0; r < 4; ++r) { const int i = 16 * ti + 4 * q4 + r, j = 16 * tj + r16; Am[i * LPQ + j] = (bf16)f2bf(i >= j ? a[r] : 0.f); } } }
        GBAR();
        f32x4 o[4];
        if (PASS == 2) { bf16x8 sb[2];
#pragma unroll
          for (int kk = 0; kk < 2; ++kk) { v4u pk; pk.x = pk2(S[2 * kk][0], S[2 * kk][1]); pk.y = pk2(S[2 * kk][2], S[2 * kk][3]); pk.z = pk2(S[2 * kk + 1][0], S[2 * kk + 1][1]); pk.w = pk2(S[2 * kk + 1][2], S[2 * kk + 1][3]); sb[kk] = __builtin_bit_cast(bf16x8, pk); }
#pragma unroll
          for (int ti = 0; ti < 4; ++ti) { f32x4 acc = mma16_k64(Am + 16 * ti * LPQ, LPQ, VT + 16 * w * LPQ, LPQ, lane);
#pragma unroll
              for (int kk = 0; kk < 2; ++kk) { const LAS bf16* qp = Qd + (16 * ti + r16) * LPQ + 32 * kk + 4 * q4;
                  const v2u lo = *(const LAS v2u*)qp, hi = *(const LAS v2u*)(qp + 16); v4u av; av.x = lo.x; av.y = lo.y; av.z = hi.x; av.w = hi.y;
                  acc = __builtin_amdgcn_mfma_f32_16x16x32_bf16(__builtin_bit_cast(bf16x8, av), sb[kk], acc, 0, 0, 0); }
              o[ti] = acc; } }
#pragma unroll
        for (int t = 0; t < 4; ++t) { const f32x4 dv = *(const LAS f32x4*)(DEC + 16 * t + 4 * q4); f32x4 acc = S[t] * dv;
            pd[t] = pd[t] * dv;
            const LAS bf16* ap = KdT + (16 * t + r16) * LPQ + 8 * q4; const LAS bf16* bp = VT + (16 * w + r16) * LPQ + 8 * q4;
#pragma unroll
            for (int kk = 0; kk < 2; ++kk) acc = __builtin_amdgcn_mfma_f32_16x16x32_bf16(*(const LAS bf16x8*)(ap + 32 * kk), *(const LAS bf16x8*)(bp + 32 * kk), acc, 0, 0, 0);
            S[t] = acc; }
        if (PASS == 1) { GBAR(); continue; }
#pragma unroll
        for (int ti = 0; ti < 4; ++ti)
#pragma unroll
            for (int r = 0; r < 4; ++r) { const float s = rowsum16(o[ti][r] * o[ti][r]); if (r16 == 0) SS[w * 64 + 16 * ti + 4 * q4 + r] = s; }
        GBAR();
        { const int cp = 16 * (r16 >> 2) + 4 * q4 + (r16 & 3); float t = 0.f;
#pragma unroll
          for (int ww = 0; ww < 8; ++ww) t += SS[ww * 64 + cp];
          RSL[cp] = __builtin_amdgcn_rsqf(t * (1.f / 128.f) + RMS_EPS); }
        asm volatile("s_waitcnt lgkmcnt(0)" ::: "memory");
#pragma unroll
        for (int ti = 0; ti < 4; ++ti) { const f32x4 rs4 = *(const LAS f32x4*)(RSL + 16 * ti + 4 * q4);
#pragma unroll
            for (int r = 0; r < 4; ++r) { const int c = 16 * ti + 4 * q4 + r; const float rs = rs4[r];
                const float g = bf2f(GOs[c * LPG + 16 * w + r16]);
                Ost[c * LPG + 16 * w + r16] = (bf16)f2bf(o[ti][r] * rs * wg * (g * __builtin_amdgcn_rcpf(1.f + __expf(-g)))); } }
        GBAR();
    }
    if (PASS == 1) {
#pragma unroll
        for (int t = 0; t < 4; ++t) { *(GAS f32x4*)(USUM + ((size_t)run * 512 + tid) * 16 + 4 * t) = S[t]; if (w == 0 && r16 == 0) *(GAS f32x4*)(PDS + (size_t)run * 64 + 16 * t + 4 * q4) = pd[t]; }
    }
}
__device__ __forceinline__ Frame mkframe(unsigned char* lds) {
    Frame F; int tx = threadIdx.x, bx = blockIdx.x, G = gridDim.x;
    { volatile LAS unsigned* st = (volatile LAS unsigned*)((LAS unsigned char*)lds + MISC_OFF) + 8; if (st[3]) bx = (int)((xb_xcc_id() & 7u) + 8u * st[2]); }
    bx = __builtin_amdgcn_readfirstlane(bx);
    asm volatile("" : "+v"(tx)); asm volatile("" : "+s"(bx)); asm volatile("" : "+s"(G));
    F.lds = (LAS unsigned char*)lds; F.tid = tx; F.lane = tx & 63; F.wave = __builtin_amdgcn_readfirstlane(tx >> 6);
    F.G = G; F.bx = bx; F.vcu = (G % 8 == 0) ? (bx % 8) * (G / 8) + bx / 8 : bx; F.gw = bx * NWAVES + F.wave; F.NGW = G * NWAVES;
    return F;
}
__device__ __forceinline__ void seam(unsigned char* lds, int k) {
    KArgs A = kargs(); const int lo = A->ph_lo, hi = A->ph_hi;
    if (!(lo <= k && k + 1 < hi)) return;
    XcdBarrier b; b.bar = (unsigned*)(A->ws + WS_CTL) + CW_BAR; b.x = xb_xcc_id(); b.st = (volatile LAS unsigned*)((LAS unsigned char*)lds + MISC_OFF) + 8;
    xcd_barrier(b);
#ifdef PROBE_DUP_BAR
    xcd_barrier(b);
#endif
}
__device__ __forceinline__ void seam_local(unsigned char* lds, int k) {
    KArgs A = kargs(); const int lo = A->ph_lo, hi = A->ph_hi;
    if (!(lo <= k && k + 1 < hi)) return;
    XcdBarrier b; b.bar = (unsigned*)(A->ws + WS_CTL) + CW_BAR; b.x = xb_xcc_id(); b.st = (volatile LAS unsigned*)((LAS unsigned char*)lds + MISC_OFF) + 8;
    if (b.st[3]) xcd_local_barrier(b, (unsigned*)(A->ws + WS_CTL) + CW_LBAR); else xcd_barrier(b);
}
__device__ __forceinline__ bool phase_on(int k) { KArgs A = kargs(); return A->ph_lo <= k && k < A->ph_hi; }

__device__ __forceinline__ int probe_reps(bool on) { int n = on ? 2 : 1; asm volatile("" : "+s"(n)); return n; }
#ifdef PROBE_DUP_A1
#define REP_A1 true
#else
#define REP_A1 false
#endif
#ifdef PROBE_DUP_C1
#define REP_C1 true
#else
#define REP_C1 false
#endif
#ifdef PROBE_DUP_P0
#define REP_P0 true
#else
#define REP_P0 false
#endif
#ifdef PROBE_DUP_D1
#define REP_D1 true
#else
#define REP_D1 false
#endif
__device__ __forceinline__ bool attn_scores_bounded(int l) {
    KArgs A = kargs(); int tx = threadIdx.x; asm volatile("" : "+v"(tx)); const int lane = tx & 63;
    float mq = fabsf(A->in[I_QNW][l * 64 + lane]), mk = fabsf(A->in[I_KNW][l * 64 + lane]);
#pragma unroll
    for (int o = 1; o < 64; o <<= 1) { mq = fmaxf(mq, __shfl_xor(mq, o)); mk = fmaxf(mk, __shfl_xor(mk, o)); }
    return __builtin_amdgcn_readfirstlane((int)(8.f * 1.4426950408889634f * mq * mk < 60.f)) != 0;
}
template <int L> __device__ __forceinline__ void layer_fwd(unsigned char* lds) {
    constexpr int pb = 1 + 12 * L;
    if (phase_on(pb + 0)) {
        Frame F = mkframe(lds); KArgs A = kargs(); unsigned char* const ws = A->ws;
        pg8::Gemm g{(const bf16*)(ws + WS_XN8), (const bf16*)(ws + WS_WIN + (size_t)L * NIN * D), M, NIN, D / 2}; pg8::StaticOrder S; S.init(M, NIN, F.G, F.bx);
        pg8::EpiInProj E{ws, A->in[I_GB] + L * 256, A->in[I_QNW] + L * 64, A->in[I_KNW] + L * 64, attn_body::C2, (const float*)(ws + WS_AS), (const float*)(ws + WS_WCS) + L * NIN};
#ifdef PROBE_DUP_A1
        for (int rep = probe_reps(true); rep > 0; --rep)
#endif
        pg8::gemm_phase<pg8::EpiInProj, pg8::StaticOrder, true, true>(F.lds + RING_OFF, g, S, E);
    }
    if (phase_on(pb + 0)) {
        Frame F = mkframe(lds); const int nfull = ((M / 256) * (NIN / 256)) % F.G;
        if (nfull == 0) quant_tables(kargs(), L, F.gw, F.NGW, F.lane);
        else if (F.bx >= nfull) quant_tables(kargs(), L, (F.bx - nfull) * NWAVES + F.wave, (F.G - nfull) * NWAVES, F.lane);
    }
    seam_local(lds, pb + 0);
    if (phase_on(pb + 1)) { Frame F = mkframe(lds);
#ifdef PROBE_DUP_GLA1
        for (int rep = probe_reps(true); rep > 0; --rep)
#endif
        if (F.G == 256) { const int x = F.bx & 7, j = F.bx >> 3; gla_run<1>(F, L, (((x >> 1) * 4 + (j >> 3)) << 4) + 8 * (x & 1) + (j & 7)); }
        else for (int run = F.bx; run < 256; run += F.G) gla_run<1>(F, L, run); }
    seam(lds, pb + 1);
    if (phase_on(pb + 2)) { Frame F = mkframe(lds);
#ifdef PROBE_DUP_GLA2
        for (int rep = probe_reps(true); rep > 0; --rep)
#endif
        if (F.G == 256) { const int x = F.bx & 7, j = F.bx >> 3; gla_run<2>(F, L, (((x >> 1) * 4 + (j >> 3)) << 4) + 8 * (x & 1) + (j & 7)); }
        else for (int run = F.bx; run < 256; run += F.G) gla_run<2>(F, L, run); }
    if (phase_on(pb + 2) && attn_scores_bounded(L)) {
        Frame F = mkframe(lds); unsigned char* const ws = kargs()->ws;
        static_assert(attn_body::L2_BYTES <= RING_BYTES && attn_body::ATTN_LDS_BYTES <= RING_BYTES, "attention LDS");
        const attn_body::StaticOrder128 S(F.G, F.bx);
#ifdef PROBE_DUP_ATTN
        for (int rep = probe_reps(true); rep > 0; --rep)
#endif
        attn_body::attn_phase128((char*)lds + RING_OFF, (const attn_body::bf16*)(ws + WS_Q), (const attn_body::bf16*)(ws + WS_K), (const attn_body::bf16*)(ws + WS_DV), (attn_body::bf16*)(ws + WS_O), S);
    }
    if (phase_on(pb + 2) && !attn_scores_bounded(L)) {
        Frame F = mkframe(lds); unsigned char* const ws = kargs()->ws;
        const attn_body::AttnTensors AT{(const attn_body::bf16*)(ws + WS_Q), (const attn_body::bf16*)(ws + WS_K), (const attn_body::bf16*)(ws + WS_DV), (attn_body::bf16*)(ws + WS_O)};
        const attn_body::StaticOrder S(F.G, F.bx);
        attn_body::attn_phase<attn_body::StaticOrder>((char*)lds + RING_OFF, AT, S);
    }
    seam(lds, pb + 2);
    if (phase_on(pb + 3)) { Frame F = mkframe(lds);
#ifdef PROBE_DUP_DIFF
        for (int rep = probe_reps(true); rep > 0; --rep)
#endif
        diff_rows(F, L); }
    seam_local(lds, pb + 3);
    if (phase_on(pb + 4)) {
        Frame F = mkframe(lds); KArgs A = kargs(); unsigned char* const ws = A->ws;
        pg8::Gemm g{(const bf16*)((const unsigned char*)A->out + OUT_MIX8)  , (const bf16*)(ws + WS_WOUT + (size_t)L * D * D), M, D, D / 2}; pg8::StaticOrder S; S.init(M, D, F.G, F.bx);
        pg8::EpiResid<L == 0> E{A->in[I_X], (bf16*)(ws + WS_RES), (const float*)((const unsigned char*)A->out + OUT_MS), (const float*)(ws + WS_WOCS) + L * D};
#ifdef PROBE_DUP_C2
        for (int rep = probe_reps(L == 0); rep > 0; --rep)
#endif
        pg8::gemm_phase<pg8::EpiResid<L == 0>, pg8::StaticOrder, true, true>(F.lds + RING_OFF, g, S, E);
    }
    seam_local(lds, pb + 4);
    if (phase_on(pb + 5)) { Frame F = mkframe(lds); KArgs A = kargs(); unsigned char* const ws = A->ws;
        unsigned char* XR8 = (unsigned char*)A->out + OUT_MIX8; float* XS = (float*)((unsigned char*)A->out + OUT_MS);
        const int NX = (F.G & 7) == 0 ? 8 : 1, XI = F.bx % NX, RX = M / NX, xw = (F.bx / NX) * NWAVES + F.wave, WX = (F.G / NX) * NWAVES;
        const int mend = RX * (XI + 1), mstep = 4 * WX; int m0 = RX * XI + 4 * xw;
        v4u r[4][2];
#define R8_LOAD(R_, M_) do { _Pragma("unroll") for (int j = 0; j < 4; ++j) { const GAS v4u* rp = (const GAS v4u*)((const bf16*)(ws + WS_RES) + (size_t)((M_) + j) * D + 16 * F.lane); R_[j][0] = rp[0]; R_[j][1] = rp[1]; } } while (0)
        if (m0 < mend) R8_LOAD(r, m0);
        for (; m0 < mend; m0 += mstep) {
            const bool hn = m0 + mstep < mend; v4u rn[4][2];
            if (hn) R8_LOAD(rn, m0 + mstep);
#pragma unroll
            for (int j = 0; j < 4; ++j) { const v4u a0 = r[j][0], a1 = r[j][1]; f32x4 va[4];
                va[0] = (f32x4){bflo(a0.x), bfhi(a0.x), bflo(a0.y), bfhi(a0.y)}; va[1] = (f32x4){bflo(a0.z), bfhi(a0.z), bflo(a0.w), bfhi(a0.w)}; va[2] = (f32x4){bflo(a1.x), bfhi(a1.x), bflo(a1.y), bfhi(a1.y)}; va[3] = (f32x4){bflo(a1.z), bfhi(a1.z), bflo(a1.w), bfhi(a1.w)};
                row_to_i8(F.lane, va, nullptr, XR8 + (size_t)(m0 + j) * D, XS + m0 + j, (float*)(ws + WS_RS) + m0 + j); }
            if (hn) {
#pragma unroll
                for (int j = 0; j < 4; ++j) { r[j][0] = rn[j][0]; r[j][1] = rn[j][1]; } }
        }
#undef R8_LOAD
    }
    seam_local(lds, pb + 5);
    if (phase_on(pb + 6)) {
        Frame F = mkframe(lds); KArgs A = kargs(); unsigned char* const ws = A->ws;
        pg8::Gemm g{(const bf16*)((const unsigned char*)A->out + OUT_MIX8), (const bf16*)(ws + WS_WQ + (size_t)L * 2048 * D), M, 2048, D / 2}; pg8::StaticOrder S; S.init(M, 2048, F.G, F.bx);
        pg8::EpiRowScale E{(bf16*)(ws + WS_Q2), 2048, (const float*)((const unsigned char*)A->out + OUT_MS), (const float*)(ws + WS_WQCS) + L * 2048};
#ifdef PROBE_DUP_D1
        for (int rep = probe_reps(true); rep > 0; --rep)
#endif
        pg8::gemm_phase<pg8::EpiRowScale, pg8::StaticOrder, true, true>(F.lds + RING_OFF, g, S, E);
    }
    seam_local(lds, pb + 6);
    if (phase_on(pb + 7)) { Frame F = mkframe(lds);
#if defined(PROBE_DUP_D2)
        int nrep = 2; asm volatile("" : "+s"(nrep));
        for (int rep = 0; rep < nrep; ++rep)
#endif
        peer_select(F, L);
    }
    seam(lds, pb + 7);
    if (phase_on(pb + 8)) { Frame F = mkframe(lds); peer_sliced<false>(F, L);
#if defined(PROBE_DUP_U)
        peer_sliced<false, true>(F, L);
#endif
    }
    seam(lds, pb + 8);
    if (phase_on(pb + 9)) { Frame F = mkframe(lds);
#ifdef PROBE_DUP_W
        for (int rep = probe_reps(true); rep > 0; --rep)
#endif
        peer_w(F, L); }
    seam(lds, pb + 9);
    if (phase_on(pb + 10)) { Frame F = mkframe(lds);
#if defined(PROBE_DUP_V)
        peer_sliced<true, true, L + 1 == DEPTH>(F, L);
#endif
        peer_sliced<true, false, L + 1 == DEPTH>(F, L); }
    seam(lds, pb + 10);
    if (L + 1 < DEPTH) {
        if (phase_on(pb + 11)) { Frame F = mkframe(lds); KArgs A = kargs(); unsigned char* const ws = A->ws;
            const int NX = (F.G & 7) == 0 ? 8 : 1, XI = F.bx % NX, RX = M / NX, xw = (F.bx / NX) * NWAVES + F.wave, WX = (F.G / NX) * NWAVES;
            const int mend = RX * (XI + 1), mstep = 4 * WX; int m0 = RX * XI + 4 * xw;
            v4u r[4][2];
#define E8_LOAD(R_, M_) do { _Pragma("unroll") for (int j = 0; j < 4; ++j) { const GAS v4u* rp = (const GAS v4u*)((const bf16*)(ws + WS_RES) + (size_t)((M_) + j) * D + 16 * F.lane); R_[j][0] = rp[0]; R_[j][1] = rp[1]; } } while (0)
            if (m0 < mend) E8_LOAD(r, m0);
            for (; m0 < mend; m0 += mstep) {
                const bool hn = m0 + mstep < mend; v4u rn[4][2];
                if (hn) E8_LOAD(rn, m0 + mstep);
#pragma unroll
                for (int j = 0; j < 4; ++j) { const v4u a0 = r[j][0], a1 = r[j][1]; f32x4 va[4];
                    va[0] = (f32x4){bflo(a0.x), bfhi(a0.x), bflo(a0.y), bfhi(a0.y)}; va[1] = (f32x4){bflo(a0.z), bfhi(a0.z), bflo(a0.w), bfhi(a0.w)}; va[2] = (f32x4){bflo(a1.x), bfhi(a1.x), bflo(a1.y), bfhi(a1.y)}; va[3] = (f32x4){bflo(a1.z), bfhi(a1.z), bflo(a1.w), bfhi(a1.w)};
                    row_to_i8(F.lane, va, nullptr, ws + WS_XN8 + (size_t)(m0 + j) * D, (float*)(ws + WS_AS) + m0 + j); }
                if (hn) {
#pragma unroll
                    for (int j = 0; j < 4; ++j) { r[j][0] = rn[j][0]; r[j][1] = rn[j][1]; } }
            }
#undef E8_LOAD
        }
        seam_local(lds, pb + 11);
    }
}

__global__ void __launch_bounds__(NWAVES * 64, 2) mega_fwd(Args args) {
    extern __shared__ __attribute__((aligned(16))) unsigned char lds[];
    (void)args;
    { const int tx = threadIdx.x; for (int u = tx; u < (LDS_BYTES - LDSCTL_OFF) / 4; u += NWAVES * 64) ((LAS unsigned*)((LAS unsigned char*)lds + LDSCTL_OFF))[u] = 0u; }
    __syncthreads();
    { KArgs A = kargs(); if (A->ph_hi - A->ph_lo > 1) (void)xcd_barrier_post((unsigned*)(A->ws + WS_CTL) + CW_BAR, (volatile LAS unsigned*)((LAS unsigned char*)lds + MISC_OFF) + 8); }
    if (phase_on(0)) { Frame F = mkframe(lds);
#ifdef PROBE_DUP_P0
        for (int rep = probe_reps(true); rep > 0; --rep)
#endif
        p0_prologue(F); }
    seam(lds, 0);
    layer_fwd<0>(lds);
    layer_fwd<1>(lds);
}

extern "C" void kernel_launch(void* const* d_in, const int* in_sizes, int n_in, void* d_out, int out_size, void* d_ws, size_t ws_size, hipStream_t stream) {
    static int grid = 0;
    if (grid == 0) {
        if (n_in != 19 || in_sizes[0] != M * D || out_size != M * D || ws_size < WS_END) { fprintf(stderr, "kernel_launch: unexpected shapes (n_in %d, in0 %d, out %d, ws %zu)\n", n_in, n_in > 0 ? in_sizes[0] : -1, out_size, ws_size); grid = -1; return; }
        int dev = 0, cus = 0, per_cu = 0;
        if (hipGetDevice(&dev) != hipSuccess || hipDeviceGetAttribute(&cus, hipDeviceAttributeMultiprocessorCount, dev) != hipSuccess) { grid = -1; return; }
        if (hipFuncSetAttribute((const void*)mega_fwd, hipFuncAttributeMaxDynamicSharedMemorySize, LDS_BYTES) != hipSuccess) { fprintf(stderr, "kernel_launch: hipFuncSetAttribute failed\n"); grid = -1; return; }
        if (hipOccupancyMaxActiveBlocksPerMultiprocessor(&per_cu, (const void*)mega_fwd, NWAVES * 64, LDS_BYTES) != hipSuccess || per_cu < 1) fprintf(stderr, "kernel_launch: occupancy query reports %d\n", per_cu);
        (void)hipGetLastError();
        grid = cus;
    }
    if (grid < 0) return;
    if (hipMemsetAsync((char*)d_ws + WS_CTL, 0, CTL_ZERO_BYTES, stream) != hipSuccess) return;
    Args a{};
    for (int i = 0; i < 19; ++i) a.in[i] = (const float*)d_in[i];
    a.out = (float*)d_out; a.ws = (unsigned char*)d_ws;
#if MK_PER_PHASE
    for (int p = 0; p < NPHASE; ++p) { a.ph_lo = p; a.ph_hi = p + 1; hipLaunchKernelGGL(mega_fwd, dim3(grid), dim3(NWAVES * 64), LDS_BYTES, stream, a); }
#else
    a.ph_lo = 0; a.ph_hi = NPHASE; hipLaunchKernelGGL(mega_fwd, dim3(grid), dim3(NWAVES * 64), LDS_BYTES, stream, a);
#endif
}
```

```cpp
#include <hip/hip_runtime.h>
#include <cstdio>
#include <cstdint>
#include <utility>
namespace pg8 {
#define PG8_LAS __attribute__((address_space(3)))
typedef unsigned short bf16_t;
typedef short bf16x8 __attribute__((ext_vector_type(8)));
typedef float f32x4 __attribute__((ext_vector_type(4)));
typedef unsigned u32x4 __attribute__((ext_vector_type(4)));
__device__ __forceinline__ float xsum16(float v) { auto rr = __builtin_amdgcn_permlane16_swap(__float_as_uint(v), __float_as_uint(v), false, false); return __uint_as_float(rr[0]) + __uint_as_float(rr[1]); }
__device__ __forceinline__ float xsum32(float v) { auto rr = __builtin_amdgcn_permlane32_swap(__float_as_uint(v), __float_as_uint(v), false, false); return __uint_as_float(rr[0]) + __uint_as_float(rr[1]); }
constexpr int BM = 256, BK = 64, HALF = 128, HTB = HALF * BK * 2  , STAGE_BYTES = 8 * HTB, NXCD = 8, WGM = 8;

__host__ __device__ __forceinline__ int lds_byte(int r, int c) { const int st = (r >> 4) * 2 + (c >> 5), rr = r & 15, cc = c & 31, ob = rr * 64 + cc * 2; return st * 1024 + (ob ^ (((ob >> 9) & 1) << 5)); }
__host__ __device__ __forceinline__ void stage_rc(int b, int& R, int& C) { const int st = b / 1024, sb = b % 1024, swz = sb ^ (((sb >> 9) & 1) << 5); R = (st >> 1) * 16 + swz / 64; C = (st & 1) * 32 + (swz % 64) / 2; }
__host__ __device__ __forceinline__ int perm32(int rho) { const int n = rho >> 4, i = rho & 15; return 8 * (i >> 2) + 4 * n + (i & 3); }

typedef int i32x4 __attribute__((ext_vector_type(4)));
template <bool I8> __device__ __forceinline__ f32x4 pg8_mma(bf16x8 b, bf16x8 a, f32x4 c) {
    if constexpr (I8) return __builtin_bit_cast(f32x4, __builtin_amdgcn_mfma_i32_16x16x64_i8(__builtin_bit_cast(i32x4, b), __builtin_bit_cast(i32x4, a), __builtin_bit_cast(i32x4, c), 0, 0, 0));
    else return __builtin_amdgcn_mfma_f32_16x16x32_bf16(b, a, c, 0, 0, 0);
}
struct Unit { int pm, pn; };
struct Gemm { const bf16_t* A; const bf16_t* Bt; int M, N, K; };

struct StaticOrder {
    int nM, nN, nwg, G, c, wgm;
    __host__ __device__ void init(int M, int N, int G_, int c_, int wgm_ = WGM) { nM = M / BM; nN = N / BM; nwg = nM * nN; G = G_; c = c_; wgm = wgm_; }
    __host__ __device__ bool next(int i, Unit& u) const {
#ifdef PROBE_DUP_A1S
        const long L = (long)(nN == 13 ? (i >> 1) : i) * G + c; if (L >= nwg) return false;
#else
        const long L = (long)i * G + c; if (L >= nwg) return false;
#endif
        int wgid = (int)L; { const int q = nwg / NXCD, r = nwg % NXCD, xcd = wgid % NXCD, off = wgid / NXCD; wgid = (xcd < r ? xcd * (q + 1) : r * (q + 1) + (xcd - r) * q) + off; }
        const int nig = wgm * nN, gid = wgid / nig, fm = gid * wgm, gsz = (nM - fm) < wgm ? (nM - fm) : wgm;
        u.pm = fm + ((wgid % nig) % gsz); u.pn = (wgid % nig) / gsz; return true;
    }
    __device__ __forceinline__ void a_ready(const Unit&) const {}
    __device__ __forceinline__ void done(const Unit&) const {}
};

__device__ __forceinline__ unsigned cvt_pk_bf16(float lo, float hi) { unsigned r; asm volatile("v_cvt_pk_bf16_f32 %0, %1, %2" : "=v"(r) : "v"(lo), "v"(hi)); return r; }
constexpr size_t WSO_Q = 160u << 20, WSO_K = 192u << 20, WSO_DV = 224u << 20, WSO_GQ = 256u << 20, WSO_GO = 272u << 20, WSO_GK = 400u << 20, WSO_GV = 416u << 20, WSO_GLOG = 448u << 20;
__device__ __forceinline__ void store8_bf16(bf16_t* p, f32x4 v0, f32x4 v1) { u32x4 w; w.x = cvt_pk_bf16(v0[0], v0[1]); w.y = cvt_pk_bf16(v0[2], v0[3]); w.z = cvt_pk_bf16(v1[0], v1[1]); w.w = cvt_pk_bf16(v1[2], v1[3]); *(u32x4*)p = w; }
__device__ __forceinline__ u32x4 pack8_bf16(f32x4 v0, f32x4 v1) { u32x4 w; w.x = cvt_pk_bf16(v0[0], v0[1]); w.y = cvt_pk_bf16(v0[2], v0[3]); w.z = cvt_pk_bf16(v1[0], v1[1]); w.w = cvt_pk_bf16(v1[2], v1[3]); return w; }
__device__ __forceinline__ void store_pair_rows(bf16_t* rowp, int ld, u32x4 x0, u32x4 x1, bool odd) {
    const u32x4 snd = odd ? x0 : x1; u32x4 rcv;
    rcv.x = (unsigned)__builtin_amdgcn_update_dpp(0, (int)snd.x, 0xB1, 0xF, 0xF, true); rcv.y = (unsigned)__builtin_amdgcn_update_dpp(0, (int)snd.y, 0xB1, 0xF, 0xF, true);
    rcv.z = (unsigned)__builtin_amdgcn_update_dpp(0, (int)snd.z, 0xB1, 0xF, 0xF, true); rcv.w = (unsigned)__builtin_amdgcn_update_dpp(0, (int)snd.w, 0xB1, 0xF, 0xF, true);
    bf16_t* pa = odd ? rowp - ld + 32 : rowp; bf16_t* pb = odd ? rowp + 32 : rowp + ld;
    __builtin_nontemporal_store(odd ? rcv : x0, (u32x4*)pa); __builtin_nontemporal_store(odd ? x1 : rcv, (u32x4*)pb);
}
__device__ __forceinline__ float log_sigmoid_f(float x) { return fminf(x, 0.f) - __logf(1.f + __expf(-fabsf(x))); }
struct EpiPlain {
    static constexpr bool PERM = true, AFTER_DRAIN = false, IDEMPOTENT = true, I8 = false;
    bf16_t* O; int ldc;
    __device__ __forceinline__ void operator()(const f32x4 (&acc)[2][2][4][2], const Unit& u, int wr, int wc, int fr, int fq) const {
        const int row0 = u.pm * BM + wr * 64 + fr, col0 = u.pn * BM + wc * 32 + 8 * fq;
#pragma unroll
        for (int ai = 0; ai < 2; ++ai)
#pragma unroll
            for (int m = 0; m < 4; ++m) { bf16_t* rowp = O + (size_t)(row0 + ai * HALF + m * 16) * ldc + col0;
#pragma unroll
                for (int bj = 0; bj < 2; ++bj) store8_bf16(rowp + bj * HALF, acc[ai][bj][m][0], acc[ai][bj][m][1]); }
    }
};
__host__ __device__ __forceinline__ int inproj_phys_row(int n) { const int cl = n & 255; return (n & ~255) + 128 * ((cl >> 5) & 1) + 32 * (cl >> 6) + (cl & 31); }
struct EpiInProj {
    static constexpr bool PERM = true, AFTER_DRAIN = false, IDEMPOTENT = true, I8 = true;
    unsigned char* ws; const float* gate_b; const float* qn_w; const float* kn_w; float qscale;
    const float* arow; const float* wcol;
#ifdef PROBE_DUP_EPI8
    bool nostore = false;
    __device__ __forceinline__ void store8_bf16(bf16_t* p, f32x4 v0, f32x4 v1) const { if (!nostore) pg8::store8_bf16(p, v0, v1); else asm volatile("" :: "v"(v0[0] + v0[1] + v0[2] + v0[3] + v1[0] + v1[1] + v1[2] + v1[3])); }
#endif
    __device__ __forceinline__ static f32x4 cvt(const f32x4& a) { const i32x4 i = __builtin_bit_cast(i32x4, a); return (f32x4){(float)i[0], (float)i[1], (float)i[2], (float)i[3]}; }
    __device__ __forceinline__ void operator()(const f32x4 (&acc)[2][2][4][2], const Unit& u, int wr, int wc, int fr, int fq) const {
        const int pn = u.pn, row0 = u.pm * BM + wr * 64 + fr, cl = wc * 64 + 8 * fq;
        f32x4 cs[2][2];
#pragma unroll
        for (int bj = 0; bj < 2; ++bj)
#pragma unroll
            for (int n = 0; n < 2; ++n) cs[bj][n] = *(const f32x4*)(wcol + pn * 256 + cl + 32 * bj + 4 * n);
        float rrv[2][4];
#pragma unroll
        for (int ai = 0; ai < 2; ++ai)
#pragma unroll
            for (int m = 0; m < 4; ++m) rrv[ai][m] = arow[row0 + ai * HALF + m * 16];
        asm volatile("" : "+v"(rrv[0][0]), "+v"(rrv[0][1]), "+v"(rrv[0][2]), "+v"(rrv[0][3]), "+v"(rrv[1][0]), "+v"(rrv[1][1]), "+v"(rrv[1][2]), "+v"(rrv[1][3]));
        if (pn == 12) {
            f32x4 bv[2][2];
#pragma unroll
            for (int bj = 0; bj < 2; ++bj)
#pragma unroll
                for (int n = 0; n < 2; ++n) bv[bj][n] = *(const f32x4*)(gate_b + cl + 32 * bj + 4 * n);
#pragma unroll
            for (int ai = 0; ai < 2; ++ai)
#pragma unroll
                for (int m = 0; m < 4; ++m) { const int row = row0 + ai * HALF + m * 16; float* rowp = (float*)(ws + WSO_GLOG) + (size_t)row * 256 + cl; const float rr = rrv[ai][m];
#pragma unroll
                    for (int bj = 0; bj < 2; ++bj)
#pragma unroll
                        for (int n = 0; n < 2; ++n) { const f32x4 v = cvt(acc[ai][bj][m][n]) * (cs[bj][n] * rr) + bv[bj][n]; f32x4 o;
                            o[0] = log_sigmoid_f(v[0]) * 0.0625f; o[1] = log_sigmoid_f(v[1]) * 0.0625f; o[2] = log_sigmoid_f(v[2]) * 0.0625f; o[3] = log_sigmoid_f(v[3]) * 0.0625f;
#ifdef PROBE_DUP_EPI8
                            if (nostore) asm volatile("" :: "v"(o[0] + o[1] + o[2] + o[3])); else
#endif
                            *(f32x4*)(rowp + 32 * bj + 4 * n) = o; } }
            return;
        }
        if (pn < 4) {
            const bool isk = pn >= 2; const float* nw = isk ? kn_w : qn_w; const float sc = isk ? 1.f : qscale;
            f32x4 wv[2][2];
#pragma unroll
            for (int bj = 0; bj < 2; ++bj)
#pragma unroll
                for (int n = 0; n < 2; ++n) wv[bj][n] = *(const f32x4*)(nw + 8 * fq + 32 * bj + 4 * n) * sc;
            bf16_t* base = (bf16_t*)(ws + (isk ? WSO_K : WSO_Q)); const int c0 = (pn & 1) * 256;
#pragma unroll
            for (int ai = 0; ai < 2; ++ai)
#pragma unroll
                for (int m = 0; m < 4; ++m) { const int row = row0 + ai * HALF + m * 16; const float rr = rrv[ai][m];
                    f32x4 x[2][2]; float ss = 0.f;
#pragma unroll
                    for (int bj = 0; bj < 2; ++bj)
#pragma unroll
                        for (int n = 0; n < 2; ++n) { x[bj][n] = cvt(acc[ai][bj][m][n]) * (cs[bj][n] * rr); ss += (x[bj][n][0] * x[bj][n][0] + x[bj][n][1] * x[bj][n][1]) + (x[bj][n][2] * x[bj][n][2] + x[bj][n][3] * x[bj][n][3]); }
                    ss = xsum32(xsum16(ss));
                    const float rs = __builtin_amdgcn_rsqf(ss * (1.f / 64.f) + 1e-6f);
                    bf16_t* rowp = base + (size_t)row * 512 + c0 + cl;
                    store_pair_rows(rowp, 512, pack8_bf16(x[0][0] * rs * wv[0][0], x[0][1] * rs * wv[0][1]), pack8_bf16(x[1][0] * rs * wv[1][0], x[1][1] * rs * wv[1][1]), fr & 1);
                }
            return;
        }
        size_t bo; int ldc, c0;
        if (pn < 6) { bo = WSO_DV; ldc = 512; c0 = (pn - 4) * 256; }
        else if (pn == 6) { bo = WSO_GQ; ldc = 256; c0 = 0; }
        else if (pn == 7) { bo = WSO_GK; ldc = 256; c0 = 0; }
        else if (pn < 10) { bo = WSO_GV; ldc = 512; c0 = (pn - 8) * 256; }
        else { bo = WSO_GO; ldc = 512; c0 = (pn - 10) * 256; }
        bf16_t* base = (bf16_t*)(ws + bo);
#pragma unroll
        for (int ai = 0; ai < 2; ++ai)
#pragma unroll
            for (int m = 0; m < 4; ++m) { const int row = row0 + ai * HALF + m * 16; bf16_t* rowp = base + (size_t)row * ldc + c0 + cl; const float rr = rrv[ai][m];
                store_pair_rows(rowp, ldc, pack8_bf16(cvt(acc[ai][0][m][0]) * (cs[0][0] * rr), cvt(acc[ai][0][m][1]) * (cs[0][1] * rr)), pack8_bf16(cvt(acc[ai][1][m][0]) * (cs[1][0] * rr), cvt(acc[ai][1][m][1]) * (cs[1][1] * rr)), fr & 1); }
    }
};
template <bool FIRST> struct EpiResid {
    static constexpr bool PERM = true, AFTER_DRAIN = false, IDEMPOTENT = FIRST, I8 = true;
    const float* x; bf16_t* res; const float* arow; const float* wcol;
    __device__ __forceinline__ static f32x4 cvt(const f32x4& a) { const i32x4 i = __builtin_bit_cast(i32x4, a); return (f32x4){(float)i[0], (float)i[1], (float)i[2], (float)i[3]}; }
    __device__ __forceinline__ void operator()(const f32x4 (&acc)[2][2][4][2], const Unit& u, int wr, int wc, int fr, int fq) const {
        const int row0 = u.pm * BM + wr * 64 + fr, col0 = u.pn * BM + wc * 32 + 8 * fq;
        f32x4 cs[2][2];
#pragma unroll
        for (int bj = 0; bj < 2; ++bj)
#pragma unroll
            for (int n = 0; n < 2; ++n) cs[bj][n] = *(const f32x4*)(wcol + col0 + bj * HALF + 4 * n);
        float rrv[2][4];
#pragma unroll
        for (int ai = 0; ai < 2; ++ai)
#pragma unroll
            for (int m = 0; m < 4; ++m) rrv[ai][m] = arow[row0 + ai * HALF + m * 16];
        asm volatile("" : "+v"(rrv[0][0]), "+v"(rrv[0][1]), "+v"(rrv[0][2]), "+v"(rrv[0][3]), "+v"(rrv[1][0]), "+v"(rrv[1][1]), "+v"(rrv[1][2]), "+v"(rrv[1][3]));
#pragma unroll
        for (int ai = 0; ai < 2; ++ai)
#pragma unroll
            for (int m = 0; m < 4; ++m) { const int row = row0 + ai * HALF + m * 16; const size_t off = (size_t)row * 1024 + col0; const float rr = rrv[ai][m];
#pragma unroll
                for (int bj = 0; bj < 2; ++bj) { f32x4 r0, r1;
                    if (FIRST) { r0 = *(const f32x4*)(x + off + bj * HALF); r1 = *(const f32x4*)(x + off + bj * HALF + 4); }
                    else { const u32x4 w = *(const u32x4*)(res + off + bj * HALF);
                        r0 = (f32x4){__builtin_bit_cast(float, w.x << 16), __builtin_bit_cast(float, w.x & 0xffff0000u), __builtin_bit_cast(float, w.y << 16), __builtin_bit_cast(float, w.y & 0xffff0000u)};
                        r1 = (f32x4){__builtin_bit_cast(float, w.z << 16), __builtin_bit_cast(float, w.z & 0xffff0000u), __builtin_bit_cast(float, w.w << 16), __builtin_bit_cast(float, w.w & 0xffff0000u)}; }
                    r0 = r0 + cvt(acc[ai][bj][m][0]) * (cs[bj][0] * rr); r1 = r1 + cvt(acc[ai][bj][m][1]) * (cs[bj][1] * rr);
                    store8_bf16(res + off + bj * HALF, r0, r1); }
            }
    }
};
struct EpiRowScale {
    static constexpr bool PERM = true, AFTER_DRAIN = false, IDEMPOTENT = true, I8 = true;
    bf16_t* O; int ldc; const float* arow; const float* wcol;
    __device__ __forceinline__ static f32x4 cvt(const f32x4& a) { const i32x4 i = __builtin_bit_cast(i32x4, a); return (f32x4){(float)i[0], (float)i[1], (float)i[2], (float)i[3]}; }
    __device__ __forceinline__ void operator()(const f32x4 (&acc)[2][2][4][2], const Unit& u, int wr, int wc, int fr, int fq) const {
        const int row0 = u.pm * BM + wr * 64 + fr, col0 = u.pn * BM + wc * 32 + 8 * fq;
        f32x4 cs[2][2];
#pragma unroll
        for (int bj = 0; bj < 2; ++bj)
#pragma unroll
            for (int n = 0; n < 2; ++n) cs[bj][n] = *(const f32x4*)(wcol + col0 + bj * HALF + 4 * n);
        float rrv[2][4];
#pragma unroll
        for (int ai = 0; ai < 2; ++ai)
#pragma unroll
            for (int m = 0; m < 4; ++m) rrv[ai][m] = arow[row0 + ai * HALF + m * 16];
        asm volatile("" : "+v"(rrv[0][0]), "+v"(rrv[0][1]), "+v"(rrv[0][2]), "+v"(rrv[0][3]), "+v"(rrv[1][0]), "+v"(rrv[1][1]), "+v"(rrv[1][2]), "+v"(rrv[1][3]));
#pragma unroll
        for (int ai = 0; ai < 2; ++ai)
#pragma unroll
            for (int m = 0; m < 4; ++m) { const int row = row0 + ai * HALF + m * 16; const float rr = rrv[ai][m];
                bf16_t* rowp = O + (size_t)row * ldc + col0;
#pragma unroll
                for (int bj = 0; bj < 2; ++bj) store8_bf16(rowp + bj * HALF, cvt(acc[ai][bj][m][0]) * (cs[bj][0] * rr), cvt(acc[ai][bj][m][1]) * (cs[bj][1] * rr)); }
    }
};
template <class Epi, class Sched, bool ALIGN_EPI = false, bool SP2 = false>
__device__ __forceinline__ void gemm_phase(PG8_LAS unsigned char* lds, const Gemm g, const Sched& S, const Epi& E) {
    const int tid = threadIdx.x, wid = __builtin_amdgcn_readfirstlane(tid >> 6), lane = tid & 63, wr = wid >> 2, wc = wid & 3, fr = lane & 15, fq = lane >> 4;
    const int K = g.K, nt = K / BK;
    unsigned voffA[2], voffB[2];
#pragma unroll
    for (int i = 0; i < 2; ++i) { int R, C; stage_rc(tid * 16 + i * 8192, R, C); const int Rb = Epi::PERM ? ((R & ~31) + perm32(R & 31)) : R;
        voffA[i] = (unsigned)(R * K + C) * 2u; voffB[i] = (unsigned)(Rb * K + C) * 2u; }
    const size_t kstep = (size_t)(BK * 2);
    const size_t hstep = (size_t)HALF * K * 2;
    const size_t tstep = 2 * hstep;
    const unsigned ldsw = (unsigned)wid * 1024u;
    const int aoff = lds_byte(wr * 64 + fr, fq * 8), boff = lds_byte(wc * 32 + fr, fq * 8);
#define PG8_SA(b, h) (((b) * 2 + (h)) * HTB)
#define PG8_SB(b, h) ((4 + (b) * 2 + (h)) * HTB)
#define PG8_STAGE(bufoff, gbase, voff) do { _Pragma("unroll") for (int _i = 0; _i < 2; ++_i) \
        __builtin_amdgcn_global_load_lds((const unsigned*)((const char*)(gbase) + (voff)[_i]), (PG8_LAS unsigned*)(lds + (bufoff) + ldsw + _i * 8192), 16, 0, 0); } while (0)
#define PG8_LDA(dst, b, h) do { _Pragma("unroll") for (int m = 0; m < 4; ++m) _Pragma("unroll") for (int k = 0; k < 2; ++k) dst[m][k] = *(const PG8_LAS bf16x8*)(lds + PG8_SA(b, h) + aoff + m * 2048 + k * 1024); } while (0)
#define PG8_LDB(dst, b, h) do { _Pragma("unroll") for (int n = 0; n < 2; ++n) _Pragma("unroll") for (int k = 0; k < 2; ++k) dst[n][k] = *(const PG8_LAS bf16x8*)(lds + PG8_SB(b, h) + boff + n * 2048 + k * 1024); } while (0)
#define PG8_MMA(ai, bj, At, Bt) do { __builtin_amdgcn_s_setprio(1); _Pragma("unroll") for (int k = 0; k < 2; ++k) _Pragma("unroll") for (int m = 0; m < 4; ++m) _Pragma("unroll") for (int n = 0; n < 2; ++n)   \
        acc[ai][bj][m][n] = pg8_mma<Epi::I8>(Bt[n][k], At[m][k], acc[ai][bj][m][n]); __builtin_amdgcn_s_setprio(0); } while (0)
#define PG8_WAIT_V(n) asm volatile("s_waitcnt vmcnt(" #n ")" ::: "memory")
#define PG8_WAIT_L(n) asm volatile("s_waitcnt lgkmcnt(" #n ")" ::: "memory")
#define PG8_BAR __builtin_amdgcn_s_barrier()
#define PG8_SCHED __builtin_amdgcn_sched_barrier(0)
    Unit cur, nxt; int ui = 0;
    if (!S.next(0, cur)) return;
    f32x4 acc[2][2][4][2];
#pragma unroll
    for (int a = 0; a < 2; ++a)
#pragma unroll
        for (int b = 0; b < 2; ++b)
#pragma unroll
            for (int m = 0; m < 4; ++m)
#pragma unroll
                for (int n = 0; n < 2; ++n) acc[a][b][m][n] = (f32x4){0.f, 0.f, 0.f, 0.f};
    bf16x8 At[4][2], B0[2][2], B1[2][2];
    const char* cA = (const char*)g.A + (size_t)cur.pm * tstep; const char* cB = (const char*)g.Bt + (size_t)cur.pn * tstep;
    S.a_ready(cur);
    if constexpr (SP2) {
        PG8_STAGE(PG8_SB(0, 0), cB, voffB); PG8_STAGE(PG8_SB(0, 1), cB + hstep, voffB); PG8_STAGE(PG8_SA(0, 0), cA, voffA); PG8_STAGE(PG8_SA(0, 1), cA + hstep, voffA);
        if (wr == 1) PG8_BAR;
        PG8_WAIT_V(2); PG8_BAR;
        PG8_STAGE(PG8_SB(1, 0), cB + kstep, voffB); PG8_STAGE(PG8_SA(1, 0), cA + kstep, voffA); PG8_STAGE(PG8_SB(1, 1), cB + hstep + kstep, voffB);
        PG8_WAIT_V(6); PG8_BAR;
    } else {
        PG8_STAGE(PG8_SB(0, 0), cB, voffB); PG8_STAGE(PG8_SA(0, 0), cA, voffA); PG8_STAGE(PG8_SB(0, 1), cB + hstep, voffB); PG8_STAGE(PG8_SA(0, 1), cA + hstep, voffA);
        if (wr == 1) PG8_BAR;
        PG8_WAIT_V(4); PG8_BAR;
        PG8_STAGE(PG8_SB(1, 0), cB + kstep, voffB); PG8_STAGE(PG8_SA(1, 0), cA + kstep, voffA); PG8_STAGE(PG8_SB(1, 1), cB + hstep + kstep, voffB);
        PG8_WAIT_V(6); PG8_BAR;
    }
    for (;;) {
        const bool has_next = S.next(ui + 1, nxt);
        const char* nA = has_next ? (const char*)g.A + (size_t)nxt.pm * tstep : cA; const char* nB = has_next ? (const char*)g.Bt + (size_t)nxt.pn * tstep : cB;
        for (int t = 0; t < nt; t += 2) {
            const bool last = (t == nt - 2);
            const char* a1 = cA + (size_t)(t + 1) * kstep;
            const char* a2 = last ? nA : cA + (size_t)(t + 2) * kstep; const char* b2 = last ? nB : cB + (size_t)(t + 2) * kstep;
            const char* a3 = a2 + kstep; const char* b3 = b2 + kstep;
            if (last && has_next) S.a_ready(nxt);
            if constexpr (SP2) {
            PG8_LDB(B0, 0, 0); PG8_LDB(B1, 0, 1); PG8_SCHED; PG8_LDA(At, 0, 0); PG8_STAGE(PG8_SA(1, 1), a1 + hstep, voffA);
            PG8_WAIT_V(8); PG8_WAIT_L(0); PG8_BAR; PG8_MMA(0, 0, At, B0); PG8_MMA(0, 1, At, B1); PG8_BAR; PG8_SCHED;
            PG8_LDA(At, 0, 1); PG8_STAGE(PG8_SB(0, 0), b2, voffB); PG8_STAGE(PG8_SB(0, 1), b2 + hstep, voffB); PG8_STAGE(PG8_SA(0, 0), a2, voffA);
            PG8_WAIT_V(8); PG8_WAIT_L(0); PG8_BAR; PG8_MMA(1, 0, At, B0); PG8_MMA(1, 1, At, B1); PG8_BAR; PG8_SCHED;
            PG8_LDB(B0, 1, 0); PG8_LDB(B1, 1, 1); PG8_SCHED; PG8_LDA(At, 1, 0); PG8_STAGE(PG8_SA(0, 1), a2 + hstep, voffA);
            PG8_WAIT_V(8); PG8_WAIT_L(0); PG8_BAR; PG8_MMA(0, 0, At, B0); PG8_MMA(0, 1, At, B1); PG8_BAR; PG8_SCHED;
            PG8_LDA(At, 1, 1); PG8_STAGE(PG8_SB(1, 0), b3, voffB); PG8_STAGE(PG8_SB(1, 1), b3 + hstep, voffB); PG8_STAGE(PG8_SA(1, 0), a3, voffA);
            PG8_WAIT_V(8); PG8_WAIT_L(0); PG8_BAR; PG8_MMA(1, 0, At, B0); PG8_MMA(1, 1, At, B1); PG8_BAR; PG8_SCHED;
            } else {
            PG8_LDB(B0, 0, 0); PG8_SCHED; PG8_LDA(At, 0, 0); PG8_STAGE(PG8_SA(1, 1), a1 + hstep, voffA);
            PG8_WAIT_L(8); PG8_BAR; PG8_WAIT_L(0); PG8_MMA(0, 0, At, B0); PG8_BAR; PG8_SCHED;
            PG8_LDB(B1, 0, 1); PG8_STAGE(PG8_SB(0, 0), b2, voffB);
            PG8_BAR; PG8_WAIT_L(0); PG8_MMA(0, 1, At, B1); PG8_BAR;
            PG8_LDA(At, 0, 1); PG8_STAGE(PG8_SA(0, 0), a2, voffA);
            PG8_BAR; PG8_WAIT_L(0); PG8_MMA(1, 0, At, B0); PG8_BAR; PG8_SCHED;
            PG8_STAGE(PG8_SB(0, 1), b2 + hstep, voffB);
            PG8_WAIT_V(6); PG8_BAR; PG8_MMA(1, 1, At, B1); PG8_BAR;
            PG8_LDB(B0, 1, 0); PG8_SCHED; PG8_LDA(At, 1, 0); PG8_STAGE(PG8_SA(0, 1), a2 + hstep, voffA);
            PG8_WAIT_L(8); PG8_BAR; PG8_WAIT_L(0); PG8_MMA(0, 0, At, B0); PG8_BAR; PG8_SCHED;
            PG8_LDB(B1, 1, 1); PG8_STAGE(PG8_SB(1, 0), b3, voffB);
            PG8_BAR; PG8_WAIT_L(0); PG8_MMA(0, 1, At, B1); PG8_BAR;
            PG8_LDA(At, 1, 1); PG8_STAGE(PG8_SA(1, 0), a3, voffA);
            PG8_BAR; PG8_WAIT_L(0); PG8_MMA(1, 0, At, B0); PG8_BAR; PG8_SCHED;
            PG8_STAGE(PG8_SB(1, 1), b3 + hstep, voffB);
            PG8_WAIT_V(6); PG8_BAR; PG8_MMA(1, 1, At, B1); PG8_BAR;
            }
        }
        if constexpr (ALIGN_EPI) { if (wr == 0) PG8_BAR; }
        if constexpr (!Epi::AFTER_DRAIN) { E(acc, cur, wr, wc, fr, fq);
#ifdef PROBE_DUP_EPI
            if constexpr (Epi::IDEMPOTENT) { asm volatile("" ::: "memory"); E(acc, cur, wr, wc, fr, fq); }
#endif
#ifdef PROBE_DUP_EPI8
            if constexpr (Epi::IDEMPOTENT && Epi::I8) { asm volatile("" ::: "memory"); Epi E2 = E;
#ifdef PROBE_NOSTORE
                E2.nostore = true;
#endif
                E2(acc, cur, wr, wc, fr, fq); }
#endif
            S.done(cur); }
        if (!has_next) break;
#pragma unroll
        for (int a = 0; a < 2; ++a)
#pragma unroll
            for (int b = 0; b < 2; ++b)
#pragma unroll
                for (int m = 0; m < 4; ++m)
#pragma unroll
                    for (int n = 0; n < 2; ++n) acc[a][b][m][n] = (f32x4){0.f, 0.f, 0.f, 0.f};
        cur = nxt; cA = nA; cB = nB; ++ui;
        if constexpr (ALIGN_EPI) { if (wr == 1) PG8_BAR; }
    }
    PG8_WAIT_V(0);
    if constexpr (!ALIGN_EPI) { if (wr == 0) PG8_BAR; }
    PG8_BAR;
    if constexpr (Epi::AFTER_DRAIN) { E.fused(acc, cur, wr, wc, fr, fq, lds, wid, lane); S.done(cur); }
#undef PG8_SA
#undef PG8_SB
#undef PG8_STAGE
#undef PG8_LDA
#undef PG8_LDB
#undef PG8_MMA
#undef PG8_WAIT_V
#undef PG8_WAIT_L
#undef PG8_BAR
#undef PG8_SCHED
}
}

#include <hip/hip_bf16.h>
#include <cmath>
namespace attn_body {
using bf16=__hip_bfloat16;
using bf16x8=__attribute__((ext_vector_type(8)))short;
using s16x4=__attribute__((ext_vector_type(4)))short;
using f32x16=__attribute__((ext_vector_type(16)))float;
using u32x4=__attribute__((ext_vector_type(4)))unsigned;
constexpr int BATCH=4,NHEAD=16,SEQ=8192,D=64,DM=NHEAD*D;
constexpr int QP=512,KP=512,VP=512,OP=1024;
constexpr int NW=8,QBLK=32,QB=QBLK*NW,KVBLK=64,NQB=SEQ/QB;
constexpr int ATTN_PITCH=DM, ATTN_UNIT_ROWS=QB;
__device__ __forceinline__ int crow(int r,int hi){return (r&3)+8*(r>>2)+4*hi;}
#define SBAR() __builtin_amdgcn_sched_barrier(0)
__device__ __forceinline__ void cmask(f32x16&p0,f32x16&p1,int jb,int qrel,int hi){
  const float NEG=-INFINITY; int kb=64*jb+4*hi;
  #pragma unroll
  for(int r=0;r<16;++r){int kv=kb+(r&3)+8*(r>>2); if(kv>qrel)p0[r]=NEG; if(kv+32>qrel)p1[r]=NEG;}
}

constexpr int NSLOT=3, SLOTB=8192;
constexpr int LDS_K=0, LDS_V=NSLOT*SLOTB, LDS_WS=2*NSLOT*SLOTB, LDS_OST=LDS_WS+NW*64*4, LDS_BYTES=LDS_OST+NW*4096;
constexpr float C2=0.125f*1.4426950408889634f;
__device__ __forceinline__ void glds16(const void*gsrc,unsigned lds_dst){unsigned keep;
  asm volatile("s_mov_b32 %0, m0\n\ts_mov_b32 m0, %2\n\ts_nop 0\n\tglobal_load_lds_dwordx4 %1, off\n\ts_mov_b32 m0, %0":"=&s"(keep):"v"(gsrc),"s"(lds_dst):"memory");}
__device__ __forceinline__ float max3f(float a,float b,float c){float r;asm("v_max3_f32 %0, %1, %2, %3":"=v"(r):"v"(a),"v"(b),"v"(c));return r;}
__device__ __forceinline__ float max2f(float a,float b){float r;asm("v_max_f32_e32 %0, %1, %2":"=v"(r):"v"(a),"v"(b));return r;}
__device__ __forceinline__ float fadd_s(float a,float b){float r;asm("v_add_f32_e32 %0, %1, %2":"=v"(r):"v"(a),"v"(b));return r;}
__device__ __forceinline__ float fsub_s(float a,float b){float r;asm("v_sub_f32_e32 %0, %1, %2":"=v"(r):"v"(a),"v"(b));return r;}
typedef float f32x2_t __attribute__((ext_vector_type(2))); typedef __bf16 bf16x2_t __attribute__((ext_vector_type(2)));
__device__ __forceinline__ unsigned cvtpk_s(float lo,float hi){f32x2_t v={lo,hi};bf16x2_t b=__builtin_convertvector(v,bf16x2_t);return __builtin_bit_cast(unsigned,b);}
#define WAIT_BAR(N) asm volatile("s_waitcnt vmcnt(" #N ") lgkmcnt(0)\n\ts_barrier":::"memory")

__device__ __forceinline__ void qkt(f32x16&p0,f32x16&p1,const char*Kslot,const bf16x8*qr,const f32x16&negm,int r32,int hi){
  const char*kb=Kslot+hi*1024+r32*16;
  #pragma unroll
  for(int d0=0;d0<4;++d0){
    const bf16x8 b0=*reinterpret_cast<const bf16x8*>(kb+d0*2048);
    const bf16x8 b1=*reinterpret_cast<const bf16x8*>(kb+d0*2048+512);
    if(d0==0){p0=__builtin_amdgcn_mfma_f32_32x32x16_bf16(b0,qr[0],negm,0,0,0);p1=__builtin_amdgcn_mfma_f32_32x32x16_bf16(b1,qr[0],negm,0,0,0);}
    else{p0=__builtin_amdgcn_mfma_f32_32x32x16_bf16(b0,qr[d0],p0,0,0,0);p1=__builtin_amdgcn_mfma_f32_32x32x16_bf16(b1,qr[d0],p1,0,0,0);}}
}
typedef __attribute__((address_space(3))) const char* lds_cptr;
typedef short v4i16_t __attribute__((ext_vector_type(4)));
__device__ __forceinline__ void kload8(bf16x8*kf,lds_cptr kp){
  kf[0]=*(const __attribute__((address_space(3))) bf16x8*)(kp);      kf[1]=*(const __attribute__((address_space(3))) bf16x8*)(kp+512);
  kf[2]=*(const __attribute__((address_space(3))) bf16x8*)(kp+2048); kf[3]=*(const __attribute__((address_space(3))) bf16x8*)(kp+2560);
  kf[4]=*(const __attribute__((address_space(3))) bf16x8*)(kp+4096); kf[5]=*(const __attribute__((address_space(3))) bf16x8*)(kp+4608);
  kf[6]=*(const __attribute__((address_space(3))) bf16x8*)(kp+6144); kf[7]=*(const __attribute__((address_space(3))) bf16x8*)(kp+6656);
}
__device__ __forceinline__ void kload2(bf16x8*kf,lds_cptr kp,int j){ kf[2*j]=*(const __attribute__((address_space(3))) bf16x8*)(kp+j*2048); kf[2*j+1]=*(const __attribute__((address_space(3))) bf16x8*)(kp+j*2048+512); }
__device__ __forceinline__ s16x4 vtr(lds_cptr p){ return __builtin_bit_cast(s16x4,__builtin_amdgcn_ds_read_tr16_b64_v4i16((__attribute__((address_space(3))) v4i16_t*)p)); }
__device__ __forceinline__ float rowmax(const f32x16&p0,const f32x16&p1){
  float a=max3f(p0[0],p0[1],p1[0]),b=max3f(p0[2],p0[3],p1[1]);a=max3f(a,p1[2],p1[3]);
  #pragma unroll
  for(int r=4;r<16;r+=4){a=max3f(a,p0[r],p0[r+1]);b=max3f(b,p0[r+2],p0[r+3]);a=max3f(a,p1[r],p1[r+1]);b=max3f(b,p1[r+2],p1[r+3]);}
  const float m=max2f(a,b);
  auto rr=__builtin_amdgcn_permlane32_swap(__float_as_uint(m),__float_as_uint(m),false,false);
  return max2f(__uint_as_float(rr[0]),__uint_as_float(rr[1]));
}
__device__ __forceinline__ void pv(f32x16*o,int vb,bf16x8 pa0,bf16x8 pa1,bf16x8 pa2,bf16x8 pa3){
  #pragma unroll
  for(int d0=0;d0<2;++d0){s16x4 lo[4],hi[4];
    #pragma unroll
    for(int ks=0;ks<4;++ks){
      asm volatile("ds_read_b64_tr_b16 %0,%1 offset:%c2":"=&v"(lo[ks]):"v"(vb),"i"(d0*4096+ks*1024):"memory");
      asm volatile("ds_read_b64_tr_b16 %0,%1 offset:%c2":"=&v"(hi[ks]):"v"(vb),"i"(d0*4096+ks*1024+512):"memory");}
    asm volatile("s_waitcnt lgkmcnt(0)":::"memory");SBAR();
    #define PK(k) (bf16x8){lo[k][0],lo[k][1],lo[k][2],lo[k][3],hi[k][0],hi[k][1],hi[k][2],hi[k][3]}
    o[d0]=__builtin_amdgcn_mfma_f32_32x32x16_bf16(pa0,PK(0),o[d0],0,0,0);
    o[d0]=__builtin_amdgcn_mfma_f32_32x32x16_bf16(pa1,PK(1),o[d0],0,0,0);
    o[d0]=__builtin_amdgcn_mfma_f32_32x32x16_bf16(pa2,PK(2),o[d0],0,0,0);
    o[d0]=__builtin_amdgcn_mfma_f32_32x32x16_bf16(pa3,PK(3),o[d0],0,0,0);
    #undef PK
  }
}

#ifndef ATTN_STORE16
#define ATTN_STORE16(p,v) (*(u32x4*)(p)=(v))
#endif
template<int THRL> __device__ __forceinline__ void attn_unit(int b,int h,int qb,const bf16*Q,const bf16*__restrict__ K,const bf16*__restrict__ V,bf16*O,char*shm){
  const int tid=threadIdx.x,lane=tid&63,r32=lane&31,hi=lane>>5; const int wid=__builtin_amdgcn_readfirstlane(tid>>6);
  const long rowbase=(long)b*SEQ; const int q0=qb*QB;
  const bf16*Qw=Q+(rowbase+q0+wid*QBLK)*QP+(h>>1)*D;
  const bf16*Kh=K+rowbase*KP+(h>>1)*D,*Vh=V+rowbase*VP+(h>>2)*128+(h&1)*D;
  const unsigned lds0=(unsigned)(uintptr_t)shm;
  float*wsf=(float*)(shm+LDS_WS)+wid*64;
  const bf16*ksrc=Kh+(long)lane*KP+wid*8;
  const bf16*vsrc=Vh+(long)(16*(wid&3)+(lane>>2))*VP+(wid>>2)*32+(lane&3)*8;
  const unsigned kdst=lds0+LDS_K+wid*1024, vdst=lds0+LDS_V+wid*1024;
  #define DMA_K(t,slot) glds16(ksrc+(long)(t)*KVBLK*KP,(unsigned)__builtin_amdgcn_readfirstlane(kdst+(slot)))
  #define DMA_V(t,slot) glds16(vsrc+(long)(t)*KVBLK*VP,(unsigned)__builtin_amdgcn_readfirstlane(vdst+(slot)))
  const int vb0=(int)(lds0+LDS_V)+((lane>>4)&1)*32+(lane&3)*8+(4*hi+((lane&15)>>2))*64;
  const char*Kbase=shm+LDS_K; bf16x8 kf[8];
  const lds_cptr shm3=(lds_cptr)shm; const lds_cptr kp0=shm3+LDS_K+hi*1024+r32*16; const lds_cptr vp0=shm3+LDS_V+((lane>>4)&1)*32+(lane&3)*8+(4*hi+((lane&15)>>2))*64;
  const int NT=(q0+QB)/KVBLK;
  DMA_K(0,0);DMA_V(0,0);DMA_K(1,SLOTB);
  bf16x8 qr[4];
  #pragma unroll
  for(int d0=0;d0<4;++d0)qr[d0]=*reinterpret_cast<const bf16x8*>(&Qw[(long)r32*QP+d0*16+hi*8]);
  float mhat=0.f,l_reg=0.f;f32x16 o[2];o[0]=f32x16{};o[1]=f32x16{};f32x16 negm=f32x16{};asm volatile("":"+v"(negm));
  const int qrel=wid*QBLK+r32;
  #define CMASK(P0,P1,t) do{int jb_=(t)-(NT-4); if(jb_>=0)cmask(P0,P1,jb_,qrel,hi);}while(0)
  bool resc=false;
  #define START(P0,P1) do{ const float rm=rowmax(P0,P1); resc=false; \
    { const float dl=rm; mhat=fadd_s(mhat,dl); \
      _Pragma("unroll") for(int r=0;r<16;++r){P0[r]=fsub_s(P0[r],dl);P1[r]=fsub_s(P1[r],dl);} \
      _Pragma("unroll") for(int r=0;r<16;++r)negm[r]=-mhat; asm volatile("":"+v"(negm)); } \
    _Pragma("unroll") for(int r=0;r<16;++r)P0[r]=__builtin_amdgcn_exp2f(P0[r]); }while(0)
  #define RESC() do{ if(resc){ asm volatile("s_waitcnt lgkmcnt(0)":::"memory"); \
      _Pragma("unroll") for(int d_=0;d_<2;++d_) _Pragma("unroll") for(int r=0;r<16;++r)o[d_][r]*=wsf[crow(r,hi)]; } }while(0)
  f32x16 pA0,pA1,pB0,pB1;
  int sl_prev=0,sl_cur=0,sl_next=SLOTB;
  #define ROT() do{sl_prev=sl_cur;sl_cur=sl_next;sl_next=(sl_next==(NSLOT-1)*SLOTB)?0:sl_next+SLOTB;}while(0)
  DMA_K(2,2*SLOTB);
  WAIT_BAR(3);
  qkt(pA0,pA1,Kbase,qr,negm,r32,hi);asm volatile("s_nop 15\n\ts_nop 7":"+v"(pA0),"+v"(pA1));CMASK(pA0,pA1,0);
  START(pA0,pA1);
  _Pragma("unroll") for(int r=0;r<16;++r)pA1[r]=__builtin_amdgcn_exp2f(pA1[r]);
  WAIT_BAR(0);
  DMA_K(3,0);DMA_V(1,SLOTB);
  ROT();
  kload8(kf,kp0+sl_cur);
  WAIT_BAR(2);
  s16x4 vlo[8],vhi[8]; u32x4 pw0,pw1,pw2,pw3;
  #define PKW(P,B) cvtpk_s(P[B],P[B+1])
  #define PAF(k) __builtin_bit_cast(bf16x8,pw##k)
  #define VFR(i) (bf16x8){vlo[i][0],vlo[i][1],vlo[i][2],vlo[i][3],vhi[i][0],vhi[i][1],vhi[i][2],vhi[i][3]}
  #define PIN(x) asm volatile("":"+v"(x))
  #define MX3(a,b,c) __builtin_fmaxf(__builtin_fmaxf((a),(b)),(c))
  #define GAPA(MF,A0,A1,A2,A3,W0,W1,PW) do{ MF; sacc+=A0; sacc+=A1; sacc+=A2; sacc+=A3; PIN(sacc); W0; W1; PIN(PW); SBAR(); }while(0)
  #define EX(v) __builtin_amdgcn_exp2f(v)
  #define GAPB(MF,X,B) do{ MF; X[B]=EX(X[B]); X[B+1]=EX(X[B+1]); X[B+2]=EX(X[B+2]); X[B+3]=EX(X[B+3]); PIN(X); SBAR(); }while(0)
  #define VRD(i) do{ vlo[i]=vtr(vp_+(((i)>>2)*4096+((i)&3)*1024)); vhi[i]=vtr(vp_+(((i)>>2)*4096+((i)&3)*1024+512)); }while(0)
  #define KRD(G,j) do{ if(G){ kload2(kf,kp0+sl_next,j); SBAR(); } }while(0)
  #define STEP(C0,C1,P0,P1,t,GK,GV,GL) do{ SBAR(); \
    const lds_cptr vp_=vp0+sl_prev; \
    VRD(0); SBAR(); float sacc=(P0[0]+P0[1]); \
    GAPA(C0=__builtin_amdgcn_mfma_f32_32x32x16_bf16(kf[0],qr[0],negm,0,0,0), P0[2],P0[3],P0[4],P0[5],     pw0[0]=PKW(P0,0), pw0[1]=PKW(P0,2), pw0); \
    VRD(4); SBAR(); GAPA(C1=__builtin_amdgcn_mfma_f32_32x32x16_bf16(kf[1],qr[0],negm,0,0,0), P0[6],P0[7],P0[8],P0[9],     pw0[2]=PKW(P0,4), pw0[3]=PKW(P0,6), pw0); \
    VRD(1); SBAR(); GAPA(C0=__builtin_amdgcn_mfma_f32_32x32x16_bf16(kf[2],qr[1],C0,0,0,0),   P0[10],P0[11],P0[12],P0[13], pw1[0]=PKW(P0,8), pw1[1]=PKW(P0,10), pw1); \
    VRD(5); SBAR(); GAPA(C1=__builtin_amdgcn_mfma_f32_32x32x16_bf16(kf[3],qr[1],C1,0,0,0),   P0[14],P0[15],P1[0],P1[1],   pw1[2]=PKW(P0,12),pw1[3]=PKW(P0,14), pw1); \
    VRD(2); SBAR(); GAPA(C0=__builtin_amdgcn_mfma_f32_32x32x16_bf16(kf[4],qr[2],C0,0,0,0),   P1[2],P1[3],P1[4],P1[5],     pw2[0]=PKW(P1,0), pw2[1]=PKW(P1,2), pw2); \
    VRD(6); SBAR(); GAPA(C1=__builtin_amdgcn_mfma_f32_32x32x16_bf16(kf[5],qr[2],C1,0,0,0),   P1[6],P1[7],P1[8],P1[9],     pw2[2]=PKW(P1,4), pw2[3]=PKW(P1,6), pw2); \
    VRD(3); SBAR(); GAPA(C0=__builtin_amdgcn_mfma_f32_32x32x16_bf16(kf[6],qr[3],C0,0,0,0),   P1[10],P1[11],P1[12],P1[13], pw3[0]=PKW(P1,8), pw3[1]=PKW(P1,10), pw3); \
    VRD(7); SBAR(); GAPA(C1=__builtin_amdgcn_mfma_f32_32x32x16_bf16(kf[7],qr[3],C1,0,0,0),   P1[14],P1[15],0.f,0.f,       pw3[2]=PKW(P1,12),pw3[3]=PKW(P1,14), pw3); \
    l_reg+=sacc; \
    if(GK){DMA_K((t)+3,sl_cur);} if(GV){DMA_V((t)+1,sl_next);} \
    CMASK(C0,C1,t); \
    { float a=MX3(C0[0],C0[1],C1[0]),b=MX3(C0[2],C0[3],C1[1]); a=MX3(a,C1[2],C1[3]); \
      _Pragma("unroll") for(int r=4;r<16;r+=4){a=MX3(a,C0[r],C0[r+1]);b=MX3(b,C0[r+2],C0[r+3]);a=MX3(a,C1[r],C1[r+1]);b=MX3(b,C1[r+2],C1[r+3]);} \
      float rm=__builtin_fmaxf(a,b); { auto rr=__builtin_amdgcn_permlane32_swap(__float_as_uint(rm),__float_as_uint(rm),false,false); rm=__builtin_fmaxf(__uint_as_float(rr[0]),__uint_as_float(rr[1])); } \
      resc=false; \
      if(__builtin_expect(__any(rm>(float)THRL),0)){ const float dl=__builtin_fmaxf(rm,0.f); mhat+=dl; \
        _Pragma("unroll") for(int r=0;r<16;++r){C0[r]-=dl;C1[r]-=dl;} \
        _Pragma("unroll") for(int r=0;r<16;++r)negm[r]=-mhat; asm volatile("":"+v"(negm)); \
        const float f=__builtin_amdgcn_exp2f(-dl); l_reg*=f; if(hi==0)wsf[r32]=f; resc=true; } } \
    SBAR(); \
    GAPB(o[0]=__builtin_amdgcn_mfma_f32_32x32x16_bf16(PAF(0),VFR(0),o[0],0,0,0), C0,0); \
    GAPB(o[1]=__builtin_amdgcn_mfma_f32_32x32x16_bf16(PAF(0),VFR(4),o[1],0,0,0), C0,4); \
    KRD(GL,0); GAPB(o[0]=__builtin_amdgcn_mfma_f32_32x32x16_bf16(PAF(1),VFR(1),o[0],0,0,0), C0,8); \
    KRD(GL,1); GAPB(o[1]=__builtin_amdgcn_mfma_f32_32x32x16_bf16(PAF(1),VFR(5),o[1],0,0,0), C0,12); \
    KRD(GL,2); GAPB(o[0]=__builtin_amdgcn_mfma_f32_32x32x16_bf16(PAF(2),VFR(2),o[0],0,0,0), C1,0); \
    KRD(GL,3); GAPB(o[1]=__builtin_amdgcn_mfma_f32_32x32x16_bf16(PAF(2),VFR(6),o[1],0,0,0), C1,4); \
    GAPB(o[0]=__builtin_amdgcn_mfma_f32_32x32x16_bf16(PAF(3),VFR(3),o[0],0,0,0), C1,8); \
    GAPB(o[1]=__builtin_amdgcn_mfma_f32_32x32x16_bf16(PAF(3),VFR(7),o[1],0,0,0), C1,12); \
    }while(0)
  int t=1;
  #undef CMASK
  #define CMASK(P0,P1,t) do{}while(0)
  for(;t+5<NT;t+=2){
    STEP(pB0,pB1,pA0,pA1,t,true,true,true);     WAIT_BAR(2); RESC(); ROT();
    STEP(pA0,pA1,pB0,pB1,t+1,true,true,true);   WAIT_BAR(2); RESC(); ROT();
  }
  #undef CMASK
  #define CMASK(P0,P1,t) do{int jb_=(t)-(NT-4); if(jb_>=0)cmask(P0,P1,jb_,qrel,hi);}while(0)
  #define ENDW(tt) do{ if((tt)+3<NT){WAIT_BAR(2);} else if((tt)+2<NT){WAIT_BAR(1);} else {WAIT_BAR(0);} }while(0)
  for(;t+1<NT;t+=2){
    STEP(pB0,pB1,pA0,pA1,t,(t+3<NT),(t+1<NT),(t+1<NT));       ENDW(t);   RESC(); ROT();
    STEP(pA0,pA1,pB0,pB1,t+1,(t+4<NT),(t+2<NT),(t+2<NT));     ENDW(t+1); RESC(); ROT();
  }
  STEP(pB0,pB1,pA0,pA1,NT-1,false,false,false); RESC();
  { float sacc=pB0[0]+pB0[1]; _Pragma("unroll") for(int r=2;r<16;++r)sacc+=pB0[r]; _Pragma("unroll") for(int r=0;r<16;++r)sacc+=pB1[r]; l_reg+=sacc;
    pw0=(u32x4){PKW(pB0,0),PKW(pB0,2),PKW(pB0,4),PKW(pB0,6)};pw1=(u32x4){PKW(pB0,8),PKW(pB0,10),PKW(pB0,12),PKW(pB0,14)};pw2=(u32x4){PKW(pB1,0),PKW(pB1,2),PKW(pB1,4),PKW(pB1,6)};pw3=(u32x4){PKW(pB1,8),PKW(pB1,10),PKW(pB1,12),PKW(pB1,14)};
    SBAR(); pv(o,vb0+sl_cur,PAF(0),PAF(1),PAF(2),PAF(3)); }
  #undef PKW
  #undef PAF
  #undef VFR
  #undef PIN
  #undef MX3
  #undef GAPA
  #undef GAPB
  #undef EX
  #undef VRD
  #undef KRD
  #undef STEP
  #undef ENDW
  {auto rr=__builtin_amdgcn_permlane32_swap(__float_as_uint(l_reg),__float_as_uint(l_reg),false,false);l_reg=__uint_as_float(rr[0])+__uint_as_float(rr[1]);}
  if(hi==0)wsf[32+r32]=l_reg;asm volatile("s_waitcnt lgkmcnt(0)":::"memory");
  float rli[16];
  #pragma unroll
  for(int r=0;r<16;++r)rli[r]=__builtin_amdgcn_rcpf(wsf[32+crow(r,hi)]);
  bf16*Ow=O+(rowbase+q0+wid*QBLK)*OP+h*D;
  { bf16*stg=(bf16*)(shm+LDS_OST)+wid*2048;
    #pragma unroll
    for(int r=0;r<16;++r){const int orow=crow(r,hi);
      #pragma unroll
      for(int d0=0;d0<2;++d0)stg[orow*64+d0*32+r32]=__float2bfloat16(o[d0][r]*rli[r]);}
    asm volatile("s_waitcnt lgkmcnt(0)":::"memory");
    #pragma unroll
    for(int i=0;i<4;++i){const int row=i*8+(lane>>3),ch=lane&7; const u32x4 v=*(const u32x4*)(stg+row*64+ch*8); ATTN_STORE16(Ow+(long)row*OP+ch*8,v);} }
  asm volatile("s_waitcnt lgkmcnt(0)\n\ts_barrier":::"memory");
  #undef DMA_K
  #undef DMA_V
  #undef CMASK
  #undef START
  #undef RESC
  #undef ROT
}
constexpr int SLOTK=8192, SLOTV=16384;
constexpr int L2_K=0, L2_V=NSLOT*SLOTK, L2_WS=L2_V+NSLOT*SLOTV, L2_OST=L2_WS+NW*64*4, L2_BYTES=L2_OST+NW*4096;
__device__ __forceinline__ void pv128(f32x16*o,int vb,bf16x8 pa0,bf16x8 pa1,bf16x8 pa2,bf16x8 pa3){
  #pragma unroll
  for(int d0=0;d0<4;++d0){s16x4 lo[4],hi[4];
    #pragma unroll
    for(int ks=0;ks<4;++ks){
      asm volatile("ds_read_b64_tr_b16 %0,%1 offset:%c2":"=&v"(lo[ks]):"v"(vb),"i"(d0*4096+ks*1024):"memory");
      asm volatile("ds_read_b64_tr_b16 %0,%1 offset:%c2":"=&v"(hi[ks]):"v"(vb),"i"(d0*4096+ks*1024+512):"memory");}
    asm volatile("s_waitcnt lgkmcnt(0)":::"memory");SBAR();
    #define PK(k) (bf16x8){lo[k][0],lo[k][1],lo[k][2],lo[k][3],hi[k][0],hi[k][1],hi[k][2],hi[k][3]}
    o[d0]=__builtin_amdgcn_mfma_f32_32x32x16_bf16(pa0,PK(0),o[d0],0,0,0);
    o[d0]=__builtin_amdgcn_mfma_f32_32x32x16_bf16(pa1,PK(1),o[d0],0,0,0);
    o[d0]=__builtin_amdgcn_mfma_f32_32x32x16_bf16(pa2,PK(2),o[d0],0,0,0);
    o[d0]=__builtin_amdgcn_mfma_f32_32x32x16_bf16(pa3,PK(3),o[d0],0,0,0);
    #undef PK
  }
}
__device__ __forceinline__ void attn_unit128(int b,int hm,int qb,const bf16*Q,const bf16*__restrict__ K,const bf16*__restrict__ V,bf16*O,char*shm){
  const int tid=threadIdx.x,lane=tid&63,r32=lane&31,hi=lane>>5; const int wid=__builtin_amdgcn_readfirstlane(tid>>6);
  const long rowbase=(long)b*SEQ; const int q0=qb*QB;
  const bf16*Qw=Q+(rowbase+q0+wid*QBLK)*QP+hm*D;
  const bf16*Kh=K+rowbase*KP+hm*D,*Vh=V+rowbase*VP+(hm>>1)*128;
  const unsigned lds0=(unsigned)(uintptr_t)shm;
  float*wsf=(float*)(shm+L2_WS)+wid*64;
  const bf16*ksrc=Kh+(long)lane*KP+wid*8;
  const bf16*vsrc=Vh+(long)(16*(wid&3)+(lane>>2))*VP+(wid>>2)*32+(lane&3)*8;
  const unsigned kdst=lds0+L2_K+wid*1024, vdst=lds0+L2_V+(wid>>2)*4096+(wid&3)*1024;
  #define DMA_K(t,slot) glds16(ksrc+(long)(t)*KVBLK*KP,(unsigned)__builtin_amdgcn_readfirstlane(kdst+(slot)))
  #define DMA_V(t,slot) do{ glds16(vsrc+(long)(t)*KVBLK*VP,(unsigned)__builtin_amdgcn_readfirstlane(vdst+2*(slot))); glds16(vsrc+(long)(t)*KVBLK*VP+64,(unsigned)__builtin_amdgcn_readfirstlane(vdst+2*(slot)+8192)); }while(0)
  const int vb0=(int)(lds0+L2_V)+((lane>>4)&1)*32+(lane&3)*8+(4*hi+((lane&15)>>2))*64;
  const char*Kbase=shm+L2_K; bf16x8 kf[8];
  const lds_cptr shm3=(lds_cptr)shm; const lds_cptr kp0=shm3+L2_K+hi*1024+r32*16; const lds_cptr vp0=shm3+L2_V+((lane>>4)&1)*32+(lane&3)*8+(4*hi+((lane&15)>>2))*64;
  const int NT=(q0+QB)/KVBLK;
  DMA_K(0,0);DMA_V(0,0);DMA_K(1,SLOTK);
  bf16x8 qr[4];
  #pragma unroll
  for(int d0=0;d0<4;++d0)qr[d0]=*reinterpret_cast<const bf16x8*>(&Qw[(long)r32*QP+d0*16+hi*8]);
  float l_reg=0.f;f32x16 o[4];o[0]=f32x16{};o[1]=f32x16{};o[2]=f32x16{};o[3]=f32x16{};
  const f32x16 zero=f32x16{};
  const int qrel=wid*QBLK+r32;
  #define CMASK(P0,P1,t) do{int jb_=(t)-(NT-4); if(jb_>=0)cmask(P0,P1,jb_,qrel,hi);}while(0)
  f32x16 pA0,pA1,pB0,pB1;
  int sl_prev=0,sl_cur=0,sl_next=SLOTK;
  #define ROT() do{sl_prev=sl_cur;sl_cur=sl_next;sl_next=(sl_next==(NSLOT-1)*SLOTK)?0:sl_next+SLOTK;}while(0)
  DMA_K(2,2*SLOTK);
  WAIT_BAR(4);
  qkt(pA0,pA1,Kbase,qr,zero,r32,hi);asm volatile("s_nop 15\n\ts_nop 7":"+v"(pA0),"+v"(pA1));CMASK(pA0,pA1,0);
  _Pragma("unroll") for(int r=0;r<16;++r){pA0[r]=__builtin_amdgcn_exp2f(pA0[r]);pA1[r]=__builtin_amdgcn_exp2f(pA1[r]);}
  WAIT_BAR(0);
  DMA_K(3,0);DMA_V(1,SLOTK);
  ROT();
  kload8(kf,kp0+sl_cur);
  WAIT_BAR(3);
  s16x4 vlo[4],vhi[4]; u32x4 pw0,pw1,pw2,pw3;
  #define PKW(P,B) cvtpk_s(P[B],P[B+1])
  #define PAF(k) __builtin_bit_cast(bf16x8,pw##k)
  #define VFR(i) (bf16x8){vlo[i][0],vlo[i][1],vlo[i][2],vlo[i][3],vhi[i][0],vhi[i][1],vhi[i][2],vhi[i][3]}
  #define PIN(x) asm volatile("":"+v"(x))
  #define GAPA(MF,A0,A1,A2,A3,W0,W1,PW) do{ MF; sacc+=A0; sacc+=A1; sacc+=A2; sacc+=A3; PIN(sacc); W0; W1; PIN(PW); SBAR(); }while(0)
  #define EX(v) __builtin_amdgcn_exp2f(v)
  #define DB(j) ((((j)&1))+2*((j)>>3))
  #define KS(j) (((j)>>1)&3)
  #define VRDJ(j) do{ vlo[(j)&3]=vtr(vp_+(DB(j)*4096+KS(j)*1024)); vhi[(j)&3]=vtr(vp_+(DB(j)*4096+KS(j)*1024+512)); SBAR(); }while(0)
  #define GAPB2(j,PF,X,B) do{ o[DB(j)]=__builtin_amdgcn_mfma_f32_32x32x16_bf16(PF,VFR((j)&3),o[DB(j)],0,0,0); X[B]=EX(X[B]); X[B+1]=EX(X[B+1]); PIN(X); SBAR(); }while(0)
  #define KRD(G,j) do{ if(G){ kload2(kf,kp0+sl_next,j); SBAR(); } }while(0)
  #define MF32(a,b,c) __builtin_amdgcn_mfma_f32_32x32x16_bf16(a,b,c,0,0,0)
  #define STEP(C0,C1,P0,P1,t,GK,GV,GL) do{ SBAR(); \
    const lds_cptr vp_=vp0+2*sl_prev; \
    float sacc=(P0[0]+P0[1]); \
    GAPA(C0=MF32(kf[0],qr[0],zero), P0[2],P0[3],P0[4],P0[5],     pw0[0]=PKW(P0,0), pw0[1]=PKW(P0,2), pw0); \
    GAPA(C1=MF32(kf[1],qr[0],zero), P0[6],P0[7],P0[8],P0[9],     pw0[2]=PKW(P0,4), pw0[3]=PKW(P0,6), pw0); \
    GAPA(C0=MF32(kf[2],qr[1],C0),   P0[10],P0[11],P0[12],P0[13], pw1[0]=PKW(P0,8), pw1[1]=PKW(P0,10), pw1); \
    GAPA(C1=MF32(kf[3],qr[1],C1),   P0[14],P0[15],P1[0],P1[1],   pw1[2]=PKW(P0,12),pw1[3]=PKW(P0,14), pw1); \
    GAPA(C0=MF32(kf[4],qr[2],C0),   P1[2],P1[3],P1[4],P1[5],     pw2[0]=PKW(P1,0), pw2[1]=PKW(P1,2), pw2); \
    VRDJ(0); GAPA(C1=MF32(kf[5],qr[2],C1),   P1[6],P1[7],P1[8],P1[9],     pw2[2]=PKW(P1,4), pw2[3]=PKW(P1,6), pw2); \
    VRDJ(1); GAPA(C0=MF32(kf[6],qr[3],C0),   P1[10],P1[11],P1[12],P1[13], pw3[0]=PKW(P1,8), pw3[1]=PKW(P1,10), pw3); \
    VRDJ(2); GAPA(C1=MF32(kf[7],qr[3],C1),   P1[14],P1[15],0.f,0.f,       pw3[2]=PKW(P1,12),pw3[3]=PKW(P1,14), pw3); \
    l_reg+=sacc; \
    if(GK){DMA_K((t)+3,sl_cur);} if(GV){DMA_V((t)+1,sl_next);} \
    CMASK(C0,C1,t); \
    SBAR(); \
    GAPB2(0,PAF(0),C0,0);  VRDJ(3); \
    GAPB2(1,PAF(0),C0,2);  VRDJ(4); \
    KRD(GL,0); GAPB2(2,PAF(1),C0,4);  VRDJ(5); \
    KRD(GL,1); GAPB2(3,PAF(1),C0,6);  VRDJ(6); \
    KRD(GL,2); GAPB2(4,PAF(2),C0,8);  VRDJ(7); \
    KRD(GL,3); GAPB2(5,PAF(2),C0,10); VRDJ(8); \
    GAPB2(6,PAF(3),C0,12); VRDJ(9); \
    GAPB2(7,PAF(3),C0,14); VRDJ(10); \
    GAPB2(8,PAF(0),C1,0);  VRDJ(11); \
    GAPB2(9,PAF(0),C1,2);  VRDJ(12); \
    GAPB2(10,PAF(1),C1,4); VRDJ(13); \
    GAPB2(11,PAF(1),C1,6); VRDJ(14); \
    GAPB2(12,PAF(2),C1,8); VRDJ(15); \
    GAPB2(13,PAF(2),C1,10); \
    GAPB2(14,PAF(3),C1,12); \
    GAPB2(15,PAF(3),C1,14); \
    }while(0)
  int t=1;
  #undef CMASK
  #define CMASK(P0,P1,t) do{}while(0)
  for(;t+5<NT;t+=2){
    STEP(pB0,pB1,pA0,pA1,t,true,true,true);     WAIT_BAR(3); ROT();
    STEP(pA0,pA1,pB0,pB1,t+1,true,true,true);   WAIT_BAR(3); ROT();
  }
  #undef CMASK
  #define CMASK(P0,P1,t) do{int jb_=(t)-(NT-4); if(jb_>=0)cmask(P0,P1,jb_,qrel,hi);}while(0)
  #define ENDW(tt) do{ if((tt)+3<NT){WAIT_BAR(3);} else if((tt)+2<NT){WAIT_BAR(2);} else {WAIT_BAR(0);} }while(0)
  for(;t+1<NT;t+=2){
    STEP(pB0,pB1,pA0,pA1,t,(t+3<NT),(t+1<NT),(t+1<NT));       ENDW(t);   ROT();
    STEP(pA0,pA1,pB0,pB1,t+1,(t+4<NT),(t+2<NT),(t+2<NT));     ENDW(t+1); ROT();
  }
  STEP(pB0,pB1,pA0,pA1,NT-1,false,false,false);
  { float sacc=pB0[0]+pB0[1]; _Pragma("unroll") for(int r=2;r<16;++r)sacc+=pB0[r]; _Pragma("unroll") for(int r=0;r<16;++r)sacc+=pB1[r]; l_reg+=sacc;
    pw0=(u32x4){PKW(pB0,0),PKW(pB0,2),PKW(pB0,4),PKW(pB0,6)};pw1=(u32x4){PKW(pB0,8),PKW(pB0,10),PKW(pB0,12),PKW(pB0,14)};pw2=(u32x4){PKW(pB1,0),PKW(pB1,2),PKW(pB1,4),PKW(pB1,6)};pw3=(u32x4){PKW(pB1,8),PKW(pB1,10),PKW(pB1,12),PKW(pB1,14)};
    SBAR(); pv128(o,vb0+2*sl_cur,PAF(0),PAF(1),PAF(2),PAF(3)); }
  #undef PKW
  #undef PAF
  #undef VFR
  #undef PIN
  #undef GAPA
  #undef GAPB2
  #undef EX
  #undef VRDJ
  #undef DB
  #undef KS
  #undef KRD
  #undef MF32
  #undef STEP
  #undef ENDW
  {auto rr=__builtin_amdgcn_permlane32_swap(__float_as_uint(l_reg),__float_as_uint(l_reg),false,false);l_reg=__uint_as_float(rr[0])+__uint_as_float(rr[1]);}
  if(hi==0)wsf[32+r32]=l_reg;asm volatile("s_waitcnt lgkmcnt(0)":::"memory");
  float rli[16];
  #pragma unroll
  for(int r=0;r<16;++r)rli[r]=__builtin_amdgcn_rcpf(wsf[32+crow(r,hi)]);
  bf16*Ow=O+(rowbase+q0+wid*QBLK)*OP+hm*128;
  { bf16*stg=(bf16*)(shm+L2_OST)+wid*2048;
    #pragma unroll
    for(int dh=0;dh<2;++dh){
      #pragma unroll
      for(int r=0;r<16;++r){const int orow=crow(r,hi);
        #pragma unroll
        for(int d0=0;d0<2;++d0)stg[orow*64+d0*32+r32]=__float2bfloat16(o[2*dh+d0][r]*rli[r]);}
      asm volatile("s_waitcnt lgkmcnt(0)":::"memory");
      #pragma unroll
      for(int i=0;i<4;++i){const int row=i*8+(lane>>3),ch=lane&7; const u32x4 v=*(const u32x4*)(stg+row*64+ch*8); ATTN_STORE16(Ow+(long)row*OP+dh*64+ch*8,v);}
      asm volatile("s_waitcnt lgkmcnt(0)":::"memory"); } }
  asm volatile("s_waitcnt lgkmcnt(0)\n\ts_barrier":::"memory");
  #undef DMA_K
  #undef DMA_V
  #undef CMASK
  #undef ROT
}
struct AttnUnit128 { int bh; int qb; };
struct StaticOrder128 {
  int vcu;
  __device__ __forceinline__ explicit StaticOrder128(int grid,int block):vcu((block%8)*(grid/8)+block/8){}
#ifdef PROBE_DUP_ATTN2
  __device__ __forceinline__ bool next(int ii,AttnUnit128&u)const{ if(ii>=8)return false; const int i=ii>>1; const int s=vcu&7; u.bh=vcu>>3; u.qb=(i==0)?s:(i==1)?15-s:(i==2)?16+s:31-s; return true; }
#else
  __device__ __forceinline__ bool next(int i,AttnUnit128&u)const{ if(i>=4)return false; const int s=vcu&7; u.bh=vcu>>3; u.qb=(i==0)?s:(i==1)?15-s:(i==2)?16+s:31-s; return true; }
#endif
};
__device__ __forceinline__ void attn_phase128(char*lds,const bf16*Q,const bf16*K,const bf16*V,bf16*O,const StaticOrder128&S){
  AttnUnit128 u;
  for(int i=0;S.next(i,u);++i) attn_unit128(u.bh>>3,u.bh&7,u.qb,Q,K,V,O,lds);
}
constexpr int ATTN_LDS_BYTES=LDS_BYTES;
struct AttnTensors { const bf16* Q; const bf16* K; const bf16* V; bf16* O; };
struct AttnUnit { int bh; int qb; };
struct StaticOrder {
  int vcu;
  __device__ __forceinline__ explicit StaticOrder(int grid,int block):vcu((block%8)*(grid/8)+block/8){}
  __device__ __forceinline__ bool next(int i,AttnUnit&u)const{ if(i>=8)return false; const int s=vcu&7,j=i&3; u.bh=2*(vcu>>3)+(i>>2); u.qb=(j==0)?s:(j==1)?15-s:(j==2)?16+s:31-s; return true; }
  __device__ __forceinline__ void a_ready(const AttnUnit&)const{}
  __device__ __forceinline__ void done(const AttnUnit&)const{}
};
template<class Sched,int THRL=8> __device__ __forceinline__ void attn_phase(char*lds,const AttnTensors&T,const Sched&S){
  AttnUnit u;
  for(int i=0;S.next(i,u);++i){ S.a_ready(u); attn_unit<THRL>(u.bh/NHEAD,u.bh%NHEAD,u.qb,T.Q,T.K,T.V,T.O,lds); S.done(u); }
}
#undef SBAR
#undef WAIT_BAR
}

constexpr int NWAVES = 8;
constexpr int BATCH = 4, T = 8192, D = 1024, M = BATCH * T, DEPTH = 2;
constexpr int IN_COLS = 3088, NIN = 3328;
constexpr int NEXP = 16384;
constexpr float RMS_EPS = 1e-6f;
constexpr int NPHASE = 24;
#ifndef MK_PER_PHASE
#define MK_PER_PHASE 0
#endif

constexpr size_t MiB = 1u << 20;
constexpr size_t WS_CTL = 0, CTL_ZERO_BYTES = 1 * MiB;
constexpr size_t WS_WIN = 2 * MiB;
constexpr size_t WS_WOUT = 16 * MiB;
constexpr size_t WS_WQ = 20 * MiB;
constexpr size_t WS_SK = 28 * MiB;
constexpr size_t WS_USC = 30 * MiB, WS_VSC = 30 * MiB + 256 * 1024;
constexpr size_t WS_TU = 32 * MiB, WS_TV = 64 * MiB;
constexpr size_t WS_XN8 = 96 * MiB;
constexpr size_t WS_XN = 96 * MiB;
constexpr size_t WS_Q = 160 * MiB, WS_K = 192 * MiB, WS_DV = 224 * MiB;
constexpr size_t WS_GQ = 256 * MiB;
constexpr size_t WS_GO = 272 * MiB;
constexpr size_t WS_OI = 304 * MiB;
constexpr size_t WS_UT = 336 * MiB;
constexpr size_t WS_GK = 400 * MiB, WS_GV = 416 * MiB, WS_GLOG = 448 * MiB;
constexpr size_t WS_O = 96 * MiB;
constexpr size_t WS_RES = 336 * MiB;
constexpr size_t WS_USUM = 304 * MiB, WS_PDS = 312 * MiB;
constexpr size_t WS_Q2 = 160 * MiB;
constexpr size_t WS_IDX = 288 * MiB, WS_GATE = 304 * MiB;
constexpr size_t WS_EW8 = 320 * MiB, WS_EWSC = 324 * MiB;
constexpr size_t WS_PART = 400 * MiB;
constexpr size_t WS_SSQ = 18 * MiB;
constexpr size_t WS_AS = 29 * MiB;
constexpr size_t WS_WCS = 29 * MiB + 512 * 1024;
constexpr size_t WS_RS = 30 * MiB + 512 * 1024;
constexpr size_t WS_END = 480 * MiB;
static_assert(WS_GLOG + (size_t)M * 256 * 4 <= WS_END && WS_PART + (size_t)8 * M * 128 * 2 <= WS_END, "workspace map");
constexpr size_t WS_WQCS = 29 * MiB + 640 * 1024;
constexpr int CW_BAR = 4096;
constexpr int CW_LBAR = 13312;
constexpr size_t WS_WOCS = 29 * MiB + 576 * 1024;
constexpr size_t OUT_MIX8 = 64 * MiB, OUT_MS = 96 * MiB;
static_assert(pg8::WSO_Q == WS_Q && pg8::WSO_K == WS_K && pg8::WSO_DV == WS_DV && pg8::WSO_GQ == WS_GQ && pg8::WSO_GO == WS_GO && pg8::WSO_GK == WS_GK && pg8::WSO_GV == WS_GV && pg8::WSO_GLOG == WS_GLOG, "epilogue offsets");

constexpr int RING_OFF = 0, RING_BYTES = 131072;
constexpr int LDSCTL_OFF = RING_BYTES, MISC_OFF = LDSCTL_OFF + 320;
constexpr int LDS_BYTES = 147456;

#define GAS __attribute__((address_space(1)))
#define LAS __attribute__((address_space(3)))
typedef unsigned short bf16;
typedef unsigned v4u __attribute__((ext_vector_type(4)));
typedef unsigned v2u __attribute__((ext_vector_type(2)));
typedef float f32x4 __attribute__((ext_vector_type(4)));
typedef float f32x16 __attribute__((ext_vector_type(16)));
typedef short bf16x8 __attribute__((ext_vector_type(8)));
typedef GAS unsigned gu32;
#define RLX_AGENT __ATOMIC_RELAXED, __HIP_MEMORY_SCOPE_AGENT
#define LDS_WAIT() asm volatile("s_waitcnt lgkmcnt(0)" ::: "memory")
__device__ __forceinline__ unsigned f2bf(float f) { unsigned u = __builtin_bit_cast(unsigned, f); return (u + 0x7fffu + ((u >> 16) & 1u)) >> 16; }
__device__ __forceinline__ unsigned pk2(float lo, float hi) { return f2bf(lo) | (f2bf(hi) << 16); }
__device__ __forceinline__ float bf2f(unsigned short h) { return __builtin_bit_cast(float, (unsigned)h << 16); }
__device__ __forceinline__ float bflo(unsigned w) { return __builtin_bit_cast(float, w << 16); }
__device__ __forceinline__ float bfhi(unsigned w) { return __builtin_bit_cast(float, w & 0xffff0000u); }

#define XB_TMO      128
#define XB_XCNT(j)  (256  + 64 * (j))
#define XB_XSUB(j)  (1280 + 64 * (j))
#define XB_XGEN(j)  (2304 + 64 * (j))
#define XB_TOP      3328
#define XB_TOPGEN   3392
#define XCD_BAR_WORDS 3456
#define XB_SPIN_CAP (1u << 18)

__device__ __forceinline__ unsigned xb_ld(unsigned* p)              { return __hip_atomic_load(p, __ATOMIC_RELAXED, __HIP_MEMORY_SCOPE_AGENT); }
__device__ __forceinline__ unsigned xb_add(unsigned* p, unsigned v) { return __hip_atomic_fetch_add(p, v, __ATOMIC_RELAXED, __HIP_MEMORY_SCOPE_AGENT); }
__device__ __forceinline__ unsigned xb_xcc_id() { return (unsigned)__builtin_amdgcn_s_getreg((3 << 11) | 20) & 0xFu; }
#define XB_SPIN(cond, bar) do { unsigned _sp = 0; while (cond) { __builtin_amdgcn_s_sleep(1); \
    if ((++_sp & 255u) == 0u) { if (xb_ld(&(bar)[XB_TMO])) break; if (_sp > XB_SPIN_CAP) { atomicAdd(&(bar)[XB_TMO], 1u); break; } } } } while (0)

struct XcdBarrier {
    unsigned* bar; unsigned x;
    volatile LAS unsigned* st;
};

__device__ __forceinline__ XcdBarrier xcd_barrier_post(unsigned* bar, volatile LAS unsigned* st) {
    XcdBarrier b; b.bar = bar; b.x = xb_xcc_id(); b.st = st;
    if (threadIdx.x == 0) st[2] = xb_add(&bar[XB_XCNT(b.x)], 1u);
    return b;
}
__device__ __forceinline__ void xcd_barrier_complete(unsigned* bar, unsigned x, unsigned& nloc, unsigned& nx) {
    const unsigned G = gridDim.x * gridDim.y * gridDim.z;
    unsigned sum, cnt, mine, sp = 0u;
    for (;;) {
        sum = 0u; cnt = 0u; mine = 0u;
#pragma unroll
        for (unsigned j = 0; j < 16; ++j) { const unsigned c = xb_ld(&bar[XB_XCNT(j)]); sum += c; cnt += (c > 0u) ? 1u : 0u; mine = (j == x) ? c : mine; }
        if (sum == G) break;
        __builtin_amdgcn_s_sleep(1);
        if ((++sp & 255u) == 0u) { if (xb_ld(&bar[XB_TMO])) break; if (sp > XB_SPIN_CAP) { atomicAdd(&bar[XB_TMO], 1u); break; } }
    }
    nloc = mine > 0u ? mine : 1u; nx = cnt > 0u ? cnt : 1u;
}

__device__ __forceinline__ void xcd_barrier(const XcdBarrier& b) {
    asm volatile("s_waitcnt vmcnt(0)" ::: "memory");
    __syncthreads();
    if (threadIdx.x == 0) {
        unsigned* bar = b.bar;
        __builtin_amdgcn_s_waitcnt(0);
        unsigned nloc = b.st[0], nx = b.st[1];
        if (nloc == 0u) { xcd_barrier_complete(bar, b.x, nloc, nx); b.st[0] = nloc; b.st[1] = nx;
            const unsigned G = gridDim.x * gridDim.y * gridDim.z; unsigned okc = (G == 256u) ? 1u : 0u;
#pragma unroll
            for (unsigned j = 0; j < 16; ++j) { const unsigned c = xb_ld(&bar[XB_XCNT(j)]); okc &= (c == (j < 8u ? G / 8u : 0u)) ? 1u : 0u; }
            b.st[3] = okc; }
        const unsigned old = xb_add(&bar[XB_XSUB(b.x)], 1u);
        const unsigned gen = old / nloc;
        if (old + 1u == (gen + 1u) * nloc) {
            __builtin_amdgcn_fence(__ATOMIC_RELEASE, "agent");
            asm volatile("s_waitcnt vmcnt(0)" ::: "memory");
            const unsigned og = xb_add(&bar[XB_TOP], 1u);
            const unsigned tg = og / nx;
            if (og + 1u == (tg + 1u) * nx) xb_add(&bar[XB_TOPGEN], 1u);
            else XB_SPIN(xb_ld(&bar[XB_TOPGEN]) == tg, bar);
            __builtin_amdgcn_fence(__ATOMIC_ACQUIRE, "agent");
            xb_add(&bar[XB_XGEN(b.x)], 1u);
            asm volatile("s_waitcnt vmcnt(0)" ::: "memory");
        } else {
            XB_SPIN(xb_ld(&bar[XB_XGEN(b.x)]) == gen, bar);
            __builtin_amdgcn_fence(__ATOMIC_ACQUIRE, "agent");
            asm volatile("s_waitcnt vmcnt(0)" ::: "memory");
        }
    }
    __syncthreads();
}

__device__ __forceinline__ void xcd_local_barrier(const XcdBarrier& b, unsigned* lbar) {
    asm volatile("s_waitcnt vmcnt(0)" ::: "memory");
    __syncthreads();
    if (threadIdx.x == 0) {
        __builtin_amdgcn_s_waitcnt(0);
        const unsigned nloc = b.st[0], gen = b.st[4]; b.st[4] = gen + 1u;
        unsigned* ctr = &lbar[64 * b.x];
        (void)xb_add(ctr, 1u);
        const unsigned target = (gen + 1u) * nloc;
        XB_SPIN(xb_ld(ctr) < target, b.bar);
        __builtin_amdgcn_fence(__ATOMIC_ACQUIRE, "agent");
        asm volatile("s_waitcnt vmcnt(0)" ::: "memory");
    }
    __syncthreads();
}

struct Args {
    const float* in[19]; float* out; unsigned char* ws; int ph_lo, ph_hi;
};
struct Frame {
    LAS unsigned char* lds;
    int tid, lane, wave, vcu, G, bx, gw, NGW;
};
enum { I_X = 0, I_ANW, I_WIN, I_QNW, I_KNW, I_LQ1, I_LK1, I_LQ2, I_LK2, I_DONW, I_GW2, I_GB, I_GONW, I_WOUT, I_FNW, I_PWQ, I_PSK, I_PU, I_PV };
typedef const __attribute__((address_space(4))) Args* KArgs;
__device__ __forceinline__ KArgs kargs() { KArgs p = (KArgs)__builtin_amdgcn_kernarg_segment_ptr(); asm volatile("" : "+s"(p)); return p; }
__device__ __forceinline__ float row16_sum(float v) {
    v += __builtin_bit_cast(float, __builtin_amdgcn_update_dpp(0, __builtin_bit_cast(int, v), 0xB1, 0xf, 0xf, true)); v += __builtin_bit_cast(float, __builtin_amdgcn_update_dpp(0, __builtin_bit_cast(int, v), 0x4E, 0xf, 0xf, true));
    v += __builtin_bit_cast(float, __builtin_amdgcn_update_dpp(0, __builtin_bit_cast(int, v), 0x141, 0xf, 0xf, true)); v += __builtin_bit_cast(float, __builtin_amdgcn_update_dpp(0, __builtin_bit_cast(int, v), 0x140, 0xf, 0xf, true));
    return v;
}
__device__ __forceinline__ float wave_max_nn(float v) {
    v = fmaxf(v, __builtin_bit_cast(float, __builtin_amdgcn_update_dpp(0, __builtin_bit_cast(int, v), 0xB1, 0xf, 0xf, true))); v = fmaxf(v, __builtin_bit_cast(float, __builtin_amdgcn_update_dpp(0, __builtin_bit_cast(int, v), 0x4E, 0xf, 0xf, true)));
    v = fmaxf(v, __builtin_bit_cast(float, __builtin_amdgcn_update_dpp(0, __builtin_bit_cast(int, v), 0x141, 0xf, 0xf, true))); v = fmaxf(v, __builtin_bit_cast(float, __builtin_amdgcn_update_dpp(0, __builtin_bit_cast(int, v), 0x140, 0xf, 0xf, true)));
    { auto rr = __builtin_amdgcn_permlane16_swap(__float_as_uint(v), __float_as_uint(v), false, false); v = fmaxf(__uint_as_float(rr[0]), __uint_as_float(rr[1])); }
    { auto rr = __builtin_amdgcn_permlane32_swap(__float_as_uint(v), __float_as_uint(v), false, false); v = fmaxf(__uint_as_float(rr[0]), __uint_as_float(rr[1])); }
    return v;
}
__device__ __forceinline__ float wave_sum(float v) { return pg8::xsum32(pg8::xsum16(row16_sum(v))); }
__device__ __forceinline__ void p0_transpose_item(const float* W, int K, int ld, int nblk, bf16* WT, int row_off, LAS float* scr, int item, int lane, const float* kscale = nullptr) {
    const int kb = item / nblk, nb = item % nblk, k0 = 64 * kb, n0 = 32 * nb;
    float tv[32];
#pragma unroll
    for (int i = 0; i < 32; ++i) tv[i] = W[(size_t)(k0 + 2 * i + (lane >> 5)) * ld + n0 + (lane & 31)];
#pragma unroll
    for (int i = 0; i < 32; ++i) scr[(2 * i + (lane >> 5)) * 33 + (lane & 31)] = tv[i];
    LDS_WAIT(); asm volatile("" ::: "memory");
    const int c = lane & 7;
    float ks[8];
#pragma unroll
    for (int i = 0; i < 8; ++i) ks[i] = kscale ? kscale[k0 + 8 * c + i] : 1.f;
#pragma unroll
    for (int j = 0; j < 4; ++j) { const int n = (lane >> 3) + 8 * j; const LAS float* s = scr + (8 * c) * 33 + n;
        v4u o; o.x = pk2(s[0 * 33] * ks[0], s[1 * 33] * ks[1]); o.y = pk2(s[2 * 33] * ks[2], s[3 * 33] * ks[3]); o.z = pk2(s[4 * 33] * ks[4], s[5 * 33] * ks[5]); o.w = pk2(s[6 * 33] * ks[6], s[7 * 33] * ks[7]);
        *(GAS v4u*)(WT + (size_t)(row_off + n0 + n) * K + k0 + 8 * c) = o; }
    LDS_WAIT(); asm volatile("" ::: "memory");
}
__device__ __forceinline__ void rms_row_to_bf16(int lane, const float* xrow, const float* w, bf16* orow) {
    const GAS f32x4* xr = (const GAS f32x4*)xrow + lane; const GAS f32x4* wr = (const GAS f32x4*)w + lane;
    f32x4 v[4]; float s = 0.f;
#pragma unroll
    for (int j = 0; j < 4; ++j) { v[j] = xr[64 * j]; s += (v[j].x * v[j].x + v[j].y * v[j].y) + (v[j].z * v[j].z + v[j].w * v[j].w); }
    const float rs = 1.f / sqrtf(wave_sum(s) * (1.f / 1024.f) + RMS_EPS);
    GAS unsigned long long* o8 = (GAS unsigned long long*)orow + lane;
#pragma unroll
    for (int j = 0; j < 4; ++j) { const f32x4 ww = wr[64 * j]; o8[64 * j] = (unsigned long long)pk2(v[j].x * rs * ww.x, v[j].y * rs * ww.y) | ((unsigned long long)pk2(v[j].z * rs * ww.z, v[j].w * rs * ww.w) << 32); }
}
__device__ __forceinline__ void rms_regs_to_bf16(int lane, const f32x4 (&v)[4], const float* w, bf16* orow) {
    const GAS f32x4* wr = (const GAS f32x4*)w + lane; float s = 0.f;
#pragma unroll
    for (int j = 0; j < 4; ++j) s += (v[j].x * v[j].x + v[j].y * v[j].y) + (v[j].z * v[j].z + v[j].w * v[j].w);
    const float rs = 1.f / sqrtf(wave_sum(s) * (1.f / 1024.f) + RMS_EPS);
    GAS unsigned long long* o8 = (GAS unsigned long long*)orow + lane;
#pragma unroll
    for (int j = 0; j < 4; ++j) { const f32x4 ww = wr[64 * j]; o8[64 * j] = (unsigned long long)pk2(v[j].x * rs * ww.x, v[j].y * rs * ww.y) | ((unsigned long long)pk2(v[j].z * rs * ww.z, v[j].w * rs * ww.w) << 32); }
}
__device__ __forceinline__ void rms_row16_to_bf16(int lane, const bf16* xrow, const float* w, bf16* orow) {
    const v4u a = ((const GAS v4u*)(xrow + 16 * lane))[0], b = ((const GAS v4u*)(xrow + 16 * lane))[1]; const unsigned ww[8] = {a.x, a.y, a.z, a.w, b.x, b.y, b.z, b.w};
    float x[16]; float s = 0.f;
#pragma unroll
    for (int q = 0; q < 8; ++q) { x[2 * q] = bflo(ww[q]); x[2 * q + 1] = bfhi(ww[q]); s += x[2 * q] * x[2 * q] + x[2 * q + 1] * x[2 * q + 1]; }
    const float rs = 1.f / sqrtf(wave_sum(s) * (1.f / 1024.f) + RMS_EPS);
    const float* wp = w + 16 * lane; v4u oa, ob;
    oa.x = pk2(x[0] * rs * wp[0], x[1] * rs * wp[1]); oa.y = pk2(x[2] * rs * wp[2], x[3] * rs * wp[3]); oa.z = pk2(x[4] * rs * wp[4], x[5] * rs * wp[5]); oa.w = pk2(x[6] * rs * wp[6], x[7] * rs * wp[7]);
    ob.x = pk2(x[8] * rs * wp[8], x[9] * rs * wp[9]); ob.y = pk2(x[10] * rs * wp[10], x[11] * rs * wp[11]); ob.z = pk2(x[12] * rs * wp[12], x[13] * rs * wp[13]); ob.w = pk2(x[14] * rs * wp[14], x[15] * rs * wp[15]);
    ((GAS v4u*)(orow + 16 * lane))[0] = oa; ((GAS v4u*)(orow + 16 * lane))[1] = ob;
}
__device__ __forceinline__ void conv_bf16(const float* src, bf16* dst, size_t n8, size_t gtid, size_t nthr) {
    for (size_t i = gtid; i < n8; i += nthr) { const f32x4 a = ((const GAS f32x4*)src)[2 * i], b = ((const GAS f32x4*)src)[2 * i + 1];
        v4u o; o.x = pk2(a.x, a.y); o.y = pk2(a.z, a.w); o.z = pk2(b.x, b.y); o.w = pk2(b.z, b.w); ((GAS v4u*)dst)[i] = o; }
}
template <bool OFFS> __device__ __forceinline__ void quant_row(int lane, const float* src, unsigned char* dst, float* scale_out) {
    const GAS f32x4* p = (const GAS f32x4*)(src + 16 * lane); f32x4 v[4]; float am = 0.f;
#pragma unroll
    for (int j = 0; j < 4; ++j) { v[j] = p[j]; am = fmaxf(fmaxf(am, fmaxf(fabsf(v[j].x), fabsf(v[j].y))), fmaxf(fabsf(v[j].z), fabsf(v[j].w))); }
    am = wave_max_nn(am);
    const float inv = am > 0.f ? 127.f / am : 0.f; const int off = OFFS ? 128 : 0;
    v4u o4; unsigned w[4];
#pragma unroll
    for (int j = 0; j < 4; ++j) { const int b0 = (int)rintf(v[j].x * inv) + off, b1 = (int)rintf(v[j].y * inv) + off, b2 = (int)rintf(v[j].z * inv) + off, b3 = (int)rintf(v[j].w * inv) + off;
        w[j] = (unsigned)(b0 & 0xff) | ((unsigned)(b1 & 0xff) << 8) | ((unsigned)(b2 & 0xff) << 16) | ((unsigned)(b3 & 0xff) << 24); }
    o4.x = w[0]; o4.y = w[1]; o4.z = w[2]; o4.w = w[3];
    *(GAS v4u*)(dst + (size_t)(lane >> 3) * NEXP * 128 + 16 * (lane & 7)) = o4;
    if (lane == 0) *scale_out = am * (1.f / 127.f);
}
__device__ __forceinline__ void quant_row_regs(int lane, const f32x4 (&v)[4], unsigned char* dst, float* scale_out) {
    float am = 0.f;
#pragma unroll
    for (int j = 0; j < 4; ++j) am = fmaxf(fmaxf(am, fmaxf(fabsf(v[j].x), fabsf(v[j].y))), fmaxf(fabsf(v[j].z), fabsf(v[j].w)));
    am = wave_max_nn(am);
    const float inv = am > 0.f ? 127.f / am : 0.f;
    v4u o4; unsigned w[4];
#pragma unroll
    for (int j = 0; j < 4; ++j) { const int b0 = (int)rintf(v[j].x * inv), b1 = (int)rintf(v[j].y * inv), b2 = (int)rintf(v[j].z * inv), b3 = (int)rintf(v[j].w * inv);
        w[j] = (unsigned)(b0 & 0xff) | ((unsigned)(b1 & 0xff) << 8) | ((unsigned)(b2 & 0xff) << 16) | ((unsigned)(b3 & 0xff) << 24); }
    o4.x = w[0]; o4.y = w[1]; o4.z = w[2]; o4.w = w[3];
    *(GAS v4u*)(dst + (size_t)(lane >> 3) * NEXP * 128 + 16 * (lane & 7)) = o4;
    if (lane == 0) *scale_out = am * (1.f / 127.f);
}
__device__ __forceinline__ void quant_tables(KArgs A, int layer, int gw0, int ngw, int lane, int rlo = 0, int rhi = 2 * NEXP) {
    unsigned char* const ws = A->ws;
    f32x4 wfv[4];
#pragma unroll
    for (int j = 0; j < 4; ++j) wfv[j] = ((const GAS f32x4*)(A->in[I_FNW] + layer * D + 16 * lane))[j];
    for (int r0 = rlo + gw0; r0 < rhi; r0 += 2 * ngw) {
        f32x4 va[4], vb[4]; const int r1 = r0 + ngw; const bool has1 = r1 < rhi;
        const int isv0 = r0 >= NEXP, isv1 = r1 >= NEXP; const int row0 = layer * NEXP + (isv0 ? r0 - NEXP : r0), row1 = layer * NEXP + (isv1 ? r1 - NEXP : r1);
        const GAS f32x4* p0 = (const GAS f32x4*)((isv0 ? A->in[I_PV] : A->in[I_PU]) + (size_t)row0 * D + 16 * lane); const GAS f32x4* p1 = (const GAS f32x4*)((isv1 ? A->in[I_PV] : A->in[I_PU]) + (size_t)(has1 ? row1 : row0) * D + 16 * lane);
#pragma unroll
        for (int j = 0; j < 4; ++j) { va[j] = p0[j]; vb[j] = p1[j]; }
        if (!isv0) {
#pragma unroll
            for (int j = 0; j < 4; ++j) va[j] = va[j] * wfv[j]; }
        if (!isv1) {
#pragma unroll
            for (int j = 0; j < 4; ++j) vb[j] = vb[j] * wfv[j]; }
        const size_t sl0 = ((size_t)layer * 8 * NEXP + (row0 & (NEXP - 1))) * 128, sl1 = ((size_t)layer * 8 * NEXP + (row1 & (NEXP - 1))) * 128;
        quant_row_regs(lane, va, ws + (isv0 ? WS_TV : WS_TU) + sl0, (float*)(ws + (isv0 ? WS_VSC : WS_USC)) + row0);
        if (has1) quant_row_regs(lane, vb, ws + (isv1 ? WS_TV : WS_TU) + sl1, (float*)(ws + (isv1 ? WS_VSC : WS_USC)) + row1);
    }
}
__device__ __forceinline__ void row_to_i8(int lane, const f32x4 (&v)[4], const float* w, unsigned char* dst, float* fac, float* rs_out = nullptr) {
    float x[16]; float s = 0.f;
#pragma unroll
    for (int j = 0; j < 4; ++j) { x[4 * j] = v[j].x; x[4 * j + 1] = v[j].y; x[4 * j + 2] = v[j].z; x[4 * j + 3] = v[j].w; }
#pragma unroll
    for (int i = 0; i < 16; ++i) s += x[i] * x[i];
    const float rs = __builtin_amdgcn_rsqf(wave_sum(s) * (1.f / 1024.f) + RMS_EPS);
    float am = 0.f;
#pragma unroll
    for (int i = 0; i < 16; ++i) { if (w) x[i] = x[i] * rs * w[16 * lane + i]; am = fmaxf(am, fabsf(x[i])); }
    am = wave_max_nn(am);
    const float inv = am > 0.f ? 127.f / am : 0.f;
    unsigned q[4];
#pragma unroll
    for (int j = 0; j < 4; ++j) { const int b0 = (int)rintf(x[4 * j] * inv), b1 = (int)rintf(x[4 * j + 1] * inv), b2 = (int)rintf(x[4 * j + 2] * inv), b3 = (int)rintf(x[4 * j + 3] * inv);
        q[j] = (unsigned)(b0 & 0xff) | ((unsigned)(b1 & 0xff) << 8) | ((unsigned)(b2 & 0xff) << 16) | ((unsigned)(b3 & 0xff) << 24); }
    *(GAS v4u*)(dst + 16 * lane) = (v4u){q[0], q[1], q[2], q[3]};
    if (lane == 0) { *fac = am * (1.f / 127.f) * (w ? 1.f : rs); if (rs_out) *rs_out = rs; }
}
constexpr int P0_WBLOCKS = DEPTH * (104 + 32 + 64);
__device__ __forceinline__ void p0_wblock(KArgs A, Frame& F, int item) {
    const int lane = F.lane, w = F.wave, kh = lane >> 5, c = lane & 31;
    const bool isin = item < DEPTH * 104, isq = item >= DEPTH * (104 + 32); const int r = isin ? item : isq ? item - DEPTH * (104 + 32) : item - DEPTH * 104, l = isin ? r / 104 : isq ? r / 64 : r / 32, nb = isin ? r % 104 : isq ? r % 64 : r % 32, n = 32 * nb + c;
    LAS float* scr = (LAS float*)(F.lds + RING_OFF + w * 16384); LAS float* XCH = (LAS float*)(F.lds + RING_OFF + 7 * 16384 + 12288);
    float v[2][32];
    if (isin && nb >= 96) {
        const float* wbase = A->in[I_WIN] + (size_t)l * D * IN_COLS + 3072; const int j = n - 3072; float g2[16];
#pragma unroll
        for (int q = 0; q < 16; ++q) g2[q] = A->in[I_GW2][(size_t)l * 16 * 256 + q * 256 + j];
        { f32x4 t[8];
#pragma unroll
          for (int q = 0; q < 8; ++q) { const int e = q * 64 + lane; t[q] = *(const GAS f32x4*)(wbase + (size_t)(128 * w + (e >> 2)) * IN_COLS + 4 * (e & 3)); }
#pragma unroll
          for (int q = 0; q < 8; ++q) ((LAS f32x4*)scr)[q * 64 + lane] = t[q]; }
        LDS_WAIT(); asm volatile("" ::: "memory");
#pragma unroll
        for (int sb = 0; sb < 2; ++sb)
#pragma unroll
            for (int i = 0; i < 32; ++i) { const LAS f32x4* wr = (const LAS f32x4*)scr + (64 * sb + 2 * i + kh) * 4; float s = 0.f;
#pragma unroll
                for (int q = 0; q < 4; ++q) { const f32x4 w4 = wr[q]; s += w4.x * g2[4 * q] + w4.y * g2[4 * q + 1] + w4.z * g2[4 * q + 2] + w4.w * g2[4 * q + 3]; }
                v[sb][i] = s; if ((i & 3) == 3) __builtin_amdgcn_sched_barrier(0); }
        LDS_WAIT(); asm volatile("" ::: "memory");
    } else {
        const float* src = isin ? A->in[I_WIN] + (size_t)l * D * IN_COLS + n : isq ? A->in[I_PWQ] + (size_t)l * D * 2048 + n : A->in[I_WOUT] + (size_t)l * D * D + n; const size_t ld = isin ? IN_COLS : isq ? 2048 : D;
#pragma unroll
        for (int sb = 0; sb < 2; ++sb)
#pragma unroll
            for (int i = 0; i < 32; ++i) v[sb][i] = src[(size_t)(128 * w + 64 * sb + 2 * i + kh) * ld];
    }
    if ((isin && l > 0) || isq) { const float* an = (isq ? A->in[I_FNW] : A->in[I_ANW]) + l * D + 128 * w + kh;
#pragma unroll
        for (int sb = 0; sb < 2; ++sb)
#pragma unroll
            for (int i = 0; i < 32; ++i) v[sb][i] *= an[64 * sb + 2 * i];
    }
    float am = 0.f;
#pragma unroll
    for (int sb = 0; sb < 2; ++sb)
#pragma unroll
        for (int i = 0; i < 32; ++i) am = fmaxf(am, fabsf(v[sb][i]));
    { auto rr = __builtin_amdgcn_permlane32_swap(__float_as_uint(am), __float_as_uint(am), false, false); am = fmaxf(__uint_as_float(rr[0]), __uint_as_float(rr[1])); }
    if (kh == 0) XCH[w * 32 + c] = am;
    __syncthreads();
    float cm = 0.f;
#pragma unroll
    for (int q = 0; q < 8; ++q) cm = fmaxf(cm, XCH[q * 32 + c]);
    __syncthreads();
    const float inv = cm > 0.f ? 127.f / cm : 0.f;
    if (w == 0 && kh == 0) (isin ? (float*)(A->ws + WS_WCS) + l * NIN : isq ? (float*)(A->ws + WS_WQCS) + l * 2048 : (float*)(A->ws + WS_WOCS) + l * D)[n] = cm * (1.f / 127.f);
    unsigned char* WT = isin ? A->ws + WS_WIN + ((size_t)l * NIN + pg8::inproj_phys_row(32 * nb)) * D : isq ? A->ws + WS_WQ + ((size_t)l * 2048 + 32 * nb) * D : A->ws + WS_WOUT + ((size_t)l * D + 32 * nb) * D;
    LAS int* sq = (LAS int*)scr;
#pragma unroll
    for (int sb = 0; sb < 2; ++sb) {
#pragma unroll
        for (int i = 0; i < 32; ++i) sq[(2 * i + kh) * 33 + c] = (int)rintf(v[sb][i] * inv);
        LDS_WAIT(); asm volatile("" ::: "memory");
        { const int nn = lane >> 1, hf = lane & 1; unsigned q[8];
#pragma unroll
          for (int j = 0; j < 8; ++j) { const LAS int* s = sq + (32 * hf + 4 * j) * 33 + nn; q[j] = (unsigned)(s[0] & 0xff) | ((unsigned)(s[33] & 0xff) << 8) | ((unsigned)(s[66] & 0xff) << 16) | ((unsigned)(s[99] & 0xff) << 24); }
          unsigned char* dst = WT + (size_t)nn * D + 128 * w + 64 * sb + 32 * hf;
          ((GAS v4u*)dst)[0] = (v4u){q[0], q[1], q[2], q[3]}; ((GAS v4u*)dst)[1] = (v4u){q[4], q[5], q[6], q[7]}; }
        LDS_WAIT(); asm volatile("" ::: "memory");
    }
}
__device__ __forceinline__ void p0_prologue(Frame& F) {
    KArgs A = kargs(); unsigned char* const ws = A->ws;
    LAS float* scr = (LAS float*)(F.lds + RING_OFF + F.wave * 16384);
    for (int item = F.bx; item < P0_WBLOCKS; item += F.G) p0_wblock(A, F, item);
    const size_t gtid = (size_t)F.gw * 64 + F.lane, nthr = (size_t)F.NGW * 64;
    conv_bf16(A->in[I_PSK], (bf16*)(ws + WS_SK), (size_t)DEPTH * 8 * 2 * 128 * 128 / 8, gtid, nthr);
    const int NX = (F.G & 7) == 0 ? 8 : 1, XI = F.bx % NX, RX = M / NX, xw = (F.bx / NX) * NWAVES + F.wave, WX = (F.G / NX) * NWAVES;
    for (int m = RX * XI + xw; m < RX * (XI + 1); m += 2 * WX) {
        const int m1 = m + WX < RX * (XI + 1) ? m + WX : m;
        const GAS f32x4* xa = (const GAS f32x4*)(A->in[I_X] + (size_t)m * D + 16 * F.lane); const GAS f32x4* xb = (const GAS f32x4*)(A->in[I_X] + (size_t)m1 * D + 16 * F.lane);
        f32x4 va[4], vb[4];
#pragma unroll
        for (int j = 0; j < 4; ++j) { va[j] = xa[j]; vb[j] = xb[j]; }
        row_to_i8(F.lane, va, A->in[I_ANW], ws + WS_XN8 + (size_t)m * D, (float*)(ws + WS_AS) + m);
        if (m1 != m) row_to_i8(F.lane, vb, A->in[I_ANW], ws + WS_XN8 + (size_t)m1 * D, (float*)(ws + WS_AS) + m1);
    }
}

__device__ __forceinline__ f32x4 mma16_k64(const LAS bf16* A, int lda, const LAS bf16* B, int ldb, int lane) {
    f32x4 acc = {0.f, 0.f, 0.f, 0.f};
    const LAS bf16* ap = A + (lane & 15) * lda + 8 * (lane >> 4); const LAS bf16* bp = B + (lane & 15) * ldb + 8 * (lane >> 4);
#pragma unroll
    for (int kk = 0; kk < 2; ++kk) { const bf16x8 a = *(const LAS bf16x8*)(ap + kk * 32), b = *(const LAS bf16x8*)(bp + kk * 32); acc = __builtin_amdgcn_mfma_f32_16x16x32_bf16(a, b, acc, 0, 0, 0); }
    return acc;
}
constexpr int LP = 72;
__device__ __forceinline__ void diff_rows(Frame& F, int l) {
    KArgs A = kargs(); unsigned char* const ws = A->ws;
    const int lane = F.lane;
    const float lam_init = 0.8f - 0.6f * expf(-0.3f * (float)l);
    const float s1 = wave_sum(A->in[I_LQ1][l * 64 + lane] * A->in[I_LK1][l * 64 + lane]), s2 = wave_sum(A->in[I_LQ2][l * 64 + lane] * A->in[I_LK2][l * 64 + lane]);
    const float lam = expf(s1) - expf(s2) + lam_init;
    const int hh = lane >> 4, c0 = 8 * (lane & 15);
    float wv[8];
#pragma unroll
    for (int i = 0; i < 8; ++i) wv[i] = A->in[I_DONW][l * 128 + c0 + i] * (1.f - lam_init);
    const bf16* O = (const bf16*)(ws + WS_O); const bf16* MIX = (const bf16*)A->out;
    unsigned char* MIX8 = (unsigned char*)A->out + OUT_MIX8; float* MS = (float*)((unsigned char*)A->out + OUT_MS);
    const int NX = (F.G & 7) == 0 ? 8 : 1, XI = F.bx % NX, RX = M / NX, xw = (F.bx / NX) * NWAVES + F.wave, WX = (F.G / NX) * NWAVES;
    const int tend = RX * (XI + 1), tstep = 4 * WX;
    v4u a[4], b[4], g[4];
#define DR_LOAD(A_, B_, G_, T_) do { _Pragma("unroll") for (int j = 0; j < 4; ++j) { const bf16* orow = O + (size_t)((T_) + j) * 1024 + 256 * hh + c0; \
            A_[j] = *(const GAS v4u*)orow; B_[j] = *(const GAS v4u*)(orow + 128); G_[j] = *(const GAS v4u*)(MIX + (size_t)((T_) + j) * 1024 + 512 + 8 * lane); } } while (0)
    int t0 = RX * XI + 4 * xw;
    if (t0 < tend) DR_LOAD(a, b, g, t0);
    for (; t0 < tend; t0 += tstep) {
        const bool hn = t0 + tstep < tend; v4u an[4], bn[4], gn[4];
        if (hn) DR_LOAD(an, bn, gn, t0 + tstep);
#pragma unroll
        for (int j = 0; j < 4; ++j) {
            const unsigned aw[4] = {a[j].x, a[j].y, a[j].z, a[j].w}, bw[4] = {b[j].x, b[j].y, b[j].z, b[j].w}, gw[4] = {g[j].x, g[j].y, g[j].z, g[j].w};
            float d[8], gv[8]; float ss = 0.f;
#pragma unroll
            for (int i = 0; i < 4; ++i) { d[2 * i] = bflo(aw[i]) - lam * bflo(bw[i]); d[2 * i + 1] = bfhi(aw[i]) - lam * bfhi(bw[i]); ss += d[2 * i] * d[2 * i] + d[2 * i + 1] * d[2 * i + 1]; gv[2 * i] = bflo(gw[i]); gv[2 * i + 1] = bfhi(gw[i]); }
            const float rs = 1.f / sqrtf(row16_sum(ss) * (1.f / 128.f) + RMS_EPS);
            float am = 0.f;
#pragma unroll
            for (int i = 0; i < 8; ++i) { d[i] = bf2f((unsigned short)f2bf(d[i] * rs * wv[i])); am = fmaxf(am, fmaxf(fabsf(d[i]), fabsf(gv[i]))); }
            am = wave_max_nn(am);
            const float inv = am > 0.f ? 127.f / am : 0.f;
            unsigned wd[2], wg[2];
#pragma unroll
            for (int q = 0; q < 2; ++q) {
                const int b0 = (int)rintf(d[4 * q] * inv), b1 = (int)rintf(d[4 * q + 1] * inv), b2 = (int)rintf(d[4 * q + 2] * inv), b3 = (int)rintf(d[4 * q + 3] * inv);
                wd[q] = (unsigned)(b0 & 0xff) | ((unsigned)(b1 & 0xff) << 8) | ((unsigned)(b2 & 0xff) << 16) | ((unsigned)(b3 & 0xff) << 24);
                const int e0 = (int)rintf(gv[4 * q] * inv), e1 = (int)rintf(gv[4 * q + 1] * inv), e2 = (int)rintf(gv[4 * q + 2] * inv), e3 = (int)rintf(gv[4 * q + 3] * inv);
                wg[q] = (unsigned)(e0 & 0xff) | ((unsigned)(e1 & 0xff) << 8) | ((unsigned)(e2 & 0xff) << 16) | ((unsigned)(e3 & 0xff) << 24); }
            unsigned char* mrow = MIX8 + (size_t)(t0 + j) * 1024;
            *(GAS v2u*)(mrow + 128 * hh + c0) = (v2u){wd[0], wd[1]};
            *(GAS v2u*)(mrow + 512 + 8 * lane) = (v2u){wg[0], wg[1]};
            if (lane == 0) MS[t0 + j] = am * (1.f / 127.f);
        }
        if (hn) {
#pragma unroll
            for (int j = 0; j < 4; ++j) { a[j] = an[j]; b[j] = bn[j]; g[j] = gn[j]; } }
    }
#undef DR_LOAD
}
namespace psel {
constexpr int cand_count() { int n = 0; for (int a = 0; a < 16; ++a) for (int b = 0; b < 16; ++b) if ((a + 1) * (b + 1) <= 16) ++n; return n; }
static_assert(cand_count() == 50, "candidate frontier");
constexpr int cand_ab(int idx) { int n = 0; for (int a = 0; a < 16; ++a) for (int b = 0; b < 16; ++b) if ((a + 1) * (b + 1) <= 16) { if (n == idx) return a * 16 + b; ++n; } return 0; }
__device__ __forceinline__ float pmax32(float m) { auto rr = __builtin_amdgcn_permlane32_swap(__float_as_uint(m), __float_as_uint(m), false, false); return fmaxf(__uint_as_float(rr[0]), __uint_as_float(rr[1])); }
__device__ __forceinline__ void ce_desc(float& a, float& b) { const float hi = fmaxf(a, b), lo = fminf(a, b); a = hi; b = lo; }
constexpr unsigned char OE16[63][2] = {{0, 1}, {2, 3}, {0, 2}, {1, 3}, {1, 2}, {4, 5}, {6, 7}, {4, 6}, {5, 7}, {5, 6}, {0, 4}, {2, 6}, {2, 4}, {1, 5}, {3, 7}, {3, 5}, {1, 2}, {3, 4}, {5, 6}, {8, 9}, {10, 11}, {8, 10}, {9, 11}, {9, 10}, {12, 13}, {14, 15}, {12, 14}, {13, 15}, {13, 14}, {8, 12}, {10, 14}, {10, 12}, {9, 13}, {11, 15}, {11, 13}, {9, 10}, {11, 12}, {13, 14}, {0, 8}, {4, 12}, {4, 8}, {2, 10}, {6, 14}, {6, 10}, {2, 4}, {6, 8}, {10, 12}, {1, 9}, {5, 13}, {5, 9}, {3, 11}, {7, 15}, {7, 11}, {3, 5}, {7, 9}, {11, 13}, {1, 2}, {3, 4}, {5, 6}, {7, 8}, {9, 10}, {11, 12}, {13, 14}};
template <int OFF, int NA> __device__ __forceinline__ void sort16_desc(float (&v)[NA]) {
#pragma unroll
    for (int i = 0; i < 63; ++i) ce_desc(v[OFF + OE16[i][0]], v[OFF + OE16[i][1]]);
}
template <int OFF, int NA> __device__ __forceinline__ void merge16_desc(float (&v)[NA]) {
#pragma unroll
    for (int lj = 3; lj >= 0; --lj)
#pragma unroll
        for (int i = 0; i < 16; ++i) { const int l = i ^ (1 << lj); if (l > i) ce_desc(v[OFF + i], v[OFF + l]); }
}
template <int A, int B, int NA> __device__ __forceinline__ void top16_merge(float (&v)[NA]) {
#pragma unroll
    for (int i = 0; i < 16; ++i) v[A + i] = fmaxf(v[A + i], v[B + 15 - i]);
    merge16_desc<A, NA>(v);
}
template <int NA> __device__ __forceinline__ void top16_cross(float (&v)[NA], float (&out)[16]) {
    float lo[16], hi[16];
#pragma unroll
    for (int i = 0; i < 16; ++i) { auto rr = __builtin_amdgcn_permlane32_swap(__float_as_uint(v[i]), __float_as_uint(v[i]), false, false); lo[i] = __uint_as_float(rr[0]); hi[i] = __uint_as_float(rr[1]); }
#pragma unroll
    for (int i = 0; i < 16; ++i) out[i] = fmaxf(lo[i], hi[15 - i]);
    merge16_desc<0, 16>(out);
}
__device__ __forceinline__ void top16_of_128(float (&sc)[64], float (&out)[16]) {
    sort16_desc<0, 64>(sc); sort16_desc<16, 64>(sc); sort16_desc<32, 64>(sc); sort16_desc<48, 64>(sc);
    top16_merge<0, 16, 64>(sc); top16_merge<32, 48, 64>(sc); top16_merge<0, 32, 64>(sc);
    top16_cross<64>(sc, out);
}
template <int S> __device__ __forceinline__ void cand_one(float (&cand)[25], const float (&v0)[16], const float (&v1)[16], bool hi) {
    constexpr int ab0 = cand_ab(2 * S), ab1 = cand_ab(2 * S + 1);
    const float s0 = v0[ab0 >> 4] + v1[ab0 & 15], s1 = v0[ab1 >> 4] + v1[ab1 & 15];
    const float s = hi ? s1 : s0; const unsigned id = hi ? (unsigned)ab1 : (unsigned)ab0;
    cand[S] = __uint_as_float((__float_as_uint(s) & ~0xFFu) | id);
}
template <int... S> __device__ __forceinline__ void cand_all(float (&cand)[25], const float (&v0)[16], const float (&v1)[16], bool hi, std::integer_sequence<int, S...>) { (cand_one<S>(cand, v0, v1, hi), ...); }
__device__ __forceinline__ unsigned lookup7(const unsigned (&tab)[4], unsigned a) {
    const unsigned sel = 0x0c0c0c00u | (a & 7u); const unsigned lo = __builtin_amdgcn_perm(tab[1], tab[0], sel), hi = __builtin_amdgcn_perm(tab[3], tab[2], sel); return (a & 8u) ? hi : lo; }
}
__device__ __forceinline__ void peer_select(Frame& F, int l) {
    KArgs A = kargs(); unsigned char* const ws = A->ws;
    const int lane = F.lane, r32 = lane & 31, hi = lane >> 5;
    const bf16* Q2 = (const bf16*)(ws + WS_Q2); const bf16* SK = (const bf16*)(ws + WS_SK) + (size_t)l * 8 * 2 * 128 * 128;
    unsigned short* IDX = (unsigned short*)(ws + WS_IDX); float* GATE = (float*)(ws + WS_GATE);
    const bool aff = F.G == 256; const int h = aff ? (F.bx >> 3) & 7 : F.bx & 7, jb = F.bx >> 3; constexpr int KP = 136;
    LAS bf16* KL = (LAS bf16*)F.lds;
#pragma unroll
    for (int i = 0; i < 8; ++i) { const int p = F.tid + 512 * i, row = p >> 4, j = p & 15; *(LAS v4u*)(KL + row * KP + 8 * j) = *(const GAS v4u*)(SK + ((size_t)h * 256 + row) * 128 + 8 * j); }
    __syncthreads();
    const int tg0 = aff ? 128 * (F.bx & 7) + 32 * (F.bx >> 6) + F.wave : jb * 8 + F.wave, tg1 = aff ? 128 * (F.bx & 7) + 32 * (F.bx >> 6) + 32 : M / 32, tgs = aff ? 8 : (F.G >> 3) * 8;
    for (int tg = tg0; tg < tg1; tg += tgs) {
        const size_t tok = (size_t)tg * 32 + r32;
        bf16x8 bq[2][8];
#pragma unroll
        for (int c = 0; c < 2; ++c)
#pragma unroll
            for (int ks = 0; ks < 8; ++ks) bq[c][ks] = *(const GAS bf16x8*)(Q2 + tok * 2048 + (h * 2 + c) * 128 + ks * 16 + 8 * hi);
        float ts[2][16];
#pragma unroll
        for (int c = 0; c < 2; ++c) {
            f32x16 acc[4];
#pragma unroll
            for (int mt = 0; mt < 4; ++mt) acc[mt] = f32x16{};
            const LAS bf16* kp = KL + (c * 128 + r32) * KP + 8 * hi;
#pragma unroll
            for (int ks = 0; ks < 8; ++ks)
#pragma unroll
                for (int mt = 0; mt < 4; ++mt) { const bf16x8 ak = *(const LAS bf16x8*)(kp + mt * 32 * KP + ks * 16); acc[mt] = __builtin_amdgcn_mfma_f32_32x32x16_bf16(ak, bq[c][ks], acc[mt], 0, 0, 0); }
            float sc[64];
#pragma unroll
            for (int mt = 0; mt < 4; ++mt)
#pragma unroll
                for (int r = 0; r < 16; ++r) { const unsigned key = (unsigned)(32 * mt + (r & 3) + 8 * (r >> 2) + 4 * hi); sc[mt * 16 + r] = __uint_as_float((__float_as_uint(acc[mt][r]) & ~0x7Fu) | key); }
            __builtin_amdgcn_sched_barrier(0);
            psel::top16_of_128(sc, ts[c]);
            __builtin_amdgcn_sched_barrier(0);
        }
        unsigned kt0[4], kt1[4]; float v0[16], v1[16];
#pragma unroll
        for (int q = 0; q < 4; ++q) { kt0[q] = 0u; kt1[q] = 0u;
#pragma unroll
            for (int j = 0; j < 4; ++j) { kt0[q] |= (__float_as_uint(ts[0][4 * q + j]) & 0x7Fu) << (8 * j); kt1[q] |= (__float_as_uint(ts[1][4 * q + j]) & 0x7Fu) << (8 * j); } }
#pragma unroll
        for (int i = 0; i < 16; ++i) { v0[i] = __uint_as_float(__float_as_uint(ts[0][i]) & ~0x7Fu); v1[i] = __uint_as_float(__float_as_uint(ts[1][i]) & ~0x7Fu); }
        float cand[25];
        psel::cand_all(cand, v0, v1, hi != 0, std::make_integer_sequence<int, 25>{});
        float c32[32];
#pragma unroll
        for (int i = 0; i < 25; ++i) c32[i] = cand[i];
#pragma unroll
        for (int i = 25; i < 32; ++i) c32[i] = -INFINITY;
        psel::sort16_desc<0, 32>(c32); psel::sort16_desc<16, 32>(c32); psel::top16_merge<0, 16, 32>(c32);
        float best[16];
        psel::top16_cross<32>(c32, best);
        int ex[16];
#pragma unroll
        for (int k = 0; k < 16; ++k) { const unsigned bb = __float_as_uint(best[k]); ex[k] = (int)(psel::lookup7(kt0, (bb >> 4) & 15u) * 128u + psel::lookup7(kt1, bb & 15u)); }
        if (hi == 0) { GAS v4u* o = (GAS v4u*)(IDX + tok * 128 + h * 16);
#pragma unroll
            for (int q = 0; q < 2; ++q) o[q] = (v4u){(unsigned)ex[8 * q] | ((unsigned)ex[8 * q + 1] << 16), (unsigned)ex[8 * q + 2] | ((unsigned)ex[8 * q + 3] << 16), (unsigned)ex[8 * q + 4] | ((unsigned)ex[8 * q + 5] << 16), (unsigned)ex[8 * q + 6] | ((unsigned)ex[8 * q + 7] << 16)}; }
        else {
            float mx = __uint_as_float(__float_as_uint(best[0]) & ~0xFFu); float g[16]; float sum = 0.f;
#pragma unroll
            for (int k = 0; k < 16; ++k) { g[k] = __expf(__uint_as_float(__float_as_uint(best[k]) & ~0xFFu) - mx); sum += g[k]; }
            const float inv = 1.f / sum; GAS f32x4* o = (GAS f32x4*)(GATE + tok * 128 + h * 16);
#pragma unroll
            for (int q = 0; q < 4; ++q) o[q] = (f32x4){g[4 * q] * inv, g[4 * q + 1] * inv, g[4 * q + 2] * inv, g[4 * q + 3] * inv}; }
    }
}
__device__ __forceinline__ float gelu_erf(float x) { return 0.5f * x * (1.f + erff(x * 0.70710678118654752f)); }
__device__ __forceinline__ float dppf(float v, const int ctrl_sel) {
    const int x = __builtin_bit_cast(int, v);
    int r;
    if (ctrl_sel == 0) r = __builtin_amdgcn_update_dpp(0, x, 0xB1, 0xf, 0xf, true);
    else if (ctrl_sel == 1) r = __builtin_amdgcn_update_dpp(0, x, 0x4E, 0xf, 0xf, true);
    else if (ctrl_sel == 2) r = __builtin_amdgcn_update_dpp(0, x, 0x141, 0xf, 0xf, true);
    else r = __builtin_amdgcn_update_dpp(0, x, 0x128, 0xf, 0xf, true);
    return __builtin_bit_cast(float, r);
}
__device__ __forceinline__ float swap_add32(float a, float b) { auto rr = __builtin_amdgcn_permlane32_swap(__float_as_uint(a), __float_as_uint(b), false, false); return __uint_as_float(rr[0]) + __uint_as_float(rr[1]); }
__device__ __forceinline__ float swap_add16(float a, float b) { auto rr = __builtin_amdgcn_permlane16_swap(__float_as_uint(a), __float_as_uint(b), false, false); return __uint_as_float(rr[0]) + __uint_as_float(rr[1]); }
__device__ __forceinline__ float reduce8(const float (&p)[8], int lane) {
    const float r0 = swap_add32(p[0], p[4]), r1 = swap_add32(p[1], p[5]), r2 = swap_add32(p[2], p[6]), r3 = swap_add32(p[3], p[7]);
    const float s0 = swap_add16(r0, r2), s1 = swap_add16(r1, r3);
    const bool b3 = (lane & 8) != 0;
    const float keep = b3 ? s1 : s0, send = b3 ? s0 : s1;
    float z = keep + dppf(send, 3);
    z += dppf(z, 0); z += dppf(z, 1); z += dppf(z, 2);
    return z;
}
__device__ __forceinline__ float ub(unsigned w, int k) { return (float)((w >> (8 * k)) & 0xffu); }
constexpr int PEER_TG = 4, PEER_NGRP = M / PEER_TG;
constexpr int CW_PEER = 8192;
__device__ __forceinline__ int peer_dequeue(gu32* ctr, int lane) {
    unsigned v = 0u; if (lane == 0) v = __hip_atomic_fetch_add(ctr, 1u, __ATOMIC_RELAXED, __HIP_MEMORY_SCOPE_AGENT);
    return __builtin_amdgcn_readfirstlane((int)v);
}
__device__ __forceinline__ unsigned peer_dequeue_issue(gu32* ctr, int lane) { unsigned v = 0u, off = 0u; asm volatile("" : "+v"(off));
    if (lane == 0) v = __hip_atomic_fetch_add(ctr + off, 1u, __ATOMIC_RELAXED, __HIP_MEMORY_SCOPE_AGENT); return v; }
__device__ __forceinline__ int peer_dequeue_get(unsigned v) { asm volatile("" : "+v"(v) :: "memory"); return __builtin_amdgcn_readfirstlane((int)v); }
struct HalfBuf { v4u p[8]; };
struct IdSet { v4u id[2]; };
struct TokAux { v4u a[2]; };
__device__ __forceinline__ void ps_ids(IdSet& I, const unsigned short* idrow) {
#pragma unroll
    for (int q = 0; q < 2; ++q) I.id[q] = ((const GAS v4u*)idrow)[q];
}
template <int HALF_> __device__ __forceinline__ void ps_gather(HalfBuf& B, const unsigned char* tab_slice, const IdSet& I, int c) {
    const unsigned c16 = 16u * (unsigned)c;
#pragma unroll
    for (int i = 0; i < 8; ++i) { const unsigned w = I.id[HALF_][i >> 1]; const unsigned e = (i & 1) ? w >> 16 : w & 0xffffu; B.p[i] = *(const GAS v4u*)(tab_slice + (e * 128u + c16)); }
}
__device__ __forceinline__ int dppi(int x, const int sel) {
    if (sel == 0) return __builtin_amdgcn_update_dpp(0, x, 0xB1, 0xf, 0xf, true);
    if (sel == 1) return __builtin_amdgcn_update_dpp(0, x, 0x4E, 0xf, 0xf, true);
    return __builtin_amdgcn_update_dpp(0, x, 0x141, 0xf, 0xf, true);
}
struct UState { int hq[4]; float sc; };
template <int HALF_> __device__ __forceinline__ void ps_compute_u(const HalfBuf& B, const TokAux& X, UState& U, bf16* part_row, int g, int c) {
    if (HALF_ == 0) { U.hq[0] = (int)X.a[0].x; U.hq[1] = (int)X.a[0].y; U.hq[2] = (int)X.a[0].z; U.hq[3] = (int)X.a[0].w; U.sc = __uint_as_float(X.a[1].x); }
    int d[8];
#pragma unroll
    for (int i = 0; i < 8; ++i) { int x = __builtin_amdgcn_sdot4((int)B.p[i].x, U.hq[0], 0, false); x = __builtin_amdgcn_sdot4((int)B.p[i].y, U.hq[1], x, false);
        x = __builtin_amdgcn_sdot4((int)B.p[i].z, U.hq[2], x, false); x = __builtin_amdgcn_sdot4((int)B.p[i].w, U.hq[3], x, false);
        x += dppi(x, 0); x += dppi(x, 1); x += dppi(x, 2); d[i] = x; }
    const float sc = U.sc;
    if (c == 0) *(GAS v4u*)(part_row + 16 * g + 8 * HALF_) = (v4u){pk2((float)d[0] * sc, (float)d[1] * sc), pk2((float)d[2] * sc, (float)d[3] * sc), pk2((float)d[4] * sc, (float)d[5] * sc), pk2((float)d[6] * sc, (float)d[7] * sc)};
}
struct VState { int acc[16]; };
template <int HALF_, bool LAST> __device__ __forceinline__ void ps_compute_v(const HalfBuf& B, const TokAux& X, VState& S, const bf16* res_cols, bf16* res_w, float* out_cols  , int lane) {
    if (HALF_ == 0) {
#pragma unroll
        for (int j = 0; j < 16; ++j) S.acc[j] = 0; }
    const unsigned wq[4] = {X.a[0].x, X.a[0].y, X.a[0].z, X.a[0].w};
#pragma unroll
    for (int q = 0; q < 2; ++q) {
        const unsigned pa[4] = {B.p[4 * q].x, B.p[4 * q].y, B.p[4 * q].z, B.p[4 * q].w}, pb[4] = {B.p[4 * q + 1].x, B.p[4 * q + 1].y, B.p[4 * q + 1].z, B.p[4 * q + 1].w};
        const unsigned pc[4] = {B.p[4 * q + 2].x, B.p[4 * q + 2].y, B.p[4 * q + 2].z, B.p[4 * q + 2].w}, pd[4] = {B.p[4 * q + 3].x, B.p[4 * q + 3].y, B.p[4 * q + 3].z, B.p[4 * q + 3].w};
        const int wv = (int)wq[2 * HALF_ + q];
#pragma unroll
        for (int p = 0; p < 4; ++p) {
            const unsigned ab_lo = __builtin_amdgcn_perm(pb[p], pa[p], 0x05010400u), ab_hi = __builtin_amdgcn_perm(pb[p], pa[p], 0x07030602u);
            const unsigned cd_lo = __builtin_amdgcn_perm(pd[p], pc[p], 0x05010400u), cd_hi = __builtin_amdgcn_perm(pd[p], pc[p], 0x07030602u);
            const unsigned t0 = __builtin_amdgcn_perm(cd_lo, ab_lo, 0x05040100u), t1 = __builtin_amdgcn_perm(cd_lo, ab_lo, 0x07060302u);
            const unsigned t2 = __builtin_amdgcn_perm(cd_hi, ab_hi, 0x05040100u), t3 = __builtin_amdgcn_perm(cd_hi, ab_hi, 0x07060302u);
            S.acc[4 * p] = __builtin_amdgcn_sdot4((int)t0, wv, S.acc[4 * p], false); S.acc[4 * p + 1] = __builtin_amdgcn_sdot4((int)t1, wv, S.acc[4 * p + 1], false);
            S.acc[4 * p + 2] = __builtin_amdgcn_sdot4((int)t2, wv, S.acc[4 * p + 2], false); S.acc[4 * p + 3] = __builtin_amdgcn_sdot4((int)t3, wv, S.acc[4 * p + 3], false);
        }
    }
    if (HALF_ == 1) {
        const float sc = __uint_as_float(X.a[1].x);
        float fa[16];
#pragma unroll
        for (int j = 0; j < 16; ++j) fa[j] = (float)S.acc[j] * sc;
        float r[8];
#pragma unroll
        for (int j = 0; j < 8; ++j) r[j] = swap_add32(fa[j], fa[j + 8]);
        float s4[4];
#pragma unroll
        for (int j = 0; j < 4; ++j) s4[j] = swap_add16(r[j], r[j + 4]);
        const bool b3 = (lane & 8) != 0;
        float z[2];
#pragma unroll
        for (int j = 0; j < 2; ++j) { const float keep = b3 ? s4[j + 2] : s4[j], send = b3 ? s4[j] : s4[j + 2]; z[j] = keep + dppf(send, 3); }
        const int col = 16 * (lane & 7) + 2 * (lane >> 3);
        const unsigned rw = *(const GAS unsigned*)(res_cols + col);
        const float y0 = bflo(rw) + z[0], y1 = bfhi(rw) + z[1];
        if (LAST) { typedef float f32x2v __attribute__((ext_vector_type(2))); *(GAS f32x2v*)(out_cols + col) = (f32x2v){y0, y1}; }
        else *(GAS unsigned*)(res_w + col) = pk2(y0, y1);
    }
}
template <bool IS_V, bool DRY = false, bool LAST = false> __device__ __forceinline__ void peer_sliced(Frame& F, int l) {
    KArgs A = kargs(); unsigned char* const ws = A->ws;
    const int lane = F.lane, g = lane >> 3, c = lane & 7;
    const int xcc = (int)(xb_xcc_id() & 7u);
    gu32* ctr0 = (gu32*)(ws + WS_CTL) + CW_PEER + 64 * ((l * 4 + (IS_V ? 1 : 0) + (DRY ? 2 : 0)) * 8);
    const unsigned short* IDX = (const unsigned short*)(ws + WS_IDX);
    for (int s = 0; s < 8; ++s) {
        const int k = (xcc + s) & 7; gu32* ctr = ctr0 + 64 * k;
        const unsigned char* tab = ws + (IS_V ? WS_TV : WS_TU) + ((size_t)(l * 8 + k) * NEXP) * 128;
        int cur = peer_dequeue(ctr, lane);
        if (cur < PEER_NGRP) {
            size_t t0 = (size_t)cur * PEER_TG;
            HalfBuf H0, H1, H2, H3; IdSet I0, I1; TokAux X0, X1, X2, X3; UState US; VState VS;
#define PS_IDS(IS, t) ps_ids(IS, IDX + (t) * 128 + 16 * g)
#define PS_AUX(XS, t) do { if (IS_V) { XS.a[0] = *(const GAS v4u*)(ws + WS_EW8 + (t) * 128 + 16 * g); XS.a[1].x = __float_as_uint(((const float*)(ws + WS_EWSC))[(t) * 8 + g]); } \
                           else { XS.a[0] = *(const GAS v4u*)((const unsigned char*)A->out + OUT_MIX8 + (t) * D + 128 * k + 16 * c); XS.a[1].x = __float_as_uint(((const float*)((const unsigned char*)A->out + OUT_MS))[t]); } } while (0)
#define PS_G(HB, IS, hf) ps_gather<hf>(HB, tab, IS, c)
#define PS_C(HB, XS, t, hf) do { if (IS_V) ps_compute_v<hf, LAST>(HB, XS, VS, (const bf16*)(ws + WS_RES) + (t) * D + 128 * k, (bf16*)(ws + (DRY ? WS_Q2 : WS_RES)) + (t) * D + 128 * k, (DRY ? (float*)(ws + WS_Q2) : A->out) + (t) * D + 128 * k, lane); \
                                 else ps_compute_u<hf>(HB, XS, US, (bf16*)(ws + WS_PART) + ((size_t)k * M + (t)) * 128, g, c); } while (0)
            PS_IDS(I0, t0); PS_IDS(I1, t0 + 1); PS_AUX(X0, t0); PS_G(H0, I0, 0); PS_G(H1, I0, 1); PS_AUX(X1, t0 + 1); PS_G(H2, I1, 0);
            for (;;) {
                const unsigned nxt_v = peer_dequeue_issue(ctr, lane);
                PS_IDS(I0, t0 + 2);                    PS_G(H3, I1, 1); PS_C(H0, X0, t0, 0);
                PS_AUX(X2, t0 + 2);                    PS_G(H0, I0, 0); PS_C(H1, X0, t0, 1);
                PS_IDS(I1, t0 + 3);                    PS_G(H1, I0, 1); PS_C(H2, X1, t0 + 1, 0);
                PS_AUX(X3, t0 + 3);                    PS_G(H2, I1, 0); PS_C(H3, X1, t0 + 1, 1);
                const int nxt = peer_dequeue_get(nxt_v);
                const bool more = nxt < PEER_NGRP; const size_t t1 = (size_t)nxt * PEER_TG;
                if (more) PS_IDS(I0, t1);              PS_G(H3, I1, 1); PS_C(H0, X2, t0 + 2, 0);
                if (more) { PS_AUX(X0, t1);            PS_G(H0, I0, 0); } PS_C(H1, X2, t0 + 2, 1);
                if (more) { PS_IDS(I1, t1 + 1);        PS_G(H1, I0, 1); } PS_C(H2, X3, t0 + 3, 0);
                if (more) { PS_AUX(X1, t1 + 1);        PS_G(H2, I1, 0); } PS_C(H3, X3, t0 + 3, 1);
                if (!more) break;
                t0 = t1;
            }
#undef PS_IDS
#undef PS_AUX
#undef PS_G
#undef PS_C
        }
    }
}
__device__ __forceinline__ void peer_w(Frame& F, int l) {
    KArgs A = kargs(); unsigned char* const ws = A->ws;
    const unsigned short* IDX = (const unsigned short*)(ws + WS_IDX); const float* GATE = (const float*)(ws + WS_GATE); const bf16* PART = (const bf16*)(ws + WS_PART);
    const float* USC = (const float*)(ws + WS_USC) + l * NEXP; const float* VSC = (const float*)(ws + WS_VSC) + l * NEXP; const float* HS = (const float*)(ws + WS_RS);
    signed char* WQ = (signed char*)(ws + WS_EW8); float* WSC = (float*)(ws + WS_EWSC);
    LAS float* UL = (LAS float*)F.lds; LAS float* VL = UL + NEXP;
    for (int i = F.tid; i < NEXP / 4; i += NWAVES * 64) { ((LAS f32x4*)UL)[i] = ((const GAS f32x4*)USC)[i]; ((LAS f32x4*)VL)[i] = ((const GAS f32x4*)VSC)[i]; }
    __syncthreads();
    const size_t nthr = (size_t)F.NGW * 64;
    const size_t iend = (size_t)M * 128, istep = 4 * nthr; size_t i0 = (size_t)F.gw * 64 + F.lane;
    unsigned pr[4][8]; int e[4]; float gt[4], hs[4];
#define W_LOAD(PR_, E_, GT_, HS_, I_) do { _Pragma("unroll") for (int j = 0; j < 4; ++j) { const size_t i = (I_) + j * nthr; \
            _Pragma("unroll") for (int k = 0; k < 8; ++k) PR_[j][k] = PART[(size_t)k * M * 128 + i]; \
            E_[j] = IDX[i]; GT_[j] = GATE[i]; HS_[j] = HS[i >> 7]; } } while (0)
    if (i0 < iend) W_LOAD(pr, e, gt, hs, i0);
    for (; i0 < iend; i0 += istep) {
        const bool hn = i0 + istep < iend; unsigned prn[4][8]; int en[4]; float gtn[4], hsn[4];
        if (hn) W_LOAD(prn, en, gtn, hsn, i0 + istep);
#pragma unroll
        for (int j = 0; j < 4; ++j) { const size_t i = i0 + j * nthr; float p = 0.f;
#pragma unroll
            for (int k = 0; k < 8; ++k) p += bf2f((unsigned short)pr[j][k]);
            const float dot = p * UL[e[j]];
            const float w = gt[j] * gelu_erf(dot) * VL[e[j]];
            float m = fabsf(w);
            m = fmaxf(m, dppf(m, 0)); m = fmaxf(m, dppf(m, 1)); m = fmaxf(m, dppf(m, 2));
            m = fmaxf(m, __builtin_bit_cast(float, __builtin_amdgcn_update_dpp(0, __builtin_bit_cast(int, m), 0x140, 0xf, 0xf, true)));
            const float inv = m > 0.f ? 127.f / m : 0.f;
            WQ[i] = (signed char)(int)rintf(w * inv);
            if ((F.lane & 15) == 0) WSC[i >> 4] = m * (1.f / 127.f); }
        if (hn) {
#pragma unroll
            for (int j = 0; j < 4; ++j) { e[j] = en[j]; gt[j] = gtn[j]; hs[j] = hsn[j];
#pragma unroll
                for (int k = 0; k < 8; ++k) pr[j][k] = prn[j][k]; } }
    }
#undef W_LOAD
}

#define GBAR() asm volatile("s_waitcnt lgkmcnt(0)\n\ts_barrier" ::: "memory")
namespace glas {
constexpr int LPQ = 72, LPG = 136, GP = 65;
constexpr int O_GF = 0, O_TT = 64 * GP * 4, O_BL = O_TT + 2048, O_KR = O_BL + 256, O_KRT = O_KR + 9216, O_QR = O_KRT + 9216, O_QD = O_QR  , O_KI = O_KR  , O_KDT = O_QR + 9216, O_VT = O_KDT + 9216,
              O_AM = O_VT + 18432, O_GO = O_AM + 9216, O_OST = O_GO + 64 * LPG * 2, O_DEC = O_OST + 64 * LPG * 2, O_SS = O_DEC + 256, O_RS = O_SS + 2048  , O_END = O_RS + 2048;
static_assert(O_END <= 131072 && O_TT % 16 == 0 && O_KR % 16 == 0 && O_DEC % 16 == 0 && O_SS % 16 == 0, "gla LDS");
struct Pre { v4u g[2], go[2], q, v[2], k; };
template <int PASS> __device__ __forceinline__ void prefetch(Pre& P, const unsigned char* ws, size_t t0, int hh, int tid) {
    const float* GLOG = (const float*)(ws + WS_GLOG); const bf16* GQ = (const bf16*)(ws + WS_GQ); const bf16* GK = (const bf16*)(ws + WS_GK); const bf16* GV = (const bf16*)(ws + WS_GV); const bf16* GO = (const bf16*)(ws + WS_GO);
#pragma unroll
    for (int i = 0; i < 2; ++i) { const int p = tid + 512 * i, c = p >> 4, j = p & 15;
        P.g[i] = *(const GAS v4u*)(GLOG + (t0 + c) * 256 + hh * 64 + 4 * j);
        if (PASS == 2) P.go[i] = *(const GAS v4u*)(GO + (t0 + c) * 512 + hh * 128 + 8 * j);
        const int cv = tid & 63, jv = (tid >> 6) + 8 * i;
        P.v[i] = *(const GAS v4u*)(GV + (t0 + cv) * 512 + hh * 128 + 8 * jv); }
    if (PASS == 2) { const int c = tid >> 3, j = tid & 7; P.q = *(const GAS v4u*)(GQ + (t0 + c) * 256 + hh * 64 + 8 * j); }
    { const int c = tid & 63, j = tid >> 6; P.k = *(const GAS v4u*)(GK + (t0 + c) * 256 + hh * 64 + 8 * j); }
}
__device__ __forceinline__ float rowsum16(float v) {
    v += dppf(v, 0); v += dppf(v, 1); v += dppf(v, 2);
    v += __builtin_bit_cast(float, __builtin_amdgcn_update_dpp(0, __builtin_bit_cast(int, v), 0x140, 0xf, 0xf, true));
    return v;
}
}
template <int PASS> __device__ __forceinline__ void gla_run(Frame& F, int l, int run) {
    using namespace glas;
    KArgs A = kargs(); unsigned char* const ws = A->ws;
    const int bh = run >> 4, n0 = (run & 15) * 8, b = bh >> 2, hh = bh & 3, tid = F.tid, lane = F.lane, w = F.wave, q4 = lane >> 4, r16 = lane & 15;
    LAS float* Gf = (LAS float*)(F.lds + O_GF); LAS float* Tt = (LAS float*)(F.lds + O_TT); LAS float* BL = (LAS float*)(F.lds + O_BL);
    LAS bf16* Kr = (LAS bf16*)(F.lds + O_KR); LAS bf16* KrT = (LAS bf16*)(F.lds + O_KRT); LAS bf16* Qr = (LAS bf16*)(F.lds + O_QR); LAS bf16* Qd = (LAS bf16*)(F.lds + O_QD); LAS bf16* Ki = (LAS bf16*)(F.lds + O_KI);
    LAS bf16* KdT = (LAS bf16*)(F.lds + O_KDT); LAS bf16* VT = (LAS bf16*)(F.lds + O_VT); LAS bf16* Am = (LAS bf16*)(F.lds + O_AM); LAS bf16* GOs = (LAS bf16*)(F.lds + O_GO); LAS bf16* Ost = (LAS bf16*)(F.lds + O_OST);
    LAS float* DEC = (LAS float*)(F.lds + O_DEC); LAS float* SS = (LAS float*)(F.lds + O_SS); LAS float* RSL = (LAS float*)(F.lds + O_RS) + 64 * F.wave;
    bf16* MIX = (bf16*)A->out;
    float* USUM = (float*)(ws + WS_USUM); float* PDS = (float*)(ws + WS_PDS);
    const float wg = A->in[I_GONW][l * 128 + 16 * w + r16];
    f32x4 S[4], pd[4];
#pragma unroll
    for (int t = 0; t < 4; ++t) { S[t] = (f32x4){0.f, 0.f, 0.f, 0.f}; pd[t] = (f32x4){1.f, 1.f, 1.f, 1.f}; }
    Pre P; prefetch<PASS>(P, ws, (size_t)b * T + (size_t)n0 * 64, hh, tid);
    if (PASS == 2) {
        int rp = run & ~15;
        for (; rp + 2 <= run; rp += 2) {
            f32x4 us[2][4], ps[2][4];
#pragma unroll
            for (int j = 0; j < 2; ++j)
#pragma unroll
                for (int t = 0; t < 4; ++t) { us[j][t] = *(const GAS f32x4*)(USUM + ((size_t)(rp + j) * 512 + tid) * 16 + 4 * t); ps[j][t] = *(const GAS f32x4*)(PDS + (size_t)(rp + j) * 64 + 16 * t + 4 * q4); }
#pragma unroll
            for (int j = 0; j < 2; ++j)
#pragma unroll
                for (int t = 0; t < 4; ++t) S[t] = S[t] * ps[j][t] + us[j][t];
        }
        for (; rp < run; ++rp) {
#pragma unroll
            for (int t = 0; t < 4; ++t) { const f32x4 us = *(const GAS f32x4*)(USUM + ((size_t)rp * 512 + tid) * 16 + 4 * t), ps = *(const GAS f32x4*)(PDS + (size_t)rp * 64 + 16 * t + 4 * q4); S[t] = S[t] * ps + us; }
        }
    }
    for (int nn = 0; nn <= 8; ++nn) {
        const int n = n0 + nn;
        const size_t t0 = (size_t)b * T + (size_t)n * 64;
        if (nn == 8) {
            if (PASS == 2 && nn > 0) {
#pragma unroll
                for (int i = 0; i < 2; ++i) { const int p = tid + 512 * i, c = p >> 4, j = p & 15;
                    *(GAS v4u*)(MIX + (t0 - 64 + c) * 1024 + 512 + hh * 128 + 8 * j) = *(const LAS v4u*)(Ost + c * LPG + 8 * j); }
            }
            break;
        }
#pragma unroll
        for (int i = 0; i < 2; ++i) { const int p = tid + 512 * i, c = p >> 4, j = p & 15;
            Gf[c * GP + 4 * j] = __uint_as_float(P.g[i].x); Gf[c * GP + 4 * j + 1] = __uint_as_float(P.g[i].y); Gf[c * GP + 4 * j + 2] = __uint_as_float(P.g[i].z); Gf[c * GP + 4 * j + 3] = __uint_as_float(P.g[i].w);
            if (PASS == 2) *(LAS v4u*)(GOs + c * LPG + 8 * j) = P.go[i];
            const int cv = tid & 63, jv = (tid >> 6) + 8 * i; const unsigned vv[4] = {P.v[i].x, P.v[i].y, P.v[i].z, P.v[i].w};
#pragma unroll
            for (int e = 0; e < 4; ++e) { VT[(8 * jv + 2 * e) * LPQ + cv] = (bf16)(vv[e] & 0xffffu); VT[(8 * jv + 2 * e + 1) * LPQ + cv] = (bf16)(vv[e] >> 16); } }
        if (PASS == 2) { const int c = tid >> 3, j = tid & 7; *(LAS v4u*)(Qr + c * LPQ + 8 * j) = P.q; }
        { const int c = tid & 63, j = tid >> 6; *(LAS v4u*)(Kr + c * LPQ + 8 * j) = P.k; const unsigned kk[4] = {P.k.x, P.k.y, P.k.z, P.k.w};
#pragma unroll
          for (int e = 0; e < 4; ++e) { KrT[(8 * j + 2 * e) * LPQ + c] = (bf16)(kk[e] & 0xffffu); KrT[(8 * j + 2 * e + 1) * LPQ + c] = (bf16)(kk[e] >> 16); } }
        if (PASS == 2 && nn > 0) {
#pragma unroll
            for (int i = 0; i < 2; ++i) { const int p = tid + 512 * i, c = p >> 4, j = p & 15;
                *(GAS v4u*)(MIX + (t0 - 64 + c) * 1024 + 512 + hh * 128 + 8 * j) = *(const LAS v4u*)(Ost + c * LPG + 8 * j); }
        }
        if (nn + 1 < 8) prefetch<PASS>(P, ws, t0 + 64, hh, tid);
        GBAR();
        { const int d = tid & 63, seg = tid >> 6; float bv[8]; float run = 0.f;
#pragma unroll
          for (int i = 0; i < 8; ++i) { run += Gf[(8 * seg + i) * GP + d]; bv[i] = run; }
          Tt[seg * 64 + d] = run;
          GBAR();
          float off = 0.f, bl = 0.f;
#pragma unroll
          for (int s = 0; s < 8; ++s) { const float tt = Tt[s * 64 + d]; bl += tt; off += (s < seg) ? tt : 0.f; }
          if (seg == 0) { DEC[d] = __expf(bl); BL[d] = bl; }
#pragma unroll
          for (int i = 0; i < 8; ++i) { const int c = 8 * seg + i; const float bc = bv[i] + off; Gf[c * GP + d] = bc;
              if (PASS == 2) { const float q = bf2f(Qr[c * LPQ + d]), k = bf2f(Kr[c * LPQ + d]);
                  Qd[c * LPQ + d] = (bf16)f2bf(q * 0.125f * __expf(bc)); Ki[c * LPQ + d] = (bf16)f2bf(k * __expf(-bc)); } } }
        GBAR();
        { const int c = tid & 63, dseg = tid >> 6;
#pragma unroll
          for (int i = 0; i < 8; ++i) { const int d = 8 * dseg + i; KdT[d * LPQ + c] = (bf16)f2bf(bf2f(KrT[d * LPQ + c]) * __expf(BL[d] - Gf[c * GP + d])); } }
        if (PASS == 2) { const int ti = w >> 1;
#pragma unroll
          for (int tjj = 0; tjj < 2; ++tjj) { const int tj = 2 * (w & 1) + tjj; const f32x4 a = mma16_k64(Qd + 16 * ti * LPQ, LPQ, Ki + 16 * tj * LPQ, LPQ, lane);
#pragma unroll
              for (int r = 0; r < 4; ++r) { const int i = 16 * ti + 4 * q4 + r, j = 16 * tj + r16; Am[i * LPQ + j] = (bf16)f2bf(i >= j ? a[r] : 0.f); } } }
        GBAR();
        f32x4 o[4];
        if (PASS == 2) { bf16x8 sb[2];
#pragma unroll
          for (int kk = 0; kk < 2; ++kk) { v4u pk; pk.x = pk2(S[2 * kk][0], S[2 * kk][1]); pk.y = pk2(S[2 * kk][2], S[2 * kk][3]); pk.z = pk2(S[2 * kk + 1][0], S[2 * kk + 1][1]); pk.w = pk2(S[2 * kk + 1][2], S[2 * kk + 1][3]); sb[kk] = __builtin_bit_cast(bf16x8, pk); }
#pragma unroll
          for (int ti = 0; ti < 4; ++ti) { f32x4 acc = mma16_k64(Am + 16 * ti * LPQ, LPQ, VT + 16 * w * LPQ, LPQ, lane);
#pragma unroll
              for (int kk = 0; kk < 2; ++kk) { const LAS bf16* qp = Qd + (16 * ti + r16) * LPQ + 32 * kk + 4 * q4;
                  const v2u lo = *(const LAS v2u*)qp, hi = *(const LAS v2u*)(qp + 16); v4u av; av.x = lo.x; av.y = lo.y; av.z = hi.x; av.w = hi.y;
                  acc = __builtin_amdgcn_mfma_f32_16x16x32_bf16(__builtin_bit_cast(bf16x8, av), sb[kk], acc, 0, 0, 0); }
              o[ti] = acc; } }
#pragma unroll
        for (int t = 0; t < 4; ++t) { const f32x4 dv = *(const LAS f32x4*)(DEC + 16 * t + 4 * q4); f32x4 acc = S[t] * dv;
            pd[t] = pd[t] * dv;
            const LAS bf16* ap = KdT + (16 * t + r16) * LPQ + 8 * q4; const LAS bf16* bp = VT + (16 * w + r16) * LPQ + 8 * q4;
#pragma unroll
            for (int kk = 0; kk < 2; ++kk) acc = __builtin_amdgcn_mfma_f32_16x16x32_bf16(*(const LAS bf16x8*)(ap + 32 * kk), *(const LAS bf16x8*)(bp + 32 * kk), acc, 0, 0, 0);
            S[t] = acc; }
        if (PASS == 1) { GBAR(); continue; }
#pragma unroll
        for (int ti = 0; ti < 4; ++ti)
#pragma unroll
            for (int r = 0; r < 4; ++r) { const float s = rowsum16(o[ti][r] * o[ti][r]); if (r16 == 0) SS[w * 64 + 16 * ti + 4 * q4 + r] = s; }
        GBAR();
        { const int cp = 16 * (r16 >> 2) + 4 * q4 + (r16 & 3); float t = 0.f;
#pragma unroll
          for (int ww = 0; ww < 8; ++ww) t += SS[ww * 64 + cp];
          RSL[cp] = __builtin_amdgcn_rsqf(t * (1.f / 128.f) + RMS_EPS); }
        asm volatile("s_waitcnt lgkmcnt(0)" ::: "memory");
#pragma unroll
        for (int ti = 0; ti < 4; ++ti) { const f32x4 rs4 = *(const LAS f32x4*)(RSL + 16 * ti + 4 * q4);
#pragma unroll
            for (int r = 0; r < 4; ++r) { const int c = 16 * ti + 4 * q4 + r; const float rs = rs4[r];
                const float g = bf2f(GOs[c * LPG + 16 * w + r16]);
                Ost[c * LPG + 16 * w + r16] = (bf16)f2bf(o[ti][r] * rs * wg * (g * __builtin_amdgcn_rcpf(1.f + __expf(-g)))); } }
        GBAR();
    }
    if (PASS == 1) {
#pragma unroll
        for (int t = 0; t < 4; ++t) { *(GAS f32x4*)(USUM + ((size_t)run * 512 + tid) * 16 + 4 * t) = S[t]; if (w == 0 && r16 == 0) *(GAS f32x4*)(PDS + (size_t)run * 64 + 16 * t + 4 * q4) = pd[t]; }
    }
}
__device__ __forceinline__ Frame mkframe(unsigned char* lds) {
    Frame F; int tx = threadIdx.x, bx = blockIdx.x, G = gridDim.x;
    { volatile LAS unsigned* st = (volatile LAS unsigned*)((LAS unsigned char*)lds + MISC_OFF) + 8; if (st[3]) bx = (int)((xb_xcc_id() & 7u) + 8u * st[2]); }
    bx = __builtin_amdgcn_readfirstlane(bx);
    asm volatile("" : "+v"(tx)); asm volatile("" : "+s"(bx)); asm volatile("" : "+s"(G));
    F.lds = (LAS unsigned char*)lds; F.tid = tx; F.lane = tx & 63; F.wave = __builtin_amdgcn_readfirstlane(tx >> 6);
    F.G = G; F.bx = bx; F.vcu = (G % 8 == 0) ? (bx % 8) * (G / 8) + bx / 8 : bx; F.gw = bx * NWAVES + F.wave; F.NGW = G * NWAVES;
    return F;
}
__device__ __forceinline__ void seam(unsigned char* lds, int k) {
    KArgs A = kargs(); const int lo = A->ph_lo, hi = A->ph_hi;
    if (!(lo <= k && k + 1 < hi)) return;
    XcdBarrier b; b.bar = (unsigned*)(A->ws + WS_CTL) + CW_BAR; b.x = xb_xcc_id(); b.st = (volatile LAS unsigned*)((LAS unsigned char*)lds + MISC_OFF) + 8;
    xcd_barrier(b);
#ifdef PROBE_DUP_BAR
    xcd_barrier(b);
#endif
}
__device__ __forceinline__ void seam_local(unsigned char* lds, int k) {
    KArgs A = kargs(); const int lo = A->ph_lo, hi = A->ph_hi;
    if (!(lo <= k && k + 1 < hi)) return;
    XcdBarrier b; b.bar = (unsigned*)(A->ws + WS_CTL) + CW_BAR; b.x = xb_xcc_id(); b.st = (volatile LAS unsigned*)((LAS unsigned char*)lds + MISC_OFF) + 8;
    if (b.st[3]) xcd_local_barrier(b, (unsigned*)(A->ws + WS_CTL) + CW_LBAR); else xcd_barrier(b);
}
__device__ __forceinline__ bool phase_on(int k) { KArgs A = kargs(); return A->ph_lo <= k && k < A->ph_hi; }

__device__ __forceinline__ int probe_reps(bool on) { int n = on ? 2 : 1; asm volatile("" : "+s"(n)); return n; }
#ifdef PROBE_DUP_A1
#define REP_A1 true
#else
#define REP_A1 false
#endif
#ifdef PROBE_DUP_C1
#define REP_C1 true
#else
#define REP_C1 false
#endif
#ifdef PROBE_DUP_P0
#define REP_P0 true
#else
#define REP_P0 false
#endif
#ifdef PROBE_DUP_D1
#define REP_D1 true
#else
#define REP_D1 false
#endif
__device__ __forceinline__ bool attn_scores_bounded(int l) {
    KArgs A = kargs(); int tx = threadIdx.x; asm volatile("" : "+v"(tx)); const int lane = tx & 63;
    float mq = fabsf(A->in[I_QNW][l * 64 + lane]), mk = fabsf(A->in[I_KNW][l * 64 + lane]);
#pragma unroll
    for (int o = 1; o < 64; o <<= 1) { mq = fmaxf(mq, __shfl_xor(mq, o)); mk = fmaxf(mk, __shfl_xor(mk, o)); }
    return __builtin_amdgcn_readfirstlane((int)(8.f * 1.4426950408889634f * mq * mk < 60.f)) != 0;
}
template <int L> __device__ __forceinline__ void layer_fwd(unsigned char* lds) {
    constexpr int pb = 1 + 12 * L;
    if (phase_on(pb + 0)) {
        Frame F = mkframe(lds); KArgs A = kargs(); unsigned char* const ws = A->ws;
        pg8::Gemm g{(const bf16*)(ws + WS_XN8), (const bf16*)(ws + WS_WIN + (size_t)L * NIN * D), M, NIN, D / 2}; pg8::StaticOrder S; S.init(M, NIN, F.G, F.bx);
        pg8::EpiInProj E{ws, A->in[I_GB] + L * 256, A->in[I_QNW] + L * 64, A->in[I_KNW] + L * 64, attn_body::C2, (const float*)(ws + WS_AS), (const float*)(ws + WS_WCS) + L * NIN};
#ifdef PROBE_DUP_A1
        for (int rep = probe_reps(true); rep > 0; --rep)
#endif
        pg8::gemm_phase<pg8::EpiInProj, pg8::StaticOrder, true, true>(F.lds + RING_OFF, g, S, E);
    }
    if (phase_on(pb + 0)) {
        Frame F = mkframe(lds); const int nfull = ((M / 256) * (NIN / 256)) % F.G;
        if (nfull == 0) quant_tables(kargs(), L, F.gw, F.NGW, F.lane);
        else if (F.bx >= nfull) quant_tables(kargs(), L, (F.bx - nfull) * NWAVES + F.wave, (F.G - nfull) * NWAVES, F.lane);
    }
    seam_local(lds, pb + 0);
    if (phase_on(pb + 1)) { Frame F = mkframe(lds);
#ifdef PROBE_DUP_GLA1
        for (int rep = probe_reps(true); rep > 0; --rep)
#endif
        if (F.G == 256) { const int x = F.bx & 7, j = F.bx >> 3; gla_run<1>(F, L, (((x >> 1) * 4 + (j >> 3)) << 4) + 8 * (x & 1) + (j & 7)); }
        else for (int run = F.bx; run < 256; run += F.G) gla_run<1>(F, L, run); }
    seam(lds, pb + 1);
    if (phase_on(pb + 2)) { Frame F = mkframe(lds);
#ifdef PROBE_DUP_GLA2
        for (int rep = probe_reps(true); rep > 0; --rep)
#endif
        if (F.G == 256) { const int x = F.bx & 7, j = F.bx >> 3; gla_run<2>(F, L, (((x >> 1) * 4 + (j >> 3)) << 4) + 8 * (x & 1) + (j & 7)); }
        else for (int run = F.bx; run < 256; run += F.G) gla_run<2>(F, L, run); }
    if (phase_on(pb + 2) && attn_scores_bounded(L)) {
        Frame F = mkframe(lds); unsigned char* const ws = kargs()->ws;
        static_assert(attn_body::L2_BYTES <= RING_BYTES && attn_body::ATTN_LDS_BYTES <= RING_BYTES, "attention LDS");
        const attn_body::StaticOrder128 S(F.G, F.bx);
#ifdef PROBE_DUP_ATTN
        for (int rep = probe_reps(true); rep > 0; --rep)
#endif
        attn_body::attn_phase128((char*)lds + RING_OFF, (const attn_body::bf16*)(ws + WS_Q), (const attn_body::bf16*)(ws + WS_K), (const attn_body::bf16*)(ws + WS_DV), (attn_body::bf16*)(ws + WS_O), S);
    }
    if (phase_on(pb + 2) && !attn_scores_bounded(L)) {
        Frame F = mkframe(lds); unsigned char* const ws = kargs()->ws;
        const attn_body::AttnTensors AT{(const attn_body::bf16*)(ws + WS_Q), (const attn_body::bf16*)(ws + WS_K), (const attn_body::bf16*)(ws + WS_DV), (attn_body::bf16*)(ws + WS_O)};
        const attn_body::StaticOrder S(F.G, F.bx);
        attn_body::attn_phase<attn_body::StaticOrder>((char*)lds + RING_OFF, AT, S);
    }
    seam(lds, pb + 2);
    if (phase_on(pb + 3)) { Frame F = mkframe(lds);
#ifdef PROBE_DUP_DIFF
        for (int rep = probe_reps(true); rep > 0; --rep)
#endif
        diff_rows(F, L); }
    seam_local(lds, pb + 3);
    if (phase_on(pb + 4)) {
        Frame F = mkframe(lds); KArgs A = kargs(); unsigned char* const ws = A->ws;
        pg8::Gemm g{(const bf16*)((const unsigned char*)A->out + OUT_MIX8)  , (const bf16*)(ws + WS_WOUT + (size_t)L * D * D), M, D, D / 2}; pg8::StaticOrder S; S.init(M, D, F.G, F.bx);
        pg8::EpiResid<L == 0> E{A->in[I_X], (bf16*)(ws + WS_RES), (const float*)((const unsigned char*)A->out + OUT_MS), (const float*)(ws + WS_WOCS) + L * D};
#ifdef PROBE_DUP_C2
        for (int rep = probe_reps(L == 0); rep > 0; --rep)
#endif
        pg8::gemm_phase<pg8::EpiResid<L == 0>, pg8::StaticOrder, true, true>(F.lds + RING_OFF, g, S, E);
    }
    seam_local(lds, pb + 4);
    if (phase_on(pb + 5)) { Frame F = mkframe(lds); KArgs A = kargs(); unsigned char* const ws = A->ws;
        unsigned char* XR8 = (unsigned char*)A->out + OUT_MIX8; float* XS = (float*)((unsigned char*)A->out + OUT_MS);
        const int NX = (F.G & 7) == 0 ? 8 : 1, XI = F.bx % NX, RX = M / NX, xw = (F.bx / NX) * NWAVES + F.wave, WX = (F.G / NX) * NWAVES;
        const int mend = RX * (XI + 1), mstep = 4 * WX; int m0 = RX * XI + 4 * xw;
        v4u r[4][2];
#define R8_LOAD(R_, M_) do { _Pragma("unroll") for (int j = 0; j < 4; ++j) { const GAS v4u* rp = (const GAS v4u*)((const bf16*)(ws + WS_RES) + (size_t)((M_) + j) * D + 16 * F.lane); R_[j][0] = rp[0]; R_[j][1] = rp[1]; } } while (0)
        if (m0 < mend) R8_LOAD(r, m0);
        for (; m0 < mend; m0 += mstep) {
            const bool hn = m0 + mstep < mend; v4u rn[4][2];
            if (hn) R8_LOAD(rn, m0 + mstep);
#pragma unroll
            for (int j = 0; j < 4; ++j) { const v4u a0 = r[j][0], a1 = r[j][1]; f32x4 va[4];
                va[0] = (f32x4){bflo(a0.x), bfhi(a0.x), bflo(a0.y), bfhi(a0.y)}; va[1] = (f32x4){bflo(a0.z), bfhi(a0.z), bflo(a0.w), bfhi(a0.w)}; va[2] = (f32x4){bflo(a1.x), bfhi(a1.x), bflo(a1.y), bfhi(a1.y)}; va[3] = (f32x4){bflo(a1.z), bfhi(a1.z), bflo(a1.w), bfhi(a1.w)};
                row_to_i8(F.lane, va, nullptr, XR8 + (size_t)(m0 + j) * D, XS + m0 + j, (float*)(ws + WS_RS) + m0 + j); }
            if (hn) {
#pragma unroll
                for (int j = 0; j < 4; ++j) { r[j][0] = rn[j][0]; r[j][1] = rn[j][1]; } }
        }
#undef R8_LOAD
    }
    seam_local(lds, pb + 5);
    if (phase_on(pb + 6)) {
        Frame F = mkframe(lds); KArgs A = kargs(); unsigned char* const ws = A->ws;
        pg8::Gemm g{(const bf16*)((const unsigned char*)A->out + OUT_MIX8), (const bf16*)(ws + WS_WQ + (size_t)L * 2048 * D), M, 2048, D / 2}; pg8::StaticOrder S; S.init(M, 2048, F.G, F.bx);
        pg8::EpiRowScale E{(bf16*)(ws + WS_Q2), 2048, (const float*)((const unsigned char*)A->out + OUT_MS), (const float*)(ws + WS_WQCS) + L * 2048};
#ifdef PROBE_DUP_D1
        for (int rep = probe_reps(true); rep > 0; --rep)
#endif
        pg8::gemm_phase<pg8::EpiRowScale, pg8::StaticOrder, true, true>(F.lds + RING_OFF, g, S, E);
    }
    seam_local(lds, pb + 6);
    if (phase_on(pb + 7)) { Frame F = mkframe(lds);
#if defined(PROBE_DUP_D2)
        int nrep = 2; asm volatile("" : "+s"(nrep));
        for (int rep = 0; rep < nrep; ++rep)
#endif
        peer_select(F, L);
    }
    seam(lds, pb + 7);
    if (phase_on(pb + 8)) { Frame F = mkframe(lds); peer_sliced<false>(F, L);
#if defined(PROBE_DUP_U)
        peer_sliced<false, true>(F, L);
#endif
    }
    seam(lds, pb + 8);
    if (phase_on(pb + 9)) { Frame F = mkframe(lds);
#ifdef PROBE_DUP_W
        for (int rep = probe_reps(true); rep > 0; --rep)
#endif
        peer_w(F, L); }
    seam(lds, pb + 9);
    if (phase_on(pb + 10)) { Frame F = mkframe(lds);
#if defined(PROBE_DUP_V)
        peer_sliced<true, true, L + 1 == DEPTH>(F, L);
#endif
        peer_sliced<true, false, L + 1 == DEPTH>(F, L); }
    seam(lds, pb + 10);
    if (L + 1 < DEPTH) {
        if (phase_on(pb + 11)) { Frame F = mkframe(lds); KArgs A = kargs(); unsigned char* const ws = A->ws;
            const int NX = (F.G & 7) == 0 ? 8 : 1, XI = F.bx % NX, RX = M / NX, xw = (F.bx / NX) * NWAVES + F.wave, WX = (F.G / NX) * NWAVES;
            const int mend = RX * (XI + 1), mstep = 4 * WX; int m0 = RX * XI + 4 * xw;
            v4u r[4][2];
#define E8_LOAD(R_, M_) do { _Pragma("unroll") for (int j = 0; j < 4; ++j) { const GAS v4u* rp = (const GAS v4u*)((const bf16*)(ws + WS_RES) + (size_t)((M_) + j) * D + 16 * F.lane); R_[j][0] = rp[0]; R_[j][1] = rp[1]; } } while (0)
            if (m0 < mend) E8_LOAD(r, m0);
            for (; m0 < mend; m0 += mstep) {
                const bool hn = m0 + mstep < mend; v4u rn[4][2];
                if (hn) E8_LOAD(rn, m0 + mstep);
#pragma unroll
                for (int j = 0; j < 4; ++j) { const v4u a0 = r[j][0], a1 = r[j][1]; f32x4 va[4];
                    va[0] = (f32x4){bflo(a0.x), bfhi(a0.x), bflo(a0.y), bfhi(a0.y)}; va[1] = (f32x4){bflo(a0.z), bfhi(a0.z), bflo(a0.w), bfhi(a0.w)}; va[2] = (f32x4){bflo(a1.x), bfhi(a1.x), bflo(a1.y), bfhi(a1.y)}; va[3] = (f32x4){bflo(a1.z), bfhi(a1.z), bflo(a1.w), bfhi(a1.w)};
                    row_to_i8(F.lane, va, nullptr, ws + WS_XN8 + (size_t)(m0 + j) * D, (float*)(ws + WS_AS) + m0 + j); }
                if (hn) {
#pragma unroll
                    for (int j = 0; j < 4; ++j) { r[j][0] = rn[j][0]; r[j][1] = rn[j][1]; } }
            }
#undef E8_LOAD
        }
        seam_local(lds, pb + 11);
    }
}

__global__ void __launch_bounds__(NWAVES * 64, 2) mega_fwd(Args args) {
    extern __shared__ __attribute__((aligned(16))) unsigned char lds[];
    (void)args;
    { const int tx = threadIdx.x; for (int u = tx; u < (LDS_BYTES - LDSCTL_OFF) / 4; u += NWAVES * 64) ((LAS unsigned*)((LAS unsigned char*)lds + LDSCTL_OFF))[u] = 0u; }
    __syncthreads();
    { KArgs A = kargs(); if (A->ph_hi - A->ph_lo > 1) (void)xcd_barrier_post((unsigned*)(A->ws + WS_CTL) + CW_BAR, (volatile LAS unsigned*)((LAS unsigned char*)lds + MISC_OFF) + 8); }
    if (phase_on(0)) { Frame F = mkframe(lds);
#ifdef PROBE_DUP_P0
        for (int rep = probe_reps(true); rep > 0; --rep)
#endif
        p0_prologue(F); }
    seam(lds, 0);
    layer_fwd<0>(lds);
    layer_fwd<1>(lds);
}

extern "C" void kernel_launch(void* const* d_in, const int* in_sizes, int n_in, void* d_out, int out_size, void* d_ws, size_t ws_size, hipStream_t stream) {
    static int grid = 0;
    if (grid == 0) {
        if (n_in != 19 || in_sizes[0] != M * D || out_size != M * D || ws_size < WS_END) { fprintf(stderr, "kernel_launch: unexpected shapes (n_in %d, in0 %d, out %d, ws %zu)\n", n_in, n_in > 0 ? in_sizes[0] : -1, out_size, ws_size); grid = -1; return; }
        int dev = 0, cus = 0, per_cu = 0;
        if (hipGetDevice(&dev) != hipSuccess || hipDeviceGetAttribute(&cus, hipDeviceAttributeMultiprocessorCount, dev) != hipSuccess) { grid = -1; return; }
        if (hipFuncSetAttribute((const void*)mega_fwd, hipFuncAttributeMaxDynamicSharedMemorySize, LDS_BYTES) != hipSuccess) { fprintf(stderr, "kernel_launch: hipFuncSetAttribute failed\n"); grid = -1; return; }
        if (hipOccupancyMaxActiveBlocksPerMultiprocessor(&per_cu, (const void*)mega_fwd, NWAVES * 64, LDS_BYTES) != hipSuccess || per_cu < 1) fprintf(stderr, "kernel_launch: occupancy query reports %d\n", per_cu);
        (void)hipGetLastError();
        grid = cus;
    }
    if (grid < 0) return;
    if (hipMemsetAsync((char*)d_ws + WS_CTL, 0, CTL_ZERO_BYTES, stream) != hipSuccess) return;
    Args a{};
    for (int i = 0; i < 19; ++i) a.in[i] = (const float*)d_in[i];
    a.out = (float*)d_out; a.ws = (unsigned char*)d_ws;
#if MK_PER_PHASE
    for (int p = 0; p < NPHASE; ++p) { a.ph_lo = p; a.ph_hi = p + 1; hipLaunchKernelGGL(mega_fwd, dim3(grid), dim3(NWAVES * 64), LDS_BYTES, stream, a); }
#else
    a.ph_lo = 0; a.ph_hi = NPHASE; hipLaunchKernelGGL(mega_fwd, dim3(grid), dim3(NWAVES * 64), LDS_BYTES, stream, a);
#endif
}
```

```cpp
#include <hip/hip_runtime.h>
#include <cstdio>
#include <cstdint>
#include <utility>
namespace pg8 {
#define PG8_LAS __attribute__((address_space(3)))
typedef unsigned short bf16_t;
typedef short bf16x8 __attribute__((ext_vector_type(8)));
typedef float f32x4 __attribute__((ext_vector_type(4)));
typedef unsigned u32x4 __attribute__((ext_vector_type(4)));
__device__ __forceinline__ float xsum16(float v) { auto rr = __builtin_amdgcn_permlane16_swap(__float_as_uint(v), __float_as_uint(v), false, false); return __uint_as_float(rr[0]) + __uint_as_float(rr[1]); }
__device__ __forceinline__ float xsum32(float v) { auto rr = __builtin_amdgcn_permlane32_swap(__float_as_uint(v), __float_as_uint(v), false, false); return __uint_as_float(rr[0]) + __uint_as_float(rr[1]); }
constexpr int BM = 256, BK = 64, HALF = 128, HTB = HALF * BK * 2  , STAGE_BYTES = 8 * HTB, NXCD = 8, WGM = 8;

__host__ __device__ __forceinline__ int lds_byte(int r, int c) { const int st = (r >> 4) * 2 + (c >> 5), rr = r & 15, cc = c & 31, ob = rr * 64 + cc * 2; return st * 1024 + (ob ^ (((ob >> 9) & 1) << 5)); }
__host__ __device__ __forceinline__ void stage_rc(int b, int& R, int& C) { const int st = b / 1024, sb = b % 1024, swz = sb ^ (((sb >> 9) & 1) << 5); R = (st >> 1) * 16 + swz / 64; C = (st & 1) * 32 + (swz % 64) / 2; }
__host__ __device__ __forceinline__ int perm32(int rho) { const int n = rho >> 4, i = rho & 15; return 8 * (i >> 2) + 4 * n + (i & 3); }

typedef int i32x4 __attribute__((ext_vector_type(4)));
template <bool I8> __device__ __forceinline__ f32x4 pg8_mma(bf16x8 b, bf16x8 a, f32x4 c) {
    if constexpr (I8) return __builtin_bit_cast(f32x4, __builtin_amdgcn_mfma_i32_16x16x64_i8(__builtin_bit_cast(i32x4, b), __builtin_bit_cast(i32x4, a), __builtin_bit_cast(i32x4, c), 0, 0, 0));
    else return __builtin_amdgcn_mfma_f32_16x16x32_bf16(b, a, c, 0, 0, 0);
}
struct Unit { int pm, pn; };
struct Gemm { const bf16_t* A; const bf16_t* Bt; int M, N, K; };

struct StaticOrder {
    int nM, nN, nwg, G, c, wgm;
    __host__ __device__ void init(int M, int N, int G_, int c_, int wgm_ = WGM) { nM = M / BM; nN = N / BM; nwg = nM * nN; G = G_; c = c_; wgm = wgm_; }
    __host__ __device__ bool next(int i, Unit& u) const {
#ifdef PROBE_DUP_A1S
        const long L = (long)(nN == 13 ? (i >> 1) : i) * G + c; if (L >= nwg) return false;
#else
        const long L = (long)i * G + c; if (L >= nwg) return false;
#endif
        int wgid = (int)L; { const int q = nwg / NXCD, r = nwg % NXCD, xcd = wgid % NXCD, off = wgid / NXCD; wgid = (xcd < r ? xcd * (q + 1) : r * (q + 1) + (xcd - r) * q) + off; }
        const int nig = wgm * nN, gid = wgid / nig, fm = gid * wgm, gsz = (nM - fm) < wgm ? (nM - fm) : wgm;
        u.pm = fm + ((wgid % nig) % gsz); u.pn = (wgid % nig) / gsz; return true;
    }
    __device__ __forceinline__ void a_ready(const Unit&) const {}
    __device__ __forceinline__ void done(const Unit&) const {}
};

__device__ __forceinline__ unsigned cvt_pk_bf16(float lo, float hi) { unsigned r; asm volatile("v_cvt_pk_bf16_f32 %0, %1, %2" : "=v"(r) : "v"(lo), "v"(hi)); return r; }
constexpr size_t WSO_Q = 160u << 20, WSO_K = 192u << 20, WSO_DV = 224u << 20, WSO_GQ = 256u << 20, WSO_GO = 272u << 20, WSO_GK = 400u << 20, WSO_GV = 416u << 20, WSO_GLOG = 448u << 20;
__device__ __forceinline__ void store8_bf16(bf16_t* p, f32x4 v0, f32x4 v1) { u32x4 w; w.x = cvt_pk_bf16(v0[0], v0[1]); w.y = cvt_pk_bf16(v0[2], v0[3]); w.z = cvt_pk_bf16(v1[0], v1[1]); w.w = cvt_pk_bf16(v1[2], v1[3]); *(u32x4*)p = w; }
__device__ __forceinline__ u32x4 pack8_bf16(f32x4 v0, f32x4 v1) { u32x4 w; w.x = cvt_pk_bf16(v0[0], v0[1]); w.y = cvt_pk_bf16(v0[2], v0[3]); w.z = cvt_pk_bf16(v1[0], v1[1]); w.w = cvt_pk_bf16(v1[2], v1[3]); return w; }
__device__ __forceinline__ void store_pair_rows(bf16_t* rowp, int ld, u32x4 x0, u32x4 x1, bool odd) {
    const u32x4 snd = odd ? x0 : x1; u32x4 rcv;
    rcv.x = (unsigned)__builtin_amdgcn_update_dpp(0, (int)snd.x, 0xB1, 0xF, 0xF, true); rcv.y = (unsigned)__builtin_amdgcn_update_dpp(0, (int)snd.y, 0xB1, 0xF, 0xF, true);
    rcv.z = (unsigned)__builtin_amdgcn_update_dpp(0, (int)snd.z, 0xB1, 0xF, 0xF, true); rcv.w = (unsigned)__builtin_amdgcn_update_dpp(0, (int)snd.w, 0xB1, 0xF, 0xF, true);
    bf16_t* pa = odd ? rowp - ld + 32 : rowp; bf16_t* pb = odd ? rowp + 32 : rowp + ld;
    __builtin_nontemporal_store(odd ? rcv : x0, (u32x4*)pa); __builtin_nontemporal_store(odd ? x1 : rcv, (u32x4*)pb);
}
__device__ __forceinline__ float log_sigmoid_f(float x) { return fminf(x, 0.f) - __logf(1.f + __expf(-fabsf(x))); }
struct EpiPlain {
    static constexpr bool PERM = true, AFTER_DRAIN = false, IDEMPOTENT = true, I8 = false;
    bf16_t* O; int ldc;
    __device__ __forceinline__ void operator()(const f32x4 (&acc)[2][2][4][2], const Unit& u, int wr, int wc, int fr, int fq) const {
        const int row0 = u.pm * BM + wr * 64 + fr, col0 = u.pn * BM + wc * 32 + 8 * fq;
#pragma unroll
        for (int ai = 0; ai < 2; ++ai)
#pragma unroll
            for (int m = 0; m < 4; ++m) { bf16_t* rowp = O + (size_t)(row0 + ai * HALF + m * 16) * ldc + col0;
#pragma unroll
                for (int bj = 0; bj < 2; ++bj) store8_bf16(rowp + bj * HALF, acc[ai][bj][m][0], acc[ai][bj][m][1]); }
    }
};
__host__ __device__ __forceinline__ int inproj_phys_row(int n) { const int cl = n & 255; return (n & ~255) + 128 * ((cl >> 5) & 1) + 32 * (cl >> 6) + (cl & 31); }
struct EpiInProj {
    static constexpr bool PERM = true, AFTER_DRAIN = false, IDEMPOTENT = true, I8 = true;
    unsigned char* ws; const float* gate_b; const float* qn_w; const float* kn_w; float qscale;
    const float* arow; const float* wcol;
#ifdef PROBE_DUP_EPI8
    bool nostore = false;
    __device__ __forceinline__ void store8_bf16(bf16_t* p, f32x4 v0, f32x4 v1) const { if (!nostore) pg8::store8_bf16(p, v0, v1); else asm volatile("" :: "v"(v0[0] + v0[1] + v0[2] + v0[3] + v1[0] + v1[1] + v1[2] + v1[3])); }
#endif
    __device__ __forceinline__ static f32x4 cvt(const f32x4& a) { const i32x4 i = __builtin_bit_cast(i32x4, a); return (f32x4){(float)i[0], (float)i[1], (float)i[2], (float)i[3]}; }
    __device__ __forceinline__ void operator()(const f32x4 (&acc)[2][2][4][2], const Unit& u, int wr, int wc, int fr, int fq) const {
        const int pn = u.pn, row0 = u.pm * BM + wr * 64 + fr, cl = wc * 64 + 8 * fq;
        f32x4 cs[2][2];
#pragma unroll
        for (int bj = 0; bj < 2; ++bj)
#pragma unroll
            for (int n = 0; n < 2; ++n) cs[bj][n] = *(const f32x4*)(wcol + pn * 256 + cl + 32 * bj + 4 * n);
        float rrv[2][4];
#pragma unroll
        for (int ai = 0; ai < 2; ++ai)
#pragma unroll
            for (int m = 0; m < 4; ++m) rrv[ai][m] = arow[row0 + ai * HALF + m * 16];
        asm volatile("" : "+v"(rrv[0][0]), "+v"(rrv[0][1]), "+v"(rrv[0][2]), "+v"(rrv[0][3]), "+v"(rrv[1][0]), "+v"(rrv[1][1]), "+v"(rrv[1][2]), "+v"(rrv[1][3]));
        if (pn == 12) {
            f32x4 bv[2][2];
#pragma unroll
            for (int bj = 0; bj < 2; ++bj)
#pragma unroll
                for (int n = 0; n < 2; ++n) bv[bj][n] = *(const f32x4*)(gate_b + cl + 32 * bj + 4 * n);
#pragma unroll
            for (int ai = 0; ai < 2; ++ai)
#pragma unroll
                for (int m = 0; m < 4; ++m) { const int row = row0 + ai * HALF + m * 16; bf16_t* rowp = (bf16_t*)(ws + WSO_GLOG) + (size_t)row * 256 + cl; const float rr = rrv[ai][m];
                    u32x4 pk[2];
#pragma unroll
                    for (int bj = 0; bj < 2; ++bj) { f32x4 o[2];
#pragma unroll
                        for (int n = 0; n < 2; ++n) { const f32x4 v = cvt(acc[ai][bj][m][n]) * (cs[bj][n] * rr) + bv[bj][n];
                            o[n][0] = log_sigmoid_f(v[0]) * 0.09016844f; o[n][1] = log_sigmoid_f(v[1]) * 0.09016844f; o[n][2] = log_sigmoid_f(v[2]) * 0.09016844f; o[n][3] = log_sigmoid_f(v[3]) * 0.09016844f; }
                        pk[bj] = pack8_bf16(o[0], o[1]); }
                    store_pair_rows(rowp, 256, pk[0], pk[1], fr & 1); }
            return;
        }
        if (pn < 4) {
            const bool isk = pn >= 2; const float* nw = isk ? kn_w : qn_w; const float sc = isk ? 1.f : qscale;
            f32x4 wv[2][2];
#pragma unroll
            for (int bj = 0; bj < 2; ++bj)
#pragma unroll
                for (int n = 0; n < 2; ++n) wv[bj][n] = *(const f32x4*)(nw + 8 * fq + 32 * bj + 4 * n) * sc;
            bf16_t* base = (bf16_t*)(ws + (isk ? WSO_K : WSO_Q)); const int c0 = (pn & 1) * 256;
#pragma unroll
            for (int ai = 0; ai < 2; ++ai)
#pragma unroll
                for (int m = 0; m < 4; ++m) { const int row = row0 + ai * HALF + m * 16; const float rr = rrv[ai][m];
                    f32x4 x[2][2]; float ss = 0.f;
#pragma unroll
                    for (int bj = 0; bj < 2; ++bj)
#pragma unroll
                        for (int n = 0; n < 2; ++n) { x[bj][n] = cvt(acc[ai][bj][m][n]) * (cs[bj][n] * rr); ss += (x[bj][n][0] * x[bj][n][0] + x[bj][n][1] * x[bj][n][1]) + (x[bj][n][2] * x[bj][n][2] + x[bj][n][3] * x[bj][n][3]); }
                    ss = xsum32(xsum16(ss));
                    const float rs = __builtin_amdgcn_rsqf(ss * (1.f / 64.f) + 1e-6f);
                    bf16_t* rowp = base + (size_t)row * 512 + c0 + cl;
                    store_pair_rows(rowp, 512, pack8_bf16(x[0][0] * rs * wv[0][0], x[0][1] * rs * wv[0][1]), pack8_bf16(x[1][0] * rs * wv[1][0], x[1][1] * rs * wv[1][1]), fr & 1);
                }
            return;
        }
        size_t bo; int ldc, c0;
        if (pn < 6) { bo = WSO_DV; ldc = 512; c0 = (pn - 4) * 256; }
        else if (pn == 6) { bo = WSO_GQ; ldc = 256; c0 = 0; }
        else if (pn == 7) { bo = WSO_GK; ldc = 256; c0 = 0; }
        else if (pn < 10) { bo = WSO_GV; ldc = 512; c0 = (pn - 8) * 256; }
        else { bo = WSO_GO; ldc = 512; c0 = (pn - 10) * 256; }
        bf16_t* base = (bf16_t*)(ws + bo);
#pragma unroll
        for (int ai = 0; ai < 2; ++ai)
#pragma unroll
            for (int m = 0; m < 4; ++m) { const int row = row0 + ai * HALF + m * 16; bf16_t* rowp = base + (size_t)row * ldc + c0 + cl; const float rr = rrv[ai][m];
                store_pair_rows(rowp, ldc, pack8_bf16(cvt(acc[ai][0][m][0]) * (cs[0][0] * rr), cvt(acc[ai][0][m][1]) * (cs[0][1] * rr)), pack8_bf16(cvt(acc[ai][1][m][0]) * (cs[1][0] * rr), cvt(acc[ai][1][m][1]) * (cs[1][1] * rr)), fr & 1); }
    }
};
template <bool FIRST> struct EpiResid {
    static constexpr bool PERM = true, AFTER_DRAIN = false, IDEMPOTENT = FIRST, I8 = true;
    const float* x; bf16_t* res; const float* arow; const float* wcol;
    __device__ __forceinline__ static f32x4 cvt(const f32x4& a) { const i32x4 i = __builtin_bit_cast(i32x4, a); return (f32x4){(float)i[0], (float)i[1], (float)i[2], (float)i[3]}; }
    __device__ __forceinline__ void operator()(const f32x4 (&acc)[2][2][4][2], const Unit& u, int wr, int wc, int fr, int fq) const {
        const int row0 = u.pm * BM + wr * 64 + fr, col0 = u.pn * BM + wc * 32 + 8 * fq;
        f32x4 cs[2][2];
#pragma unroll
        for (int bj = 0; bj < 2; ++bj)
#pragma unroll
            for (int n = 0; n < 2; ++n) cs[bj][n] = *(const f32x4*)(wcol + col0 + bj * HALF + 4 * n);
        float rrv[2][4];
#pragma unroll
        for (int ai = 0; ai < 2; ++ai)
#pragma unroll
            for (int m = 0; m < 4; ++m) rrv[ai][m] = arow[row0 + ai * HALF + m * 16];
        asm volatile("" : "+v"(rrv[0][0]), "+v"(rrv[0][1]), "+v"(rrv[0][2]), "+v"(rrv[0][3]), "+v"(rrv[1][0]), "+v"(rrv[1][1]), "+v"(rrv[1][2]), "+v"(rrv[1][3]));
#pragma unroll
        for (int ai = 0; ai < 2; ++ai) {
            if constexpr (FIRST) {
#pragma unroll
                for (int bj = 0; bj < 2; ++bj) { f32x4 r[4][2];
#pragma unroll
                    for (int m = 0; m < 4; ++m) { const float* p = x + (size_t)(row0 + ai * HALF + m * 16) * 1024 + col0 + bj * HALF; r[m][0] = *(const f32x4*)p; r[m][1] = *(const f32x4*)(p + 4); }
                    asm volatile("" : "+v"(r[0][0]), "+v"(r[0][1]), "+v"(r[1][0]), "+v"(r[1][1]), "+v"(r[2][0]), "+v"(r[2][1]), "+v"(r[3][0]), "+v"(r[3][1]));
#pragma unroll
                    for (int m = 0; m < 4; ++m) { const size_t off = (size_t)(row0 + ai * HALF + m * 16) * 1024 + col0 + bj * HALF; const float rr = rrv[ai][m];
                        store8_bf16(res + off, r[m][0] + cvt(acc[ai][bj][m][0]) * (cs[bj][0] * rr), r[m][1] + cvt(acc[ai][bj][m][1]) * (cs[bj][1] * rr)); } }
            } else {
                u32x4 w[4][2];
#pragma unroll
                for (int m = 0; m < 4; ++m)
#pragma unroll
                    for (int bj = 0; bj < 2; ++bj) w[m][bj] = *(const u32x4*)(res + (size_t)(row0 + ai * HALF + m * 16) * 1024 + col0 + bj * HALF);
                asm volatile("" : "+v"(w[0][0]), "+v"(w[0][1]), "+v"(w[1][0]), "+v"(w[1][1]), "+v"(w[2][0]), "+v"(w[2][1]), "+v"(w[3][0]), "+v"(w[3][1]));
#pragma unroll
                for (int m = 0; m < 4; ++m)
#pragma unroll
                    for (int bj = 0; bj < 2; ++bj) { const size_t off = (size_t)(row0 + ai * HALF + m * 16) * 1024 + col0 + bj * HALF; const float rr = rrv[ai][m]; const u32x4 v = w[m][bj];
                        const f32x4 r0 = (f32x4){__builtin_bit_cast(float, v.x << 16), __builtin_bit_cast(float, v.x & 0xffff0000u), __builtin_bit_cast(float, v.y << 16), __builtin_bit_cast(float, v.y & 0xffff0000u)};
                        const f32x4 r1 = (f32x4){__builtin_bit_cast(float, v.z << 16), __builtin_bit_cast(float, v.z & 0xffff0000u), __builtin_bit_cast(float, v.w << 16), __builtin_bit_cast(float, v.w & 0xffff0000u)};
                        store8_bf16(res + off, r0 + cvt(acc[ai][bj][m][0]) * (cs[bj][0] * rr), r1 + cvt(acc[ai][bj][m][1]) * (cs[bj][1] * rr)); }
            }
        }
    }
};
struct EpiRowScale {
    static constexpr bool PERM = true, AFTER_DRAIN = false, IDEMPOTENT = true, I8 = true;
    bf16_t* O; int ldc; const float* arow; const float* wcol;
    __device__ __forceinline__ static f32x4 cvt(const f32x4& a) { const i32x4 i = __builtin_bit_cast(i32x4, a); return (f32x4){(float)i[0], (float)i[1], (float)i[2], (float)i[3]}; }
    __device__ __forceinline__ void operator()(const f32x4 (&acc)[2][2][4][2], const Unit& u, int wr, int wc, int fr, int fq) const {
        const int row0 = u.pm * BM + wr * 64 + fr, col0 = u.pn * BM + wc * 32 + 8 * fq;
        f32x4 cs[2][2];
#pragma unroll
        for (int bj = 0; bj < 2; ++bj)
#pragma unroll
            for (int n = 0; n < 2; ++n) cs[bj][n] = *(const f32x4*)(wcol + col0 + bj * HALF + 4 * n);
        float rrv[2][4];
#pragma unroll
        for (int ai = 0; ai < 2; ++ai)
#pragma unroll
            for (int m = 0; m < 4; ++m) rrv[ai][m] = arow[row0 + ai * HALF + m * 16];
        asm volatile("" : "+v"(rrv[0][0]), "+v"(rrv[0][1]), "+v"(rrv[0][2]), "+v"(rrv[0][3]), "+v"(rrv[1][0]), "+v"(rrv[1][1]), "+v"(rrv[1][2]), "+v"(rrv[1][3]));
#pragma unroll
        for (int ai = 0; ai < 2; ++ai)
#pragma unroll
            for (int m = 0; m < 4; ++m) { const int row = row0 + ai * HALF + m * 16; const float rr = rrv[ai][m];
                bf16_t* rowp = O + (size_t)row * ldc + col0;
#pragma unroll
                for (int bj = 0; bj < 2; ++bj) store8_bf16(rowp + bj * HALF, cvt(acc[ai][bj][m][0]) * (cs[bj][0] * rr), cvt(acc[ai][bj][m][1]) * (cs[bj][1] * rr)); }
    }
};
template <class Epi, class Sched, bool ALIGN_EPI = false, bool SP2 = false>
__device__ __forceinline__ void gemm_phase(PG8_LAS unsigned char* lds, const Gemm g, const Sched& S, const Epi& E) {
    const int tid = threadIdx.x, wid = __builtin_amdgcn_readfirstlane(tid >> 6), lane = tid & 63, wr = wid >> 2, wc = wid & 3, fr = lane & 15, fq = lane >> 4;
    const int K = g.K, nt = K / BK;
    unsigned voffA[2], voffB[2];
#pragma unroll
    for (int i = 0; i < 2; ++i) { int R, C; stage_rc(tid * 16 + i * 8192, R, C); const int Rb = Epi::PERM ? ((R & ~31) + perm32(R & 31)) : R;
        voffA[i] = (unsigned)(R * K + C) * 2u; voffB[i] = (unsigned)(Rb * K + C) * 2u; }
    const size_t kstep = (size_t)(BK * 2);
    const size_t hstep = (size_t)HALF * K * 2;
    const size_t tstep = 2 * hstep;
    const unsigned ldsw = (unsigned)wid * 1024u;
    const int aoff = lds_byte(wr * 64 + fr, fq * 8), boff = lds_byte(wc * 32 + fr, fq * 8);
#define PG8_SA(b, h) (((b) * 2 + (h)) * HTB)
#define PG8_SB(b, h) ((4 + (b) * 2 + (h)) * HTB)
#define PG8_STAGE(bufoff, gbase, voff) do { _Pragma("unroll") for (int _i = 0; _i < 2; ++_i) \
        __builtin_amdgcn_global_load_lds((const unsigned*)((const char*)(gbase) + (voff)[_i]), (PG8_LAS unsigned*)(lds + (bufoff) + ldsw + _i * 8192), 16, 0, 0); } while (0)
#define PG8_LDA(dst, b, h) do { _Pragma("unroll") for (int m = 0; m < 4; ++m) _Pragma("unroll") for (int k = 0; k < 2; ++k) dst[m][k] = *(const PG8_LAS bf16x8*)(lds + PG8_SA(b, h) + aoff + m * 2048 + k * 1024); } while (0)
#define PG8_LDB(dst, b, h) do { _Pragma("unroll") for (int n = 0; n < 2; ++n) _Pragma("unroll") for (int k = 0; k < 2; ++k) dst[n][k] = *(const PG8_LAS bf16x8*)(lds + PG8_SB(b, h) + boff + n * 2048 + k * 1024); } while (0)
#define PG8_MMA(ai, bj, At, Bt) do { __builtin_amdgcn_s_setprio(1); _Pragma("unroll") for (int k = 0; k < 2; ++k) _Pragma("unroll") for (int m = 0; m < 4; ++m) _Pragma("unroll") for (int n = 0; n < 2; ++n)   \
        acc[ai][bj][m][n] = pg8_mma<Epi::I8>(Bt[n][k], At[m][k], acc[ai][bj][m][n]); __builtin_amdgcn_s_setprio(0); } while (0)
#define PG8_WAIT_V(n) asm volatile("s_waitcnt vmcnt(" #n ")" ::: "memory")
#define PG8_WAIT_L(n) asm volatile("s_waitcnt lgkmcnt(" #n ")" ::: "memory")
#define PG8_BAR __builtin_amdgcn_s_barrier()
#define PG8_SCHED __builtin_amdgcn_sched_barrier(0)
    Unit cur, nxt; int ui = 0;
    if (!S.next(0, cur)) return;
    f32x4 acc[2][2][4][2];
#pragma unroll
    for (int a = 0; a < 2; ++a)
#pragma unroll
        for (int b = 0; b < 2; ++b)
#pragma unroll
            for (int m = 0; m < 4; ++m)
#pragma unroll
                for (int n = 0; n < 2; ++n) acc[a][b][m][n] = (f32x4){0.f, 0.f, 0.f, 0.f};
    bf16x8 At[4][2], B0[2][2], B1[2][2];
    const char* cA = (const char*)g.A + (size_t)cur.pm * tstep; const char* cB = (const char*)g.Bt + (size_t)cur.pn * tstep;
    S.a_ready(cur);
    if constexpr (SP2) {
        PG8_STAGE(PG8_SB(0, 0), cB, voffB); PG8_STAGE(PG8_SB(0, 1), cB + hstep, voffB); PG8_STAGE(PG8_SA(0, 0), cA, voffA); PG8_STAGE(PG8_SA(0, 1), cA + hstep, voffA);
        if (wr == 1) PG8_BAR;
        PG8_WAIT_V(2); PG8_BAR;
        PG8_STAGE(PG8_SB(1, 0), cB + kstep, voffB); PG8_STAGE(PG8_SA(1, 0), cA + kstep, voffA); PG8_STAGE(PG8_SB(1, 1), cB + hstep + kstep, voffB);
        PG8_WAIT_V(6); PG8_BAR;
    } else {
        PG8_STAGE(PG8_SB(0, 0), cB, voffB); PG8_STAGE(PG8_SA(0, 0), cA, voffA); PG8_STAGE(PG8_SB(0, 1), cB + hstep, voffB); PG8_STAGE(PG8_SA(0, 1), cA + hstep, voffA);
        if (wr == 1) PG8_BAR;
        PG8_WAIT_V(4); PG8_BAR;
        PG8_STAGE(PG8_SB(1, 0), cB + kstep, voffB); PG8_STAGE(PG8_SA(1, 0), cA + kstep, voffA); PG8_STAGE(PG8_SB(1, 1), cB + hstep + kstep, voffB);
        PG8_WAIT_V(6); PG8_BAR;
    }
    for (;;) {
        const bool has_next = S.next(ui + 1, nxt);
        const char* nA = has_next ? (const char*)g.A + (size_t)nxt.pm * tstep : cA; const char* nB = has_next ? (const char*)g.Bt + (size_t)nxt.pn * tstep : cB;
        for (int t = 0; t < nt; t += 2) {
            const bool last = (t == nt - 2);
            const char* a1 = cA + (size_t)(t + 1) * kstep;
            const char* a2 = last ? nA : cA + (size_t)(t + 2) * kstep; const char* b2 = last ? nB : cB + (size_t)(t + 2) * kstep;
            const char* a3 = a2 + kstep; const char* b3 = b2 + kstep;
            if (last && has_next) S.a_ready(nxt);
            if constexpr (SP2) {
            PG8_LDB(B0, 0, 0); PG8_LDB(B1, 0, 1); PG8_SCHED; PG8_LDA(At, 0, 0); PG8_STAGE(PG8_SA(1, 1), a1 + hstep, voffA);
            PG8_WAIT_V(8); PG8_WAIT_L(0); PG8_BAR; PG8_MMA(0, 0, At, B0); PG8_MMA(0, 1, At, B1); PG8_BAR; PG8_SCHED;
            PG8_LDA(At, 0, 1); PG8_STAGE(PG8_SB(0, 0), b2, voffB); PG8_STAGE(PG8_SB(0, 1), b2 + hstep, voffB); PG8_STAGE(PG8_SA(0, 0), a2, voffA);
            PG8_WAIT_V(8); PG8_WAIT_L(0); PG8_BAR; PG8_MMA(1, 0, At, B0); PG8_MMA(1, 1, At, B1); PG8_BAR; PG8_SCHED;
            PG8_LDB(B0, 1, 0); PG8_LDB(B1, 1, 1); PG8_SCHED; PG8_LDA(At, 1, 0); PG8_STAGE(PG8_SA(0, 1), a2 + hstep, voffA);
            PG8_WAIT_V(8); PG8_WAIT_L(0); PG8_BAR; PG8_MMA(0, 0, At, B0); PG8_MMA(0, 1, At, B1); PG8_BAR; PG8_SCHED;
            PG8_LDA(At, 1, 1); PG8_STAGE(PG8_SB(1, 0), b3, voffB); PG8_STAGE(PG8_SB(1, 1), b3 + hstep, voffB); PG8_STAGE(PG8_SA(1, 0), a3, voffA);
            PG8_WAIT_V(8); PG8_WAIT_L(0); PG8_BAR; PG8_MMA(1, 0, At, B0); PG8_MMA(1, 1, At, B1); PG8_BAR; PG8_SCHED;
            } else {
            PG8_LDB(B0, 0, 0); PG8_SCHED; PG8_LDA(At, 0, 0); PG8_STAGE(PG8_SA(1, 1), a1 + hstep, voffA);
            PG8_WAIT_L(8); PG8_BAR; PG8_WAIT_L(0); PG8_MMA(0, 0, At, B0); PG8_BAR; PG8_SCHED;
            PG8_LDB(B1, 0, 1); PG8_STAGE(PG8_SB(0, 0), b2, voffB);
            PG8_BAR; PG8_WAIT_L(0); PG8_MMA(0, 1, At, B1); PG8_BAR;
            PG8_LDA(At, 0, 1); PG8_STAGE(PG8_SA(0, 0), a2, voffA);
            PG8_BAR; PG8_WAIT_L(0); PG8_MMA(1, 0, At, B0); PG8_BAR; PG8_SCHED;
            PG8_STAGE(PG8_SB(0, 1), b2 + hstep, voffB);
            PG8_WAIT_V(6); PG8_BAR; PG8_MMA(1, 1, At, B1); PG8_BAR;
            PG8_LDB(B0, 1, 0); PG8_SCHED; PG8_LDA(At, 1, 0); PG8_STAGE(PG8_SA(0, 1), a2 + hstep, voffA);
            PG8_WAIT_L(8); PG8_BAR; PG8_WAIT_L(0); PG8_MMA(0, 0, At, B0); PG8_BAR; PG8_SCHED;
            PG8_LDB(B1, 1, 1); PG8_STAGE(PG8_SB(1, 0), b3, voffB);
            PG8_BAR; PG8_WAIT_L(0); PG8_MMA(0, 1, At, B1); PG8_BAR;
            PG8_LDA(At, 1, 1); PG8_STAGE(PG8_SA(1, 0), a3, voffA);
            PG8_BAR; PG8_WAIT_L(0); PG8_MMA(1, 0, At, B0); PG8_BAR; PG8_SCHED;
            PG8_STAGE(PG8_SB(1, 1), b3 + hstep, voffB);
            PG8_WAIT_V(6); PG8_BAR; PG8_MMA(1, 1, At, B1); PG8_BAR;
            }
        }
        if constexpr (ALIGN_EPI) { if (wr == 0) PG8_BAR; }
        if constexpr (!Epi::AFTER_DRAIN) { E(acc, cur, wr, wc, fr, fq);
#ifdef PROBE_DUP_EPI
            if constexpr (Epi::IDEMPOTENT) { asm volatile("" ::: "memory"); E(acc, cur, wr, wc, fr, fq); }
#endif
#ifdef PROBE_DUP_EPI8
            if constexpr (Epi::IDEMPOTENT && Epi::I8) { asm volatile("" ::: "memory"); Epi E2 = E;
#ifdef PROBE_NOSTORE
                E2.nostore = true;
#endif
                E2(acc, cur, wr, wc, fr, fq); }
#endif
            S.done(cur); }
        if (!has_next) break;
#pragma unroll
        for (int a = 0; a < 2; ++a)
#pragma unroll
            for (int b = 0; b < 2; ++b)
#pragma unroll
                for (int m = 0; m < 4; ++m)
#pragma unroll
                    for (int n = 0; n < 2; ++n) acc[a][b][m][n] = (f32x4){0.f, 0.f, 0.f, 0.f};
        cur = nxt; cA = nA; cB = nB; ++ui;
        if constexpr (ALIGN_EPI) { if (wr == 1) PG8_BAR; }
    }
    PG8_WAIT_V(0);
    if constexpr (!ALIGN_EPI) { if (wr == 0) PG8_BAR; }
    PG8_BAR;
    if constexpr (Epi::AFTER_DRAIN) { E.fused(acc, cur, wr, wc, fr, fq, lds, wid, lane); S.done(cur); }
#undef PG8_SA
#undef PG8_SB
#undef PG8_STAGE
#undef PG8_LDA
#undef PG8_LDB
#undef PG8_MMA
#undef PG8_WAIT_V
#undef PG8_WAIT_L
#undef PG8_BAR
#undef PG8_SCHED
}
}

#include <hip/hip_bf16.h>
#include <cmath>
namespace attn_body {
using bf16=__hip_bfloat16;
using bf16x8=__attribute__((ext_vector_type(8)))short;
using s16x4=__attribute__((ext_vector_type(4)))short;
using f32x16=__attribute__((ext_vector_type(16)))float;
using u32x4=__attribute__((ext_vector_type(4)))unsigned;
constexpr int BATCH=4,NHEAD=16,SEQ=8192,D=64,DM=NHEAD*D;
constexpr int QP=512,KP=512,VP=512,OP=1024;
constexpr int NW=8,QBLK=32,QB=QBLK*NW,KVBLK=64,NQB=SEQ/QB;
constexpr int ATTN_PITCH=DM, ATTN_UNIT_ROWS=QB;
__device__ __forceinline__ int crow(int r,int hi){return (r&3)+8*(r>>2)+4*hi;}
#define SBAR() __builtin_amdgcn_sched_barrier(0)
__device__ __forceinline__ void cmask(f32x16&p0,f32x16&p1,int jb,int qrel,int hi){
  const float NEG=-INFINITY; int kb=64*jb+4*hi;
  #pragma unroll
  for(int r=0;r<16;++r){int kv=kb+(r&3)+8*(r>>2); if(kv>qrel)p0[r]=NEG; if(kv+32>qrel)p1[r]=NEG;}
}

constexpr int NSLOT=3, SLOTB=8192;
constexpr int LDS_K=0, LDS_V=NSLOT*SLOTB, LDS_WS=2*NSLOT*SLOTB, LDS_OST=LDS_WS+NW*64*4, LDS_BYTES=LDS_OST+NW*4096;
constexpr float C2=0.125f*1.4426950408889634f;
__device__ __forceinline__ void glds16(const void*gsrc,unsigned lds_dst){unsigned keep;
  asm volatile("s_mov_b32 %0, m0\n\ts_mov_b32 m0, %2\n\ts_nop 0\n\tglobal_load_lds_dwordx4 %1, off\n\ts_mov_b32 m0, %0":"=&s"(keep):"v"(gsrc),"s"(lds_dst):"memory");}
__device__ __forceinline__ float max3f(float a,float b,float c){float r;asm("v_max3_f32 %0, %1, %2, %3":"=v"(r):"v"(a),"v"(b),"v"(c));return r;}
__device__ __forceinline__ float max2f(float a,float b){float r;asm("v_max_f32_e32 %0, %1, %2":"=v"(r):"v"(a),"v"(b));return r;}
__device__ __forceinline__ float fadd_s(float a,float b){float r;asm("v_add_f32_e32 %0, %1, %2":"=v"(r):"v"(a),"v"(b));return r;}
__device__ __forceinline__ float fsub_s(float a,float b){float r;asm("v_sub_f32_e32 %0, %1, %2":"=v"(r):"v"(a),"v"(b));return r;}
typedef float f32x2_t __attribute__((ext_vector_type(2))); typedef __bf16 bf16x2_t __attribute__((ext_vector_type(2)));
__device__ __forceinline__ unsigned cvtpk_s(float lo,float hi){f32x2_t v={lo,hi};bf16x2_t b=__builtin_convertvector(v,bf16x2_t);return __builtin_bit_cast(unsigned,b);}
#define WAIT_BAR(N) asm volatile("s_waitcnt vmcnt(" #N ") lgkmcnt(0)\n\ts_barrier":::"memory")

__device__ __forceinline__ void qkt(f32x16&p0,f32x16&p1,const char*Kslot,const bf16x8*qr,const f32x16&negm,int r32,int hi){
  const char*kb=Kslot+hi*1024+r32*16;
  #pragma unroll
  for(int d0=0;d0<4;++d0){
    const bf16x8 b0=*reinterpret_cast<const bf16x8*>(kb+d0*2048);
    const bf16x8 b1=*reinterpret_cast<const bf16x8*>(kb+d0*2048+512);
    if(d0==0){p0=__builtin_amdgcn_mfma_f32_32x32x16_bf16(b0,qr[0],negm,0,0,0);p1=__builtin_amdgcn_mfma_f32_32x32x16_bf16(b1,qr[0],negm,0,0,0);}
    else{p0=__builtin_amdgcn_mfma_f32_32x32x16_bf16(b0,qr[d0],p0,0,0,0);p1=__builtin_amdgcn_mfma_f32_32x32x16_bf16(b1,qr[d0],p1,0,0,0);}}
}
typedef __attribute__((address_space(3))) const char* lds_cptr;
typedef short v4i16_t __attribute__((ext_vector_type(4)));
__device__ __forceinline__ void kload8(bf16x8*kf,lds_cptr kp){
  kf[0]=*(const __attribute__((address_space(3))) bf16x8*)(kp);      kf[1]=*(const __attribute__((address_space(3))) bf16x8*)(kp+512);
  kf[2]=*(const __attribute__((address_space(3))) bf16x8*)(kp+2048); kf[3]=*(const __attribute__((address_space(3))) bf16x8*)(kp+2560);
  kf[4]=*(const __attribute__((address_space(3))) bf16x8*)(kp+4096); kf[5]=*(const __attribute__((address_space(3))) bf16x8*)(kp+4608);
  kf[6]=*(const __attribute__((address_space(3))) bf16x8*)(kp+6144); kf[7]=*(const __attribute__((address_space(3))) bf16x8*)(kp+6656);
}
__device__ __forceinline__ void kload2(bf16x8*kf,lds_cptr kp,int j){ kf[2*j]=*(const __attribute__((address_space(3))) bf16x8*)(kp+j*2048); kf[2*j+1]=*(const __attribute__((address_space(3))) bf16x8*)(kp+j*2048+512); }
__device__ __forceinline__ s16x4 vtr(lds_cptr p){ return __builtin_bit_cast(s16x4,__builtin_amdgcn_ds_read_tr16_b64_v4i16((__attribute__((address_space(3))) v4i16_t*)p)); }
__device__ __forceinline__ float rowmax(const f32x16&p0,const f32x16&p1){
  float a=max3f(p0[0],p0[1],p1[0]),b=max3f(p0[2],p0[3],p1[1]);a=max3f(a,p1[2],p1[3]);
  #pragma unroll
  for(int r=4;r<16;r+=4){a=max3f(a,p0[r],p0[r+1]);b=max3f(b,p0[r+2],p0[r+3]);a=max3f(a,p1[r],p1[r+1]);b=max3f(b,p1[r+2],p1[r+3]);}
  const float m=max2f(a,b);
  auto rr=__builtin_amdgcn_permlane32_swap(__float_as_uint(m),__float_as_uint(m),false,false);
  return max2f(__uint_as_float(rr[0]),__uint_as_float(rr[1]));
}
__device__ __forceinline__ void pv(f32x16*o,int vb,bf16x8 pa0,bf16x8 pa1,bf16x8 pa2,bf16x8 pa3){
  #pragma unroll
  for(int d0=0;d0<2;++d0){s16x4 lo[4],hi[4];
    #pragma unroll
    for(int ks=0;ks<4;++ks){
      asm volatile("ds_read_b64_tr_b16 %0,%1 offset:%c2":"=&v"(lo[ks]):"v"(vb),"i"(d0*4096+ks*1024):"memory");
      asm volatile("ds_read_b64_tr_b16 %0,%1 offset:%c2":"=&v"(hi[ks]):"v"(vb),"i"(d0*4096+ks*1024+512):"memory");}
    asm volatile("s_waitcnt lgkmcnt(0)":::"memory");SBAR();
    #define PK(k) (bf16x8){lo[k][0],lo[k][1],lo[k][2],lo[k][3],hi[k][0],hi[k][1],hi[k][2],hi[k][3]}
    o[d0]=__builtin_amdgcn_mfma_f32_32x32x16_bf16(pa0,PK(0),o[d0],0,0,0);
    o[d0]=__builtin_amdgcn_mfma_f32_32x32x16_bf16(pa1,PK(1),o[d0],0,0,0);
    o[d0]=__builtin_amdgcn_mfma_f32_32x32x16_bf16(pa2,PK(2),o[d0],0,0,0);
    o[d0]=__builtin_amdgcn_mfma_f32_32x32x16_bf16(pa3,PK(3),o[d0],0,0,0);
    #undef PK
  }
}

#ifndef ATTN_STORE16
#define ATTN_STORE16(p,v) __builtin_nontemporal_store((v),(u32x4*)(p))
#endif
template<int THRL> __device__ __forceinline__ void attn_unit(int b,int h,int qb,const bf16*Q,const bf16*__restrict__ K,const bf16*__restrict__ V,bf16*O,char*shm){
  const int tid=threadIdx.x,lane=tid&63,r32=lane&31,hi=lane>>5; const int wid=__builtin_amdgcn_readfirstlane(tid>>6);
  const long rowbase=(long)b*SEQ; const int q0=qb*QB;
  const bf16*Qw=Q+(rowbase+q0+wid*QBLK)*QP+(h>>1)*D;
  const bf16*Kh=K+rowbase*KP+(h>>1)*D,*Vh=V+rowbase*VP+(h>>2)*128+(h&1)*D;
  const unsigned lds0=(unsigned)(uintptr_t)shm;
  float*wsf=(float*)(shm+LDS_WS)+wid*64;
  const bf16*ksrc=Kh+(long)lane*KP+wid*8;
  const bf16*vsrc=Vh+(long)(16*(wid&3)+(lane>>2))*VP+(wid>>2)*32+(lane&3)*8;
  const unsigned kdst=lds0+LDS_K+wid*1024, vdst=lds0+LDS_V+wid*1024;
  #define DMA_K(t,slot) glds16(ksrc+(long)(t)*KVBLK*KP,(unsigned)__builtin_amdgcn_readfirstlane(kdst+(slot)))
  #define DMA_V(t,slot) glds16(vsrc+(long)(t)*KVBLK*VP,(unsigned)__builtin_amdgcn_readfirstlane(vdst+(slot)))
  const int vb0=(int)(lds0+LDS_V)+((lane>>4)&1)*32+(lane&3)*8+(4*hi+((lane&15)>>2))*64;
  const char*Kbase=shm+LDS_K; bf16x8 kf[8];
  const lds_cptr shm3=(lds_cptr)shm; const lds_cptr kp0=shm3+LDS_K+hi*1024+r32*16; const lds_cptr vp0=shm3+LDS_V+((lane>>4)&1)*32+(lane&3)*8+(4*hi+((lane&15)>>2))*64;
  const int NT=(q0+QB)/KVBLK;
  DMA_K(0,0);DMA_V(0,0);DMA_K(1,SLOTB);
  bf16x8 qr[4];
  #pragma unroll
  for(int d0=0;d0<4;++d0)qr[d0]=*reinterpret_cast<const bf16x8*>(&Qw[(long)r32*QP+d0*16+hi*8]);
  float mhat=0.f,l_reg=0.f;f32x16 o[2];o[0]=f32x16{};o[1]=f32x16{};f32x16 negm=f32x16{};asm volatile("":"+v"(negm));
  const int qrel=wid*QBLK+r32;
  #define CMASK(P0,P1,t) do{int jb_=(t)-(NT-4); if(jb_>=0)cmask(P0,P1,jb_,qrel,hi);}while(0)
  bool resc=false;
  #define START(P0,P1) do{ const float rm=rowmax(P0,P1); resc=false; \
    { const float dl=rm; mhat=fadd_s(mhat,dl); \
      _Pragma("unroll") for(int r=0;r<16;++r){P0[r]=fsub_s(P0[r],dl);P1[r]=fsub_s(P1[r],dl);} \
      _Pragma("unroll") for(int r=0;r<16;++r)negm[r]=-mhat; asm volatile("":"+v"(negm)); } \
    _Pragma("unroll") for(int r=0;r<16;++r)P0[r]=__builtin_amdgcn_exp2f(P0[r]); }while(0)
  #define RESC() do{ if(resc){ asm volatile("s_waitcnt lgkmcnt(0)":::"memory"); \
      _Pragma("unroll") for(int d_=0;d_<2;++d_) _Pragma("unroll") for(int r=0;r<16;++r)o[d_][r]*=wsf[crow(r,hi)]; } }while(0)
  f32x16 pA0,pA1,pB0,pB1;
  int sl_prev=0,sl_cur=0,sl_next=SLOTB;
  #define ROT() do{sl_prev=sl_cur;sl_cur=sl_next;sl_next=(sl_next==(NSLOT-1)*SLOTB)?0:sl_next+SLOTB;}while(0)
  DMA_K(2,2*SLOTB);
  WAIT_BAR(3);
  qkt(pA0,pA1,Kbase,qr,negm,r32,hi);asm volatile("s_nop 15\n\ts_nop 7":"+v"(pA0),"+v"(pA1));CMASK(pA0,pA1,0);
  START(pA0,pA1);
  _Pragma("unroll") for(int r=0;r<16;++r)pA1[r]=__builtin_amdgcn_exp2f(pA1[r]);
  WAIT_BAR(0);
  DMA_K(3,0);DMA_V(1,SLOTB);
  ROT();
  kload8(kf,kp0+sl_cur);
  WAIT_BAR(2);
  s16x4 vlo[8],vhi[8]; u32x4 pw0,pw1,pw2,pw3;
  #define PKW(P,B) cvtpk_s(P[B],P[B+1])
  #define PAF(k) __builtin_bit_cast(bf16x8,pw##k)
  #define VFR(i) (bf16x8){vlo[i][0],vlo[i][1],vlo[i][2],vlo[i][3],vhi[i][0],vhi[i][1],vhi[i][2],vhi[i][3]}
  #define PIN(x) asm volatile("":"+v"(x))
  #define MX3(a,b,c) __builtin_fmaxf(__builtin_fmaxf((a),(b)),(c))
  #define GAPA(MF,A0,A1,A2,A3,W0,W1,PW) do{ MF; sacc+=A0; sacc+=A1; sacc+=A2; sacc+=A3; PIN(sacc); W0; W1; PIN(PW); SBAR(); }while(0)
  #define EX(v) __builtin_amdgcn_exp2f(v)
  #define GAPB(MF,X,B) do{ MF; X[B]=EX(X[B]); X[B+1]=EX(X[B+1]); X[B+2]=EX(X[B+2]); X[B+3]=EX(X[B+3]); PIN(X); SBAR(); }while(0)
  #define VRD(i) do{ vlo[i]=vtr(vp_+(((i)>>2)*4096+((i)&3)*1024)); vhi[i]=vtr(vp_+(((i)>>2)*4096+((i)&3)*1024+512)); }while(0)
  #define KRD(G,j) do{ if(G){ kload2(kf,kp0+sl_next,j); SBAR(); } }while(0)
  #define STEP(C0,C1,P0,P1,t,GK,GV,GL) do{ SBAR(); \
    const lds_cptr vp_=vp0+sl_prev; \
    VRD(0); SBAR(); float sacc=(P0[0]+P0[1]); \
    GAPA(C0=__builtin_amdgcn_mfma_f32_32x32x16_bf16(kf[0],qr[0],negm,0,0,0), P0[2],P0[3],P0[4],P0[5],     pw0[0]=PKW(P0,0), pw0[1]=PKW(P0,2), pw0); \
    VRD(4); SBAR(); GAPA(C1=__builtin_amdgcn_mfma_f32_32x32x16_bf16(kf[1],qr[0],negm,0,0,0), P0[6],P0[7],P0[8],P0[9],     pw0[2]=PKW(P0,4), pw0[3]=PKW(P0,6), pw0); \
    VRD(1); SBAR(); GAPA(C0=__builtin_amdgcn_mfma_f32_32x32x16_bf16(kf[2],qr[1],C0,0,0,0),   P0[10],P0[11],P0[12],P0[13], pw1[0]=PKW(P0,8), pw1[1]=PKW(P0,10), pw1); \
    VRD(5); SBAR(); GAPA(C1=__builtin_amdgcn_mfma_f32_32x32x16_bf16(kf[3],qr[1],C1,0,0,0),   P0[14],P0[15],P1[0],P1[1],   pw1[2]=PKW(P0,12),pw1[3]=PKW(P0,14), pw1); \
    VRD(2); SBAR(); GAPA(C0=__builtin_amdgcn_mfma_f32_32x32x16_bf16(kf[4],qr[2],C0,0,0,0),   P1[2],P1[3],P1[4],P1[5],     pw2[0]=PKW(P1,0), pw2[1]=PKW(P1,2), pw2); \
    VRD(6); SBAR(); GAPA(C1=__builtin_amdgcn_mfma_f32_32x32x16_bf16(kf[5],qr[2],C1,0,0,0),   P1[6],P1[7],P1[8],P1[9],     pw2[2]=PKW(P1,4), pw2[3]=PKW(P1,6), pw2); \
    VRD(3); SBAR(); GAPA(C0=__builtin_amdgcn_mfma_f32_32x32x16_bf16(kf[6],qr[3],C0,0,0,0),   P1[10],P1[11],P1[12],P1[13], pw3[0]=PKW(P1,8), pw3[1]=PKW(P1,10), pw3); \
    VRD(7); SBAR(); GAPA(C1=__builtin_amdgcn_mfma_f32_32x32x16_bf16(kf[7],qr[3],C1,0,0,0),   P1[14],P1[15],0.f,0.f,       pw3[2]=PKW(P1,12),pw3[3]=PKW(P1,14), pw3); \
    l_reg+=sacc; \
    if(GK){DMA_K((t)+3,sl_cur);} if(GV){DMA_V((t)+1,sl_next);} \
    CMASK(C0,C1,t); \
    { float a=MX3(C0[0],C0[1],C1[0]),b=MX3(C0[2],C0[3],C1[1]); a=MX3(a,C1[2],C1[3]); \
      _Pragma("unroll") for(int r=4;r<16;r+=4){a=MX3(a,C0[r],C0[r+1]);b=MX3(b,C0[r+2],C0[r+3]);a=MX3(a,C1[r],C1[r+1]);b=MX3(b,C1[r+2],C1[r+3]);} \
      float rm=__builtin_fmaxf(a,b); { auto rr=__builtin_amdgcn_permlane32_swap(__float_as_uint(rm),__float_as_uint(rm),false,false); rm=__builtin_fmaxf(__uint_as_float(rr[0]),__uint_as_float(rr[1])); } \
      resc=false; \
      if(__builtin_expect(__any(rm>(float)THRL),0)){ const float dl=__builtin_fmaxf(rm,0.f); mhat+=dl; \
        _Pragma("unroll") for(int r=0;r<16;++r){C0[r]-=dl;C1[r]-=dl;} \
        _Pragma("unroll") for(int r=0;r<16;++r)negm[r]=-mhat; asm volatile("":"+v"(negm)); \
        const float f=__builtin_amdgcn_exp2f(-dl); l_reg*=f; if(hi==0)wsf[r32]=f; resc=true; } } \
    SBAR(); \
    GAPB(o[0]=__builtin_amdgcn_mfma_f32_32x32x16_bf16(PAF(0),VFR(0),o[0],0,0,0), C0,0); \
    GAPB(o[1]=__builtin_amdgcn_mfma_f32_32x32x16_bf16(PAF(0),VFR(4),o[1],0,0,0), C0,4); \
    KRD(GL,0); GAPB(o[0]=__builtin_amdgcn_mfma_f32_32x32x16_bf16(PAF(1),VFR(1),o[0],0,0,0), C0,8); \
    KRD(GL,1); GAPB(o[1]=__builtin_amdgcn_mfma_f32_32x32x16_bf16(PAF(1),VFR(5),o[1],0,0,0), C0,12); \
    KRD(GL,2); GAPB(o[0]=__builtin_amdgcn_mfma_f32_32x32x16_bf16(PAF(2),VFR(2),o[0],0,0,0), C1,0); \
    KRD(GL,3); GAPB(o[1]=__builtin_amdgcn_mfma_f32_32x32x16_bf16(PAF(2),VFR(6),o[1],0,0,0), C1,4); \
    GAPB(o[0]=__builtin_amdgcn_mfma_f32_32x32x16_bf16(PAF(3),VFR(3),o[0],0,0,0), C1,8); \
    GAPB(o[1]=__builtin_amdgcn_mfma_f32_32x32x16_bf16(PAF(3),VFR(7),o[1],0,0,0), C1,12); \
    }while(0)
  int t=1;
  #undef CMASK
  #define CMASK(P0,P1,t) do{}while(0)
  for(;t+5<NT;t+=2){
    STEP(pB0,pB1,pA0,pA1,t,true,true,true);     WAIT_BAR(2); RESC(); ROT();
    STEP(pA0,pA1,pB0,pB1,t+1,true,true,true);   WAIT_BAR(2); RESC(); ROT();
  }
  #undef CMASK
  #define CMASK(P0,P1,t) do{int jb_=(t)-(NT-4); if(jb_>=0)cmask(P0,P1,jb_,qrel,hi);}while(0)
  #define ENDW(tt) do{ if((tt)+3<NT){WAIT_BAR(2);} else if((tt)+2<NT){WAIT_BAR(1);} else {WAIT_BAR(0);} }while(0)
  for(;t+1<NT;t+=2){
    STEP(pB0,pB1,pA0,pA1,t,(t+3<NT),(t+1<NT),(t+1<NT));       ENDW(t);   RESC(); ROT();
    STEP(pA0,pA1,pB0,pB1,t+1,(t+4<NT),(t+2<NT),(t+2<NT));     ENDW(t+1); RESC(); ROT();
  }
  STEP(pB0,pB1,pA0,pA1,NT-1,false,false,false); RESC();
  { float sacc=pB0[0]+pB0[1]; _Pragma("unroll") for(int r=2;r<16;++r)sacc+=pB0[r]; _Pragma("unroll") for(int r=0;r<16;++r)sacc+=pB1[r]; l_reg+=sacc;
    pw0=(u32x4){PKW(pB0,0),PKW(pB0,2),PKW(pB0,4),PKW(pB0,6)};pw1=(u32x4){PKW(pB0,8),PKW(pB0,10),PKW(pB0,12),PKW(pB0,14)};pw2=(u32x4){PKW(pB1,0),PKW(pB1,2),PKW(pB1,4),PKW(pB1,6)};pw3=(u32x4){PKW(pB1,8),PKW(pB1,10),PKW(pB1,12),PKW(pB1,14)};
    SBAR(); pv(o,vb0+sl_cur,PAF(0),PAF(1),PAF(2),PAF(3)); }
  #undef PKW
  #undef PAF
  #undef VFR
  #undef PIN
  #undef MX3
  #undef GAPA
  #undef GAPB
  #undef EX
  #undef VRD
  #undef KRD
  #undef STEP
  #undef ENDW
  {auto rr=__builtin_amdgcn_permlane32_swap(__float_as_uint(l_reg),__float_as_uint(l_reg),false,false);l_reg=__uint_as_float(rr[0])+__uint_as_float(rr[1]);}
  if(hi==0)wsf[32+r32]=l_reg;asm volatile("s_waitcnt lgkmcnt(0)":::"memory");
  float rli[16];
  #pragma unroll
  for(int r=0;r<16;++r)rli[r]=__builtin_amdgcn_rcpf(wsf[32+crow(r,hi)]);
  bf16*Ow=O+(rowbase+q0+wid*QBLK)*OP+h*D;
  { bf16*stg=(bf16*)(shm+LDS_OST)+wid*2048;
    #pragma unroll
    for(int r=0;r<16;++r){const int orow=crow(r,hi);
      #pragma unroll
      for(int d0=0;d0<2;++d0)stg[orow*64+d0*32+r32]=__float2bfloat16(o[d0][r]*rli[r]);}
    asm volatile("s_waitcnt lgkmcnt(0)":::"memory");
    #pragma unroll
    for(int i=0;i<4;++i){const int row=i*8+(lane>>3),ch=lane&7; const u32x4 v=*(const u32x4*)(stg+row*64+ch*8); ATTN_STORE16(Ow+(long)row*OP+ch*8,v);} }
  asm volatile("s_waitcnt lgkmcnt(0)\n\ts_barrier":::"memory");
  #undef DMA_K
  #undef DMA_V
  #undef CMASK
  #undef START
  #undef RESC
  #undef ROT
}
constexpr int SLOTK=8192, SLOTV=16384;
constexpr int L2_K=0, L2_V=NSLOT*SLOTK, L2_WS=L2_V+NSLOT*SLOTV, L2_OST=L2_WS+NW*64*4, L2_BYTES=L2_OST+NW*4096;
__device__ __forceinline__ void pv128(f32x16*o,int vb,bf16x8 pa0,bf16x8 pa1,bf16x8 pa2,bf16x8 pa3){
  #pragma unroll
  for(int d0=0;d0<4;++d0){s16x4 lo[4],hi[4];
    #pragma unroll
    for(int ks=0;ks<4;++ks){
      asm volatile("ds_read_b64_tr_b16 %0,%1 offset:%c2":"=&v"(lo[ks]):"v"(vb),"i"(d0*4096+ks*1024):"memory");
      asm volatile("ds_read_b64_tr_b16 %0,%1 offset:%c2":"=&v"(hi[ks]):"v"(vb),"i"(d0*4096+ks*1024+512):"memory");}
    asm volatile("s_waitcnt lgkmcnt(0)":::"memory");SBAR();
    #define PK(k) (bf16x8){lo[k][0],lo[k][1],lo[k][2],lo[k][3],hi[k][0],hi[k][1],hi[k][2],hi[k][3]}
    o[d0]=__builtin_amdgcn_mfma_f32_32x32x16_bf16(pa0,PK(0),o[d0],0,0,0);
    o[d0]=__builtin_amdgcn_mfma_f32_32x32x16_bf16(pa1,PK(1),o[d0],0,0,0);
    o[d0]=__builtin_amdgcn_mfma_f32_32x32x16_bf16(pa2,PK(2),o[d0],0,0,0);
    o[d0]=__builtin_amdgcn_mfma_f32_32x32x16_bf16(pa3,PK(3),o[d0],0,0,0);
    #undef PK
  }
}
__device__ __forceinline__ void attn_unit128(int b,int hm,int qb,const bf16*Q,const bf16*__restrict__ K,const bf16*__restrict__ V,bf16*O,char*shm){
  const int tid=threadIdx.x,lane=tid&63,r32=lane&31,hi=lane>>5; const int wid=__builtin_amdgcn_readfirstlane(tid>>6);
  const long rowbase=(long)b*SEQ; const int q0=qb*QB;
  const bf16*Qw=Q+(rowbase+q0+wid*QBLK)*QP+hm*D;
  const bf16*Kh=K+rowbase*KP+hm*D,*Vh=V+rowbase*VP+(hm>>1)*128;
  const unsigned lds0=(unsigned)(uintptr_t)shm;
  float*wsf=(float*)(shm+L2_WS)+wid*64;
  const bf16*ksrc=Kh+(long)lane*KP+wid*8;
  const bf16*vsrc=Vh+(long)(16*(wid&3)+(lane>>2))*VP+(wid>>2)*32+(lane&3)*8;
  const unsigned kdst=lds0+L2_K+wid*1024, vdst=lds0+L2_V+(wid>>2)*4096+(wid&3)*1024;
  #define DMA_K(t,slot) glds16(ksrc+(long)(t)*KVBLK*KP,(unsigned)__builtin_amdgcn_readfirstlane(kdst+(slot)))
  #define DMA_V(t,slot) do{ glds16(vsrc+(long)(t)*KVBLK*VP,(unsigned)__builtin_amdgcn_readfirstlane(vdst+2*(slot))); glds16(vsrc+(long)(t)*KVBLK*VP+64,(unsigned)__builtin_amdgcn_readfirstlane(vdst+2*(slot)+8192)); }while(0)
  const int vb0=(int)(lds0+L2_V)+((lane>>4)&1)*32+(lane&3)*8+(4*hi+((lane&15)>>2))*64;
  const char*Kbase=shm+L2_K; bf16x8 kf[8];
  const lds_cptr shm3=(lds_cptr)shm; const lds_cptr kp0=shm3+L2_K+hi*1024+r32*16; const lds_cptr vp0=shm3+L2_V+((lane>>4)&1)*32+(lane&3)*8+(4*hi+((lane&15)>>2))*64;
  const int NT=(q0+QB)/KVBLK;
  DMA_K(0,0);DMA_V(0,0);DMA_K(1,SLOTK);
  bf16x8 qr[4];
  #pragma unroll
  for(int d0=0;d0<4;++d0)qr[d0]=*reinterpret_cast<const bf16x8*>(&Qw[(long)r32*QP+d0*16+hi*8]);
  float l_reg=0.f;f32x16 o[4];o[0]=f32x16{};o[1]=f32x16{};o[2]=f32x16{};o[3]=f32x16{};
  const f32x16 zero=f32x16{};
  const int qrel=wid*QBLK+r32;
  #define CMASK(P0,P1,t) do{int jb_=(t)-(NT-4); if(jb_>=0)cmask(P0,P1,jb_,qrel,hi);}while(0)
  f32x16 pA0,pA1,pB0,pB1;
  int sl_prev=0,sl_cur=0,sl_next=SLOTK;
  #define ROT() do{sl_prev=sl_cur;sl_cur=sl_next;sl_next=(sl_next==(NSLOT-1)*SLOTK)?0:sl_next+SLOTK;}while(0)
  DMA_K(2,2*SLOTK);
  WAIT_BAR(4);
  qkt(pA0,pA1,Kbase,qr,zero,r32,hi);asm volatile("s_nop 15\n\ts_nop 7":"+v"(pA0),"+v"(pA1));CMASK(pA0,pA1,0);
  _Pragma("unroll") for(int r=0;r<16;++r){pA0[r]=__builtin_amdgcn_exp2f(pA0[r]);pA1[r]=__builtin_amdgcn_exp2f(pA1[r]);}
  WAIT_BAR(0);
  DMA_K(3,0);DMA_V(1,SLOTK);
  ROT();
  kload8(kf,kp0+sl_cur);
  WAIT_BAR(3);
  s16x4 vlo[4],vhi[4]; u32x4 pw0,pw1,pw2,pw3;
  #define PKW(P,B) cvtpk_s(P[B],P[B+1])
  #define PAF(k) __builtin_bit_cast(bf16x8,pw##k)
  #define VFR(i) (bf16x8){vlo[i][0],vlo[i][1],vlo[i][2],vlo[i][3],vhi[i][0],vhi[i][1],vhi[i][2],vhi[i][3]}
  #define PIN(x) asm volatile("":"+v"(x))
  #define GAPA(MF,A0,A1,A2,A3,W0,W1,PW) do{ MF; sacc+=A0; sacc+=A1; sacc+=A2; sacc+=A3; PIN(sacc); W0; W1; PIN(PW); SBAR(); }while(0)
  #define EX(v) __builtin_amdgcn_exp2f(v)
  #define DB(j) ((((j)&1))+2*((j)>>3))
  #define KS(j) (((j)>>1)&3)
  #define VRDJ(j) do{ vlo[(j)&3]=vtr(vp_+(DB(j)*4096+KS(j)*1024)); vhi[(j)&3]=vtr(vp_+(DB(j)*4096+KS(j)*1024+512)); SBAR(); }while(0)
  #define GAPB2(j,PF,X,B) do{ o[DB(j)]=__builtin_amdgcn_mfma_f32_32x32x16_bf16(PF,VFR((j)&3),o[DB(j)],0,0,0); X[B]=EX(X[B]); X[B+1]=EX(X[B+1]); PIN(X); SBAR(); }while(0)
  #define KRD(G,j) do{ if(G){ kload2(kf,kp0+sl_next,j); SBAR(); } }while(0)
  #define MF32(a,b,c) __builtin_amdgcn_mfma_f32_32x32x16_bf16(a,b,c,0,0,0)
  #define STEP(C0,C1,P0,P1,t,GK,GV,GL) do{ SBAR(); \
    const lds_cptr vp_=vp0+2*sl_prev; \
    float sacc=(P0[0]+P0[1]); \
    GAPA(C0=MF32(kf[0],qr[0],zero), P0[2],P0[3],P0[4],P0[5],     pw0[0]=PKW(P0,0), pw0[1]=PKW(P0,2), pw0); \
    GAPA(C1=MF32(kf[1],qr[0],zero), P0[6],P0[7],P0[8],P0[9],     pw0[2]=PKW(P0,4), pw0[3]=PKW(P0,6), pw0); \
    GAPA(C0=MF32(kf[2],qr[1],C0),   P0[10],P0[11],P0[12],P0[13], pw1[0]=PKW(P0,8), pw1[1]=PKW(P0,10), pw1); \
    GAPA(C1=MF32(kf[3],qr[1],C1),   P0[14],P0[15],P1[0],P1[1],   pw1[2]=PKW(P0,12),pw1[3]=PKW(P0,14), pw1); \
    GAPA(C0=MF32(kf[4],qr[2],C0),   P1[2],P1[3],P1[4],P1[5],     pw2[0]=PKW(P1,0), pw2[1]=PKW(P1,2), pw2); \
    VRDJ(0); GAPA(C1=MF32(kf[5],qr[2],C1),   P1[6],P1[7],P1[8],P1[9],     pw2[2]=PKW(P1,4), pw2[3]=PKW(P1,6), pw2); \
    VRDJ(1); GAPA(C0=MF32(kf[6],qr[3],C0),   P1[10],P1[11],P1[12],P1[13], pw3[0]=PKW(P1,8), pw3[1]=PKW(P1,10), pw3); \
    VRDJ(2); GAPA(C1=MF32(kf[7],qr[3],C1),   P1[14],P1[15],0.f,0.f,       pw3[2]=PKW(P1,12),pw3[3]=PKW(P1,14), pw3); \
    l_reg+=sacc; \
    if(GK){DMA_K((t)+3,sl_cur);} if(GV){DMA_V((t)+1,sl_next);} \
    CMASK(C0,C1,t); \
    SBAR(); \
    GAPB2(0,PAF(0),C0,0);  VRDJ(3); \
    GAPB2(1,PAF(0),C0,2);  VRDJ(4); \
    KRD(GL,0); GAPB2(2,PAF(1),C0,4);  VRDJ(5); \
    KRD(GL,1); GAPB2(3,PAF(1),C0,6);  VRDJ(6); \
    KRD(GL,2); GAPB2(4,PAF(2),C0,8);  VRDJ(7); \
    KRD(GL,3); GAPB2(5,PAF(2),C0,10); VRDJ(8); \
    GAPB2(6,PAF(3),C0,12); VRDJ(9); \
    GAPB2(7,PAF(3),C0,14); VRDJ(10); \
    GAPB2(8,PAF(0),C1,0);  VRDJ(11); \
    GAPB2(9,PAF(0),C1,2);  VRDJ(12); \
    GAPB2(10,PAF(1),C1,4); VRDJ(13); \
    GAPB2(11,PAF(1),C1,6); VRDJ(14); \
    GAPB2(12,PAF(2),C1,8); VRDJ(15); \
    GAPB2(13,PAF(2),C1,10); \
    GAPB2(14,PAF(3),C1,12); \
    GAPB2(15,PAF(3),C1,14); \
    }while(0)
  int t=1;
  #undef CMASK
  #define CMASK(P0,P1,t) do{}while(0)
  for(;t+5<NT;t+=2){
    STEP(pB0,pB1,pA0,pA1,t,true,true,true);     WAIT_BAR(3); ROT();
    STEP(pA0,pA1,pB0,pB1,t+1,true,true,true);   WAIT_BAR(3); ROT();
  }
  #undef CMASK
  #define CMASK(P0,P1,t) do{int jb_=(t)-(NT-4); if(jb_>=0)cmask(P0,P1,jb_,qrel,hi);}while(0)
  #define ENDW(tt) do{ if((tt)+3<NT){WAIT_BAR(3);} else if((tt)+2<NT){WAIT_BAR(2);} else {WAIT_BAR(0);} }while(0)
  for(;t+1<NT;t+=2){
    STEP(pB0,pB1,pA0,pA1,t,(t+3<NT),(t+1<NT),(t+1<NT));       ENDW(t);   ROT();
    STEP(pA0,pA1,pB0,pB1,t+1,(t+4<NT),(t+2<NT),(t+2<NT));     ENDW(t+1); ROT();
  }
  STEP(pB0,pB1,pA0,pA1,NT-1,false,false,false);
  { float sacc=pB0[0]+pB0[1]; _Pragma("unroll") for(int r=2;r<16;++r)sacc+=pB0[r]; _Pragma("unroll") for(int r=0;r<16;++r)sacc+=pB1[r]; l_reg+=sacc;
    pw0=(u32x4){PKW(pB0,0),PKW(pB0,2),PKW(pB0,4),PKW(pB0,6)};pw1=(u32x4){PKW(pB0,8),PKW(pB0,10),PKW(pB0,12),PKW(pB0,14)};pw2=(u32x4){PKW(pB1,0),PKW(pB1,2),PKW(pB1,4),PKW(pB1,6)};pw3=(u32x4){PKW(pB1,8),PKW(pB1,10),PKW(pB1,12),PKW(pB1,14)};
    SBAR(); pv128(o,vb0+2*sl_cur,PAF(0),PAF(1),PAF(2),PAF(3)); }
  #undef PKW
  #undef PAF
  #undef VFR
  #undef PIN
  #undef GAPA
  #undef GAPB2
  #undef EX
  #undef VRDJ
  #undef DB
  #undef KS
  #undef KRD
  #undef MF32
  #undef STEP
  #undef ENDW
  {auto rr=__builtin_amdgcn_permlane32_swap(__float_as_uint(l_reg),__float_as_uint(l_reg),false,false);l_reg=__uint_as_float(rr[0])+__uint_as_float(rr[1]);}
  if(hi==0)wsf[32+r32]=l_reg;asm volatile("s_waitcnt lgkmcnt(0)":::"memory");
  float rli[16];
  #pragma unroll
  for(int r=0;r<16;++r)rli[r]=__builtin_amdgcn_rcpf(wsf[32+crow(r,hi)]);
  bf16*Ow=O+(rowbase+q0+wid*QBLK)*OP+hm*128;
  { bf16*stg=(bf16*)(shm+L2_OST)+wid*2048;
    #pragma unroll
    for(int dh=0;dh<2;++dh){
      #pragma unroll
      for(int r=0;r<16;++r){const int orow=crow(r,hi);
        #pragma unroll
        for(int d0=0;d0<2;++d0)stg[orow*64+d0*32+r32]=__float2bfloat16(o[2*dh+d0][r]*rli[r]);}
      asm volatile("s_waitcnt lgkmcnt(0)":::"memory");
      #pragma unroll
      for(int i=0;i<4;++i){const int row=i*8+(lane>>3),ch=lane&7; const u32x4 v=*(const u32x4*)(stg+row*64+ch*8); ATTN_STORE16(Ow+(long)row*OP+dh*64+ch*8,v);}
      asm volatile("s_waitcnt lgkmcnt(0)":::"memory"); } }
  asm volatile("s_waitcnt lgkmcnt(0)\n\ts_barrier":::"memory");
  #undef DMA_K
  #undef DMA_V
  #undef CMASK
  #undef ROT
}
struct AttnUnit128 { int bh; int qb; };
struct StaticOrder128 {
  int vcu;
  __device__ __forceinline__ explicit StaticOrder128(int grid,int block):vcu((block%8)*(grid/8)+block/8){}
#ifdef PROBE_DUP_ATTN2
  __device__ __forceinline__ bool next(int ii,AttnUnit128&u)const{ if(ii>=8)return false; const int i=ii>>1; const int s=vcu&7; u.bh=vcu>>3; u.qb=(i==0)?s:(i==1)?15-s:(i==2)?16+s:31-s; return true; }
#else
  __device__ __forceinline__ bool next(int i,AttnUnit128&u)const{ if(i>=4)return false; const int s=vcu&7; u.bh=vcu>>3; u.qb=(i==0)?s:(i==1)?15-s:(i==2)?16+s:31-s; return true; }
#endif
};
__device__ __forceinline__ void attn_phase128(char*lds,const bf16*Q,const bf16*K,const bf16*V,bf16*O,const StaticOrder128&S){
  AttnUnit128 u;
  for(int i=0;S.next(i,u);++i) attn_unit128(u.bh>>3,u.bh&7,u.qb,Q,K,V,O,lds);
}
constexpr int ATTN_LDS_BYTES=LDS_BYTES;
struct AttnTensors { const bf16* Q; const bf16* K; const bf16* V; bf16* O; };
struct AttnUnit { int bh; int qb; };
struct StaticOrder {
  int vcu;
  __device__ __forceinline__ explicit StaticOrder(int grid,int block):vcu((block%8)*(grid/8)+block/8){}
  __device__ __forceinline__ bool next(int i,AttnUnit&u)const{ if(i>=8)return false; const int s=vcu&7,j=i&3; u.bh=2*(vcu>>3)+(i>>2); u.qb=(j==0)?s:(j==1)?15-s:(j==2)?16+s:31-s; return true; }
  __device__ __forceinline__ void a_ready(const AttnUnit&)const{}
  __device__ __forceinline__ void done(const AttnUnit&)const{}
};
template<class Sched,int THRL=8> __device__ __forceinline__ void attn_phase(char*lds,const AttnTensors&T,const Sched&S){
  AttnUnit u;
  for(int i=0;S.next(i,u);++i){ S.a_ready(u); attn_unit<THRL>(u.bh/NHEAD,u.bh%NHEAD,u.qb,T.Q,T.K,T.V,T.O,lds); S.done(u); }
}
#undef SBAR
#undef WAIT_BAR
}

constexpr int NWAVES = 8;
constexpr int BATCH = 4, T = 8192, D = 1024, M = BATCH * T, DEPTH = 2;
constexpr int IN_COLS = 3088, NIN = 3328;
constexpr int NEXP = 16384;
constexpr float RMS_EPS = 1e-6f;
constexpr int NPHASE = 24;
#ifndef MK_PER_PHASE
#define MK_PER_PHASE 0
#endif

constexpr size_t MiB = 1u << 20;
constexpr size_t WS_CTL = 0, CTL_ZERO_BYTES = 1 * MiB;
constexpr size_t WS_WIN = 2 * MiB;
constexpr size_t WS_WOUT = 16 * MiB;
constexpr size_t WS_WQ = 20 * MiB;
constexpr size_t WS_SK = 28 * MiB;
constexpr size_t WS_USC = 30 * MiB, WS_VSC = 30 * MiB + 256 * 1024;
constexpr size_t WS_TU = 32 * MiB, WS_TV = 64 * MiB;
constexpr size_t WS_XN8 = 96 * MiB;
constexpr size_t WS_XN = 96 * MiB;
constexpr size_t WS_Q = 160 * MiB, WS_K = 192 * MiB, WS_DV = 224 * MiB;
constexpr size_t WS_GQ = 256 * MiB;
constexpr size_t WS_GO = 272 * MiB;
constexpr size_t WS_OI = 304 * MiB;
constexpr size_t WS_UT = 336 * MiB;
constexpr size_t WS_GK = 400 * MiB, WS_GV = 416 * MiB, WS_GLOG = 448 * MiB;
constexpr size_t WS_O = 96 * MiB;
constexpr size_t WS_RES = 336 * MiB;
constexpr size_t WS_USUM = 304 * MiB, WS_PDS = 312 * MiB;
constexpr size_t WS_Q2 = 160 * MiB;
constexpr size_t WS_IDX = 288 * MiB, WS_GATE = 304 * MiB;
constexpr size_t WS_EW8 = 320 * MiB, WS_EWSC = 324 * MiB;
constexpr size_t WS_PART = 400 * MiB;
constexpr size_t WS_SSQ = 18 * MiB;
constexpr size_t WS_AS = 29 * MiB;
constexpr size_t WS_WCS = 29 * MiB + 512 * 1024;
constexpr size_t WS_RS = 30 * MiB + 512 * 1024;
constexpr size_t WS_END = 480 * MiB;
static_assert(WS_GLOG + (size_t)M * 256 * 4 <= WS_END && WS_PART + (size_t)8 * M * 128 * 2 <= WS_END, "workspace map");
constexpr size_t WS_WQCS = 29 * MiB + 640 * 1024;
constexpr int CW_BAR = 4096;
constexpr int CW_LBAR = 13312;
constexpr size_t WS_WOCS = 29 * MiB + 576 * 1024;
constexpr size_t OUT_MIX8 = 64 * MiB, OUT_MS = 96 * MiB;
static_assert(pg8::WSO_Q == WS_Q && pg8::WSO_K == WS_K && pg8::WSO_DV == WS_DV && pg8::WSO_GQ == WS_GQ && pg8::WSO_GO == WS_GO && pg8::WSO_GK == WS_GK && pg8::WSO_GV == WS_GV && pg8::WSO_GLOG == WS_GLOG, "epilogue offsets");

constexpr int RING_OFF = 0, RING_BYTES = 131072;
constexpr int LDSCTL_OFF = RING_BYTES, MISC_OFF = LDSCTL_OFF + 320;
constexpr int LDS_BYTES = 147456;

#define GAS __attribute__((address_space(1)))
#define LAS __attribute__((address_space(3)))
typedef unsigned short bf16;
typedef unsigned v4u __attribute__((ext_vector_type(4)));
typedef unsigned v2u __attribute__((ext_vector_type(2)));
typedef float f32x4 __attribute__((ext_vector_type(4)));
typedef float f32x16 __attribute__((ext_vector_type(16)));
typedef short bf16x8 __attribute__((ext_vector_type(8)));
typedef GAS unsigned gu32;
#define RLX_AGENT __ATOMIC_RELAXED, __HIP_MEMORY_SCOPE_AGENT
#define LDS_WAIT() asm volatile("s_waitcnt lgkmcnt(0)" ::: "memory")
typedef float f32x2c __attribute__((ext_vector_type(2))); typedef __bf16 bf16x2c __attribute__((ext_vector_type(2)));
__device__ __forceinline__ unsigned pk2(float lo, float hi) { const f32x2c v = {lo, hi}; return __builtin_bit_cast(unsigned, __builtin_convertvector(v, bf16x2c)); }
__device__ __forceinline__ unsigned f2bf(float f) { return pk2(f, 0.f) & 0xffffu; }
__device__ __forceinline__ unsigned q8x4(float x0, float x1, float x2, float x3, float inv) {
    const unsigned y0 = __builtin_bit_cast(unsigned, __builtin_fmaf(x0, inv, 12582912.f)), y1 = __builtin_bit_cast(unsigned, __builtin_fmaf(x1, inv, 12582912.f));
    const unsigned y2 = __builtin_bit_cast(unsigned, __builtin_fmaf(x2, inv, 12582912.f)), y3 = __builtin_bit_cast(unsigned, __builtin_fmaf(x3, inv, 12582912.f));
    return __builtin_amdgcn_perm(y1, y0, 0x0c0c0400u) | __builtin_amdgcn_perm(y3, y2, 0x04000c0cu);
}
__device__ __forceinline__ float bf2f(unsigned short h) { return __builtin_bit_cast(float, (unsigned)h << 16); }
__device__ __forceinline__ float bflo(unsigned w) { return __builtin_bit_cast(float, w << 16); }
__device__ __forceinline__ float bfhi(unsigned w) { return __builtin_bit_cast(float, w & 0xffff0000u); }

#define XB_TMO      128
#define XB_XCNT(j)  (256  + 64 * (j))
#define XB_XSUB(j)  (1280 + 64 * (j))
#define XB_XGEN(j)  (2304 + 64 * (j))
#define XB_TOP      3328
#define XB_TOPGEN   3392
#define XCD_BAR_WORDS 3456
#define XB_SPIN_CAP (1u << 18)

__device__ __forceinline__ unsigned xb_ld(unsigned* p)              { return __hip_atomic_load(p, __ATOMIC_RELAXED, __HIP_MEMORY_SCOPE_AGENT); }
__device__ __forceinline__ unsigned xb_add(unsigned* p, unsigned v) { return __hip_atomic_fetch_add(p, v, __ATOMIC_RELAXED, __HIP_MEMORY_SCOPE_AGENT); }
__device__ __forceinline__ unsigned xb_xcc_id() { return (unsigned)__builtin_amdgcn_s_getreg((3 << 11) | 20) & 0xFu; }
#define XB_SPIN(cond, bar) do { unsigned _sp = 0; while (cond) { __builtin_amdgcn_s_sleep(1); \
    if ((++_sp & 255u) == 0u) { if (xb_ld(&(bar)[XB_TMO])) break; if (_sp > XB_SPIN_CAP) { atomicAdd(&(bar)[XB_TMO], 1u); break; } } } } while (0)

struct XcdBarrier {
    unsigned* bar; unsigned x;
    volatile LAS unsigned* st;
};

__device__ __forceinline__ XcdBarrier xcd_barrier_post(unsigned* bar, volatile LAS unsigned* st) {
    XcdBarrier b; b.bar = bar; b.x = xb_xcc_id(); b.st = st;
    if (threadIdx.x == 0) st[2] = xb_add(&bar[XB_XCNT(b.x)], 1u);
    return b;
}
__device__ __forceinline__ void xcd_barrier_complete(unsigned* bar, unsigned x, unsigned& nloc, unsigned& nx) {
    const unsigned G = gridDim.x * gridDim.y * gridDim.z;
    unsigned sum, cnt, mine, sp = 0u;
    for (;;) {
        sum = 0u; cnt = 0u; mine = 0u;
#pragma unroll
        for (unsigned j = 0; j < 16; ++j) { const unsigned c = xb_ld(&bar[XB_XCNT(j)]); sum += c; cnt += (c > 0u) ? 1u : 0u; mine = (j == x) ? c : mine; }
        if (sum == G) break;
        __builtin_amdgcn_s_sleep(1);
        if ((++sp & 255u) == 0u) { if (xb_ld(&bar[XB_TMO])) break; if (sp > XB_SPIN_CAP) { atomicAdd(&bar[XB_TMO], 1u); break; } }
    }
    nloc = mine > 0u ? mine : 1u; nx = cnt > 0u ? cnt : 1u;
}

__device__ __forceinline__ void xcd_barrier(const XcdBarrier& b) {
    asm volatile("s_waitcnt vmcnt(0)" ::: "memory");
    __syncthreads();
    if (threadIdx.x == 0) {
        unsigned* bar = b.bar;
        __builtin_amdgcn_s_waitcnt(0);
        unsigned nloc = b.st[0], nx = b.st[1];
        if (nloc == 0u) { xcd_barrier_complete(bar, b.x, nloc, nx); b.st[0] = nloc; b.st[1] = nx;
            const unsigned G = gridDim.x * gridDim.y * gridDim.z; unsigned okc = (G == 256u) ? 1u : 0u;
#pragma unroll
            for (unsigned j = 0; j < 16; ++j) { const unsigned c = xb_ld(&bar[XB_XCNT(j)]); okc &= (c == (j < 8u ? G / 8u : 0u)) ? 1u : 0u; }
            b.st[3] = okc; }
        const unsigned old = xb_add(&bar[XB_XSUB(b.x)], 1u);
        const unsigned gen = old / nloc;
        if (old + 1u == (gen + 1u) * nloc) {
            __builtin_amdgcn_fence(__ATOMIC_RELEASE, "agent");
            asm volatile("s_waitcnt vmcnt(0)" ::: "memory");
            const unsigned og = xb_add(&bar[XB_TOP], 1u);
            const unsigned tg = og / nx;
            if (og + 1u == (tg + 1u) * nx) xb_add(&bar[XB_TOPGEN], 1u);
            else XB_SPIN(xb_ld(&bar[XB_TOPGEN]) == tg, bar);
            __builtin_amdgcn_fence(__ATOMIC_ACQUIRE, "agent");
            xb_add(&bar[XB_XGEN(b.x)], 1u);
            asm volatile("s_waitcnt vmcnt(0)" ::: "memory");
        } else {
            XB_SPIN(xb_ld(&bar[XB_XGEN(b.x)]) == gen, bar);
            __builtin_amdgcn_fence(__ATOMIC_ACQUIRE, "agent");
            asm volatile("s_waitcnt vmcnt(0)" ::: "memory");
        }
    }
    __syncthreads();
}

__device__ __forceinline__ void xcd_local_barrier(const XcdBarrier& b, unsigned* lbar) {
    asm volatile("s_waitcnt vmcnt(0)" ::: "memory");
    __syncthreads();
    if (threadIdx.x == 0) {
        __builtin_amdgcn_s_waitcnt(0);
        const unsigned nloc = b.st[0], gen = b.st[4]; b.st[4] = gen + 1u;
        unsigned* ctr = &lbar[64 * b.x];
        (void)xb_add(ctr, 1u);
        const unsigned target = (gen + 1u) * nloc;
        XB_SPIN(xb_ld(ctr) < target, b.bar);
        __builtin_amdgcn_fence(__ATOMIC_ACQUIRE, "agent");
        asm volatile("s_waitcnt vmcnt(0)" ::: "memory");
    }
    __syncthreads();
}

struct Args {
    const float* in[19]; float* out; unsigned char* ws; int ph_lo, ph_hi;
};
struct Frame {
    LAS unsigned char* lds;
    int tid, lane, wave, vcu, G, bx, gw, NGW;
};
enum { I_X = 0, I_ANW, I_WIN, I_QNW, I_KNW, I_LQ1, I_LK1, I_LQ2, I_LK2, I_DONW, I_GW2, I_GB, I_GONW, I_WOUT, I_FNW, I_PWQ, I_PSK, I_PU, I_PV };
typedef const __attribute__((address_space(4))) Args* KArgs;
__device__ __forceinline__ KArgs kargs() { KArgs p = (KArgs)__builtin_amdgcn_kernarg_segment_ptr(); asm volatile("" : "+s"(p)); return p; }
__device__ __forceinline__ float row16_sum(float v) {
    v += __builtin_bit_cast(float, __builtin_amdgcn_update_dpp(0, __builtin_bit_cast(int, v), 0xB1, 0xf, 0xf, true)); v += __builtin_bit_cast(float, __builtin_amdgcn_update_dpp(0, __builtin_bit_cast(int, v), 0x4E, 0xf, 0xf, true));
    v += __builtin_bit_cast(float, __builtin_amdgcn_update_dpp(0, __builtin_bit_cast(int, v), 0x141, 0xf, 0xf, true)); v += __builtin_bit_cast(float, __builtin_amdgcn_update_dpp(0, __builtin_bit_cast(int, v), 0x140, 0xf, 0xf, true));
    return v;
}
__device__ __forceinline__ float wave_max_nn(float v) {
    v = fmaxf(v, __builtin_bit_cast(float, __builtin_amdgcn_update_dpp(0, __builtin_bit_cast(int, v), 0xB1, 0xf, 0xf, true))); v = fmaxf(v, __builtin_bit_cast(float, __builtin_amdgcn_update_dpp(0, __builtin_bit_cast(int, v), 0x4E, 0xf, 0xf, true)));
    v = fmaxf(v, __builtin_bit_cast(float, __builtin_amdgcn_update_dpp(0, __builtin_bit_cast(int, v), 0x141, 0xf, 0xf, true))); v = fmaxf(v, __builtin_bit_cast(float, __builtin_amdgcn_update_dpp(0, __builtin_bit_cast(int, v), 0x140, 0xf, 0xf, true)));
    { auto rr = __builtin_amdgcn_permlane16_swap(__float_as_uint(v), __float_as_uint(v), false, false); v = fmaxf(__uint_as_float(rr[0]), __uint_as_float(rr[1])); }
    { auto rr = __builtin_amdgcn_permlane32_swap(__float_as_uint(v), __float_as_uint(v), false, false); v = fmaxf(__uint_as_float(rr[0]), __uint_as_float(rr[1])); }
    return v;
}
__device__ __forceinline__ float wave_sum(float v) { return pg8::xsum32(pg8::xsum16(row16_sum(v))); }
__device__ __forceinline__ void p0_transpose_item(const float* W, int K, int ld, int nblk, bf16* WT, int row_off, LAS float* scr, int item, int lane, const float* kscale = nullptr) {
    const int kb = item / nblk, nb = item % nblk, k0 = 64 * kb, n0 = 32 * nb;
    float tv[32];
#pragma unroll
    for (int i = 0; i < 32; ++i) tv[i] = W[(size_t)(k0 + 2 * i + (lane >> 5)) * ld + n0 + (lane & 31)];
#pragma unroll
    for (int i = 0; i < 32; ++i) scr[(2 * i + (lane >> 5)) * 33 + (lane & 31)] = tv[i];
    LDS_WAIT(); asm volatile("" ::: "memory");
    const int c = lane & 7;
    float ks[8];
#pragma unroll
    for (int i = 0; i < 8; ++i) ks[i] = kscale ? kscale[k0 + 8 * c + i] : 1.f;
#pragma unroll
    for (int j = 0; j < 4; ++j) { const int n = (lane >> 3) + 8 * j; const LAS float* s = scr + (8 * c) * 33 + n;
        v4u o; o.x = pk2(s[0 * 33] * ks[0], s[1 * 33] * ks[1]); o.y = pk2(s[2 * 33] * ks[2], s[3 * 33] * ks[3]); o.z = pk2(s[4 * 33] * ks[4], s[5 * 33] * ks[5]); o.w = pk2(s[6 * 33] * ks[6], s[7 * 33] * ks[7]);
        *(GAS v4u*)(WT + (size_t)(row_off + n0 + n) * K + k0 + 8 * c) = o; }
    LDS_WAIT(); asm volatile("" ::: "memory");
}
__device__ __forceinline__ void rms_row_to_bf16(int lane, const float* xrow, const float* w, bf16* orow) {
    const GAS f32x4* xr = (const GAS f32x4*)xrow + lane; const GAS f32x4* wr = (const GAS f32x4*)w + lane;
    f32x4 v[4]; float s = 0.f;
#pragma unroll
    for (int j = 0; j < 4; ++j) { v[j] = xr[64 * j]; s += (v[j].x * v[j].x + v[j].y * v[j].y) + (v[j].z * v[j].z + v[j].w * v[j].w); }
    const float rs = 1.f / sqrtf(wave_sum(s) * (1.f / 1024.f) + RMS_EPS);
    GAS unsigned long long* o8 = (GAS unsigned long long*)orow + lane;
#pragma unroll
    for (int j = 0; j < 4; ++j) { const f32x4 ww = wr[64 * j]; o8[64 * j] = (unsigned long long)pk2(v[j].x * rs * ww.x, v[j].y * rs * ww.y) | ((unsigned long long)pk2(v[j].z * rs * ww.z, v[j].w * rs * ww.w) << 32); }
}
__device__ __forceinline__ void rms_regs_to_bf16(int lane, const f32x4 (&v)[4], const float* w, bf16* orow) {
    const GAS f32x4* wr = (const GAS f32x4*)w + lane; float s = 0.f;
#pragma unroll
    for (int j = 0; j < 4; ++j) s += (v[j].x * v[j].x + v[j].y * v[j].y) + (v[j].z * v[j].z + v[j].w * v[j].w);
    const float rs = 1.f / sqrtf(wave_sum(s) * (1.f / 1024.f) + RMS_EPS);
    GAS unsigned long long* o8 = (GAS unsigned long long*)orow + lane;
#pragma unroll
    for (int j = 0; j < 4; ++j) { const f32x4 ww = wr[64 * j]; o8[64 * j] = (unsigned long long)pk2(v[j].x * rs * ww.x, v[j].y * rs * ww.y) | ((unsigned long long)pk2(v[j].z * rs * ww.z, v[j].w * rs * ww.w) << 32); }
}
__device__ __forceinline__ void rms_row16_to_bf16(int lane, const bf16* xrow, const float* w, bf16* orow) {
    const v4u a = ((const GAS v4u*)(xrow + 16 * lane))[0], b = ((const GAS v4u*)(xrow + 16 * lane))[1]; const unsigned ww[8] = {a.x, a.y, a.z, a.w, b.x, b.y, b.z, b.w};
    float x[16]; float s = 0.f;
#pragma unroll
    for (int q = 0; q < 8; ++q) { x[2 * q] = bflo(ww[q]); x[2 * q + 1] = bfhi(ww[q]); s += x[2 * q] * x[2 * q] + x[2 * q + 1] * x[2 * q + 1]; }
    const float rs = 1.f / sqrtf(wave_sum(s) * (1.f / 1024.f) + RMS_EPS);
    const float* wp = w + 16 * lane; v4u oa, ob;
    oa.x = pk2(x[0] * rs * wp[0], x[1] * rs * wp[1]); oa.y = pk2(x[2] * rs * wp[2], x[3] * rs * wp[3]); oa.z = pk2(x[4] * rs * wp[4], x[5] * rs * wp[5]); oa.w = pk2(x[6] * rs * wp[6], x[7] * rs * wp[7]);
    ob.x = pk2(x[8] * rs * wp[8], x[9] * rs * wp[9]); ob.y = pk2(x[10] * rs * wp[10], x[11] * rs * wp[11]); ob.z = pk2(x[12] * rs * wp[12], x[13] * rs * wp[13]); ob.w = pk2(x[14] * rs * wp[14], x[15] * rs * wp[15]);
    ((GAS v4u*)(orow + 16 * lane))[0] = oa; ((GAS v4u*)(orow + 16 * lane))[1] = ob;
}
__device__ __forceinline__ void conv_bf16(const float* src, bf16* dst, size_t n8, size_t gtid, size_t nthr) {
    for (size_t i = gtid; i < n8; i += nthr) { const f32x4 a = ((const GAS f32x4*)src)[2 * i], b = ((const GAS f32x4*)src)[2 * i + 1];
        v4u o; o.x = pk2(a.x, a.y); o.y = pk2(a.z, a.w); o.z = pk2(b.x, b.y); o.w = pk2(b.z, b.w); ((GAS v4u*)dst)[i] = o; }
}
template <bool OFFS> __device__ __forceinline__ void quant_row(int lane, const float* src, unsigned char* dst, float* scale_out) {
    const GAS f32x4* p = (const GAS f32x4*)(src + 16 * lane); f32x4 v[4]; float am = 0.f;
#pragma unroll
    for (int j = 0; j < 4; ++j) { v[j] = p[j]; am = fmaxf(fmaxf(am, fmaxf(fabsf(v[j].x), fabsf(v[j].y))), fmaxf(fabsf(v[j].z), fabsf(v[j].w))); }
    am = wave_max_nn(am);
    const float inv = am > 0.f ? 127.f / am : 0.f; const int off = OFFS ? 128 : 0;
    v4u o4; unsigned w[4];
#pragma unroll
    for (int j = 0; j < 4; ++j) { const int b0 = (int)rintf(v[j].x * inv) + off, b1 = (int)rintf(v[j].y * inv) + off, b2 = (int)rintf(v[j].z * inv) + off, b3 = (int)rintf(v[j].w * inv) + off;
        w[j] = (unsigned)(b0 & 0xff) | ((unsigned)(b1 & 0xff) << 8) | ((unsigned)(b2 & 0xff) << 16) | ((unsigned)(b3 & 0xff) << 24); }
    o4.x = w[0]; o4.y = w[1]; o4.z = w[2]; o4.w = w[3];
    *(GAS v4u*)(dst + (size_t)(lane >> 3) * NEXP * 128 + 16 * (lane & 7)) = o4;
    if (lane == 0) *scale_out = am * (1.f / 127.f);
}
__device__ __forceinline__ void quant_row_regs(int lane, const f32x4 (&v)[4], unsigned char* dst, float* scale_out) {
    float am = 0.f;
#pragma unroll
    for (int j = 0; j < 4; ++j) am = fmaxf(fmaxf(am, fmaxf(fabsf(v[j].x), fabsf(v[j].y))), fmaxf(fabsf(v[j].z), fabsf(v[j].w)));
    am = wave_max_nn(am);
    const float inv = am > 0.f ? 127.f * __builtin_amdgcn_rcpf(am) : 0.f;
    v4u o4; unsigned w[4];
#pragma unroll
    for (int j = 0; j < 4; ++j) w[j] = q8x4(v[j].x, v[j].y, v[j].z, v[j].w, inv);
    o4.x = w[0]; o4.y = w[1]; o4.z = w[2]; o4.w = w[3];
    *(GAS v4u*)(dst + (size_t)(lane >> 3) * NEXP * 128 + 16 * (lane & 7)) = o4;
    if (lane == 0) *scale_out = am * (1.f / 127.f);
}
__device__ __forceinline__ void quant_tables(KArgs A, int layer, int gw0, int ngw, int lane, int rlo = 0, int rhi = 2 * NEXP) {
    unsigned char* const ws = A->ws;
    f32x4 wfv[4];
#pragma unroll
    for (int j = 0; j < 4; ++j) wfv[j] = ((const GAS f32x4*)(A->in[I_FNW] + layer * D + 16 * lane))[j];
    for (int r0 = rlo + gw0; r0 < rhi; r0 += 2 * ngw) {
        f32x4 va[4], vb[4]; const int r1 = r0 + ngw; const bool has1 = r1 < rhi;
        const int isv0 = r0 >= NEXP, isv1 = r1 >= NEXP; const int row0 = layer * NEXP + (isv0 ? r0 - NEXP : r0), row1 = layer * NEXP + (isv1 ? r1 - NEXP : r1);
        const GAS f32x4* p0 = (const GAS f32x4*)((isv0 ? A->in[I_PV] : A->in[I_PU]) + (size_t)row0 * D + 16 * lane); const GAS f32x4* p1 = (const GAS f32x4*)((isv1 ? A->in[I_PV] : A->in[I_PU]) + (size_t)(has1 ? row1 : row0) * D + 16 * lane);
#pragma unroll
        for (int j = 0; j < 4; ++j) { va[j] = p0[j]; vb[j] = p1[j]; }
        if (!isv0) {
#pragma unroll
            for (int j = 0; j < 4; ++j) va[j] = va[j] * wfv[j]; }
        if (!isv1) {
#pragma unroll
            for (int j = 0; j < 4; ++j) vb[j] = vb[j] * wfv[j]; }
        const size_t sl0 = ((size_t)layer * 8 * NEXP + (row0 & (NEXP - 1))) * 128, sl1 = ((size_t)layer * 8 * NEXP + (row1 & (NEXP - 1))) * 128;
        quant_row_regs(lane, va, ws + (isv0 ? WS_TV : WS_TU) + sl0, (float*)(ws + (isv0 ? WS_VSC : WS_USC)) + row0);
        if (has1) quant_row_regs(lane, vb, ws + (isv1 ? WS_TV : WS_TU) + sl1, (float*)(ws + (isv1 ? WS_VSC : WS_USC)) + row1);
    }
}
__device__ __forceinline__ void row_to_i8(int lane, const f32x4 (&v)[4], const float* w, unsigned char* dst, float* fac, float* rs_out = nullptr) {
    float x[16]; float s = 0.f;
#pragma unroll
    for (int j = 0; j < 4; ++j) { x[4 * j] = v[j].x; x[4 * j + 1] = v[j].y; x[4 * j + 2] = v[j].z; x[4 * j + 3] = v[j].w; }
#pragma unroll
    for (int i = 0; i < 16; ++i) s += x[i] * x[i];
    const float rs = __builtin_amdgcn_rsqf(wave_sum(s) * (1.f / 1024.f) + RMS_EPS);
    float am = 0.f;
#pragma unroll
    for (int i = 0; i < 16; ++i) { if (w) x[i] = x[i] * rs * w[16 * lane + i]; am = fmaxf(am, fabsf(x[i])); }
    am = wave_max_nn(am);
    const float inv = am > 0.f ? 127.f * __builtin_amdgcn_rcpf(am) : 0.f;
    unsigned q[4];
#pragma unroll
    for (int j = 0; j < 4; ++j) q[j] = q8x4(x[4 * j], x[4 * j + 1], x[4 * j + 2], x[4 * j + 3], inv);
    *(GAS v4u*)(dst + 16 * lane) = (v4u){q[0], q[1], q[2], q[3]};
    if (lane == 0) { *fac = am * (1.f / 127.f) * (w ? 1.f : rs); if (rs_out) *rs_out = rs; }
}
constexpr int P0_WBLOCKS = DEPTH * (104 + 32 + 64);
__device__ __forceinline__ void p0_wblock(KArgs A, Frame& F, int item) {
    const int lane = F.lane, w = F.wave, kh = lane >> 5, c = lane & 31;
    const bool isin = item < DEPTH * 104, isq = item >= DEPTH * (104 + 32); const int r = isin ? item : isq ? item - DEPTH * (104 + 32) : item - DEPTH * 104, l = isin ? r / 104 : isq ? r / 64 : r / 32, nb = isin ? r % 104 : isq ? r % 64 : r % 32, n = 32 * nb + c;
    LAS float* scr = (LAS float*)(F.lds + RING_OFF + w * 16384); LAS float* XCH = (LAS float*)(F.lds + RING_OFF + 7 * 16384 + 12288);
    float v[2][32];
    if (isin && nb >= 96) {
        const float* wbase = A->in[I_WIN] + (size_t)l * D * IN_COLS + 3072; const int j = n - 3072; float g2[16];
#pragma unroll
        for (int q = 0; q < 16; ++q) g2[q] = A->in[I_GW2][(size_t)l * 16 * 256 + q * 256 + j];
        { f32x4 t[8];
#pragma unroll
          for (int q = 0; q < 8; ++q) { const int e = q * 64 + lane; t[q] = *(const GAS f32x4*)(wbase + (size_t)(128 * w + (e >> 2)) * IN_COLS + 4 * (e & 3)); }
#pragma unroll
          for (int q = 0; q < 8; ++q) ((LAS f32x4*)scr)[q * 64 + lane] = t[q]; }
        LDS_WAIT(); asm volatile("" ::: "memory");
#pragma unroll
        for (int sb = 0; sb < 2; ++sb)
#pragma unroll
            for (int i = 0; i < 32; ++i) { const LAS f32x4* wr = (const LAS f32x4*)scr + (64 * sb + 2 * i + kh) * 4; float s = 0.f;
#pragma unroll
                for (int q = 0; q < 4; ++q) { const f32x4 w4 = wr[q]; s += w4.x * g2[4 * q] + w4.y * g2[4 * q + 1] + w4.z * g2[4 * q + 2] + w4.w * g2[4 * q + 3]; }
                v[sb][i] = s; if ((i & 3) == 3) __builtin_amdgcn_sched_barrier(0); }
        LDS_WAIT(); asm volatile("" ::: "memory");
    } else {
        const float* src = isin ? A->in[I_WIN] + (size_t)l * D * IN_COLS + n : isq ? A->in[I_PWQ] + (size_t)l * D * 2048 + n : A->in[I_WOUT] + (size_t)l * D * D + n; const size_t ld = isin ? IN_COLS : isq ? 2048 : D;
#pragma unroll
        for (int sb = 0; sb < 2; ++sb)
#pragma unroll
            for (int i = 0; i < 32; ++i) v[sb][i] = src[(size_t)(128 * w + 64 * sb + 2 * i + kh) * ld];
    }
    if ((isin && l > 0) || isq) { const float* an = (isq ? A->in[I_FNW] : A->in[I_ANW]) + l * D + 128 * w + kh;
#pragma unroll
        for (int sb = 0; sb < 2; ++sb)
#pragma unroll
            for (int i = 0; i < 32; ++i) v[sb][i] *= an[64 * sb + 2 * i];
    }
    float am = 0.f;
#pragma unroll
    for (int sb = 0; sb < 2; ++sb)
#pragma unroll
        for (int i = 0; i < 32; ++i) am = fmaxf(am, fabsf(v[sb][i]));
    { auto rr = __builtin_amdgcn_permlane32_swap(__float_as_uint(am), __float_as_uint(am), false, false); am = fmaxf(__uint_as_float(rr[0]), __uint_as_float(rr[1])); }
    if (kh == 0) XCH[w * 32 + c] = am;
    __syncthreads();
    float cm = 0.f;
#pragma unroll
    for (int q = 0; q < 8; ++q) cm = fmaxf(cm, XCH[q * 32 + c]);
    __syncthreads();
    const float inv = cm > 0.f ? 127.f / cm : 0.f;
    if (w == 0 && kh == 0) (isin ? (float*)(A->ws + WS_WCS) + l * NIN : isq ? (float*)(A->ws + WS_WQCS) + l * 2048 : (float*)(A->ws + WS_WOCS) + l * D)[n] = cm * (1.f / 127.f);
    unsigned char* WT = isin ? A->ws + WS_WIN + ((size_t)l * NIN + pg8::inproj_phys_row(32 * nb)) * D : isq ? A->ws + WS_WQ + ((size_t)l * 2048 + 32 * nb) * D : A->ws + WS_WOUT + ((size_t)l * D + 32 * nb) * D;
    LAS int* sq = (LAS int*)scr;
#pragma unroll
    for (int sb = 0; sb < 2; ++sb) {
#pragma unroll
        for (int i = 0; i < 32; ++i) sq[(2 * i + kh) * 33 + c] = (int)rintf(v[sb][i] * inv);
        LDS_WAIT(); asm volatile("" ::: "memory");
        { const int nn = lane >> 1, hf = lane & 1; unsigned q[8];
#pragma unroll
          for (int j = 0; j < 8; ++j) { const LAS int* s = sq + (32 * hf + 4 * j) * 33 + nn; q[j] = (unsigned)(s[0] & 0xff) | ((unsigned)(s[33] & 0xff) << 8) | ((unsigned)(s[66] & 0xff) << 16) | ((unsigned)(s[99] & 0xff) << 24); }
          unsigned char* dst = WT + (size_t)nn * D + 128 * w + 64 * sb + 32 * hf;
          ((GAS v4u*)dst)[0] = (v4u){q[0], q[1], q[2], q[3]}; ((GAS v4u*)dst)[1] = (v4u){q[4], q[5], q[6], q[7]}; }
        LDS_WAIT(); asm volatile("" ::: "memory");
    }
}
__device__ __forceinline__ void p0_prologue(Frame& F) {
    KArgs A = kargs(); unsigned char* const ws = A->ws;
    LAS float* scr = (LAS float*)(F.lds + RING_OFF + F.wave * 16384);
    for (int item = F.bx; item < P0_WBLOCKS; item += F.G) p0_wblock(A, F, item);
    const size_t gtid = (size_t)F.gw * 64 + F.lane, nthr = (size_t)F.NGW * 64;
    conv_bf16(A->in[I_PSK], (bf16*)(ws + WS_SK), (size_t)DEPTH * 8 * 2 * 128 * 128 / 8, gtid, nthr);
    const int NX = (F.G & 7) == 0 ? 8 : 1, XI = F.bx % NX, RX = M / NX, xw = (F.bx / NX) * NWAVES + F.wave, WX = (F.G / NX) * NWAVES;
    for (int m = RX * XI + xw; m < RX * (XI + 1); m += 2 * WX) {
        const int m1 = m + WX < RX * (XI + 1) ? m + WX : m;
        const GAS f32x4* xa = (const GAS f32x4*)(A->in[I_X] + (size_t)m * D + 16 * F.lane); const GAS f32x4* xb = (const GAS f32x4*)(A->in[I_X] + (size_t)m1 * D + 16 * F.lane);
        f32x4 va[4], vb[4];
#pragma unroll
        for (int j = 0; j < 4; ++j) { va[j] = xa[j]; vb[j] = xb[j]; }
        row_to_i8(F.lane, va, A->in[I_ANW], ws + WS_XN8 + (size_t)m * D, (float*)(ws + WS_AS) + m);
        if (m1 != m) row_to_i8(F.lane, vb, A->in[I_ANW], ws + WS_XN8 + (size_t)m1 * D, (float*)(ws + WS_AS) + m1);
    }
}

__device__ __forceinline__ f32x4 mma16_k64(const LAS bf16* A, int lda, const LAS bf16* B, int ldb, int lane) {
    f32x4 acc = {0.f, 0.f, 0.f, 0.f};
    const LAS bf16* ap = A + (lane & 15) * lda + 8 * (lane >> 4); const LAS bf16* bp = B + (lane & 15) * ldb + 8 * (lane >> 4);
#pragma unroll
    for (int kk = 0; kk < 2; ++kk) { const bf16x8 a = *(const LAS bf16x8*)(ap + kk * 32), b = *(const LAS bf16x8*)(bp + kk * 32); acc = __builtin_amdgcn_mfma_f32_16x16x32_bf16(a, b, acc, 0, 0, 0); }
    return acc;
}
constexpr int LP = 72;
__device__ __forceinline__ void diff_rows(Frame& F, int l) {
    KArgs A = kargs(); unsigned char* const ws = A->ws;
    const int lane = F.lane;
    const float lam_init = 0.8f - 0.6f * expf(-0.3f * (float)l);
    const float s1 = wave_sum(A->in[I_LQ1][l * 64 + lane] * A->in[I_LK1][l * 64 + lane]), s2 = wave_sum(A->in[I_LQ2][l * 64 + lane] * A->in[I_LK2][l * 64 + lane]);
    const float lam = expf(s1) - expf(s2) + lam_init;
    const int hh = lane >> 4, c0 = 8 * (lane & 15);
    float wv[8];
#pragma unroll
    for (int i = 0; i < 8; ++i) wv[i] = A->in[I_DONW][l * 128 + c0 + i] * (1.f - lam_init);
    const bf16* O = (const bf16*)(ws + WS_O); const bf16* MIX = (const bf16*)A->out;
    unsigned char* MIX8 = (unsigned char*)A->out + OUT_MIX8; float* MS = (float*)((unsigned char*)A->out + OUT_MS);
    const int NX = (F.G & 7) == 0 ? 8 : 1, XI = F.bx % NX, RX = M / NX, xw = (F.bx / NX) * NWAVES + F.wave, WX = (F.G / NX) * NWAVES;
    const int tend = RX * (XI + 1), tstep = 4 * WX;
    v4u a[4], b[4], g[4];
#define DR_LOAD(A_, B_, G_, T_) do { _Pragma("unroll") for (int j = 0; j < 4; ++j) { const bf16* orow = O + (size_t)((T_) + j) * 1024 + 256 * hh + c0; \
            A_[j] = *(const GAS v4u*)orow; B_[j] = *(const GAS v4u*)(orow + 128); G_[j] = *(const GAS v4u*)(MIX + (size_t)((T_) + j) * 1024 + 512 + 8 * lane); } } while (0)
    int t0 = RX * XI + 4 * xw;
    if (t0 < tend) DR_LOAD(a, b, g, t0);
    for (; t0 < tend; t0 += tstep) {
        const bool hn = t0 + tstep < tend; v4u an[4], bn[4], gn[4];
        if (hn) DR_LOAD(an, bn, gn, t0 + tstep);
#pragma unroll
        for (int j = 0; j < 4; ++j) {
            const unsigned aw[4] = {a[j].x, a[j].y, a[j].z, a[j].w}, bw[4] = {b[j].x, b[j].y, b[j].z, b[j].w}, gw[4] = {g[j].x, g[j].y, g[j].z, g[j].w};
            float d[8], gv[8]; float ss = 0.f;
#pragma unroll
            for (int i = 0; i < 4; ++i) { d[2 * i] = bflo(aw[i]) - lam * bflo(bw[i]); d[2 * i + 1] = bfhi(aw[i]) - lam * bfhi(bw[i]); ss += d[2 * i] * d[2 * i] + d[2 * i + 1] * d[2 * i + 1]; gv[2 * i] = bflo(gw[i]); gv[2 * i + 1] = bfhi(gw[i]); }
            const float rs = __builtin_amdgcn_rsqf(row16_sum(ss) * (1.f / 128.f) + RMS_EPS);
            float am = 0.f;
#pragma unroll
            for (int i = 0; i < 8; ++i) { d[i] = d[i] * rs * wv[i]; am = fmaxf(am, fmaxf(fabsf(d[i]), fabsf(gv[i]))); }
            am = wave_max_nn(am);
            const float inv = am > 0.f ? 127.f * __builtin_amdgcn_rcpf(am) : 0.f;
            unsigned wd[2], wg[2];
#pragma unroll
            for (int q = 0; q < 2; ++q) {
                wd[q] = q8x4(d[4 * q], d[4 * q + 1], d[4 * q + 2], d[4 * q + 3], inv); wg[q] = q8x4(gv[4 * q], gv[4 * q + 1], gv[4 * q + 2], gv[4 * q + 3], inv); }
            unsigned char* mrow = MIX8 + (size_t)(t0 + j) * 1024;
            *(GAS v2u*)(mrow + 128 * hh + c0) = (v2u){wd[0], wd[1]};
            *(GAS v2u*)(mrow + 512 + 8 * lane) = (v2u){wg[0], wg[1]};
            if (lane == 0) MS[t0 + j] = am * (1.f / 127.f);
        }
        if (hn) {
#pragma unroll
            for (int j = 0; j < 4; ++j) { a[j] = an[j]; b[j] = bn[j]; g[j] = gn[j]; } }
    }
#undef DR_LOAD
}
namespace psel {
constexpr int cand_count() { int n = 0; for (int a = 0; a < 16; ++a) for (int b = 0; b < 16; ++b) if ((a + 1) * (b + 1) <= 16) ++n; return n; }
static_assert(cand_count() == 50, "candidate frontier");
constexpr int cand_ab(int idx) { int n = 0; for (int a = 0; a < 16; ++a) for (int b = 0; b < 16; ++b) if ((a + 1) * (b + 1) <= 16) { if (n == idx) return a * 16 + b; ++n; } return 0; }
__device__ __forceinline__ float pmax32(float m) { auto rr = __builtin_amdgcn_permlane32_swap(__float_as_uint(m), __float_as_uint(m), false, false); return fmaxf(__uint_as_float(rr[0]), __uint_as_float(rr[1])); }
__device__ __forceinline__ void ce_desc(float& a, float& b) { const float hi = fmaxf(a, b), lo = fminf(a, b); a = hi; b = lo; }
constexpr unsigned char OE16[63][2] = {{0, 1}, {2, 3}, {0, 2}, {1, 3}, {1, 2}, {4, 5}, {6, 7}, {4, 6}, {5, 7}, {5, 6}, {0, 4}, {2, 6}, {2, 4}, {1, 5}, {3, 7}, {3, 5}, {1, 2}, {3, 4}, {5, 6}, {8, 9}, {10, 11}, {8, 10}, {9, 11}, {9, 10}, {12, 13}, {14, 15}, {12, 14}, {13, 15}, {13, 14}, {8, 12}, {10, 14}, {10, 12}, {9, 13}, {11, 15}, {11, 13}, {9, 10}, {11, 12}, {13, 14}, {0, 8}, {4, 12}, {4, 8}, {2, 10}, {6, 14}, {6, 10}, {2, 4}, {6, 8}, {10, 12}, {1, 9}, {5, 13}, {5, 9}, {3, 11}, {7, 15}, {7, 11}, {3, 5}, {7, 9}, {11, 13}, {1, 2}, {3, 4}, {5, 6}, {7, 8}, {9, 10}, {11, 12}, {13, 14}};
template <int OFF, int NA> __device__ __forceinline__ void sort16_desc(float (&v)[NA]) {
#pragma unroll
    for (int i = 0; i < 63; ++i) ce_desc(v[OFF + OE16[i][0]], v[OFF + OE16[i][1]]);
}
template <int OFF, int NA> __device__ __forceinline__ void merge16_desc(float (&v)[NA]) {
#pragma unroll
    for (int lj = 3; lj >= 0; --lj)
#pragma unroll
        for (int i = 0; i < 16; ++i) { const int l = i ^ (1 << lj); if (l > i) ce_desc(v[OFF + i], v[OFF + l]); }
}
template <int A, int B, int NA> __device__ __forceinline__ void top16_merge(float (&v)[NA]) {
#pragma unroll
    for (int i = 0; i < 16; ++i) v[A + i] = fmaxf(v[A + i], v[B + 15 - i]);
    merge16_desc<A, NA>(v);
}
template <int NA> __device__ __forceinline__ void top16_cross(float (&v)[NA], float (&out)[16]) {
    float lo[16], hi[16];
#pragma unroll
    for (int i = 0; i < 16; ++i) { auto rr = __builtin_amdgcn_permlane32_swap(__float_as_uint(v[i]), __float_as_uint(v[i]), false, false); lo[i] = __uint_as_float(rr[0]); hi[i] = __uint_as_float(rr[1]); }
#pragma unroll
    for (int i = 0; i < 16; ++i) out[i] = fmaxf(lo[i], hi[15 - i]);
    merge16_desc<0, 16>(out);
}
__device__ __forceinline__ void top16_of_128(float (&sc)[64], float (&out)[16]) {
    sort16_desc<0, 64>(sc); sort16_desc<16, 64>(sc); sort16_desc<32, 64>(sc); sort16_desc<48, 64>(sc);
    top16_merge<0, 16, 64>(sc); top16_merge<32, 48, 64>(sc); top16_merge<0, 32, 64>(sc);
    top16_cross<64>(sc, out);
}
template <int S> __device__ __forceinline__ void cand_one(float (&cand)[25], const float (&v0)[16], const float (&v1)[16], bool hi) {
    constexpr int ab0 = cand_ab(2 * S), ab1 = cand_ab(2 * S + 1);
    const float s0 = v0[ab0 >> 4] + v1[ab0 & 15], s1 = v0[ab1 >> 4] + v1[ab1 & 15];
    const float s = hi ? s1 : s0; const unsigned id = hi ? (unsigned)ab1 : (unsigned)ab0;
    cand[S] = __uint_as_float((__float_as_uint(s) & ~0xFFu) | id);
}
template <int... S> __device__ __forceinline__ void cand_all(float (&cand)[25], const float (&v0)[16], const float (&v1)[16], bool hi, std::integer_sequence<int, S...>) { (cand_one<S>(cand, v0, v1, hi), ...); }
__device__ __forceinline__ unsigned lookup7(const unsigned (&tab)[4], unsigned a) {
    const unsigned sel = 0x0c0c0c00u | (a & 7u); const unsigned lo = __builtin_amdgcn_perm(tab[1], tab[0], sel), hi = __builtin_amdgcn_perm(tab[3], tab[2], sel); return (a & 8u) ? hi : lo; }
}
__device__ __forceinline__ void peer_select(Frame& F, int l) {
    KArgs A = kargs(); unsigned char* const ws = A->ws;
    const int lane = F.lane, r32 = lane & 31, hi = lane >> 5;
    const bf16* Q2 = (const bf16*)(ws + WS_Q2); const bf16* SK = (const bf16*)(ws + WS_SK) + (size_t)l * 8 * 2 * 128 * 128;
    unsigned short* IDX = (unsigned short*)(ws + WS_IDX); float* GATE = (float*)(ws + WS_GATE);
    const bool aff = F.G == 256; const int h = aff ? (F.bx >> 3) & 7 : F.bx & 7, jb = F.bx >> 3; constexpr int KP = 136;
    LAS bf16* KL = (LAS bf16*)F.lds;
#pragma unroll
    for (int i = 0; i < 8; ++i) { const int p = F.tid + 512 * i, row = p >> 4, j = p & 15; *(LAS v4u*)(KL + row * KP + 8 * j) = *(const GAS v4u*)(SK + ((size_t)h * 256 + row) * 128 + 8 * j); }
    __syncthreads();
    const int tg0 = aff ? 128 * (F.bx & 7) + 32 * (F.bx >> 6) + F.wave : jb * 8 + F.wave, tg1 = aff ? 128 * (F.bx & 7) + 32 * (F.bx >> 6) + 32 : M / 32, tgs = aff ? 8 : (F.G >> 3) * 8;
    for (int tg = tg0; tg < tg1; tg += tgs) {
        const size_t tok = (size_t)tg * 32 + r32;
        bf16x8 bq[2][8];
#pragma unroll
        for (int c = 0; c < 2; ++c)
#pragma unroll
            for (int ks = 0; ks < 8; ++ks) bq[c][ks] = *(const GAS bf16x8*)(Q2 + tok * 2048 + (h * 2 + c) * 128 + ks * 16 + 8 * hi);
        float ts[2][16];
#pragma unroll
        for (int c = 0; c < 2; ++c) {
            f32x16 acc[4];
#pragma unroll
            for (int mt = 0; mt < 4; ++mt) acc[mt] = f32x16{};
            const LAS bf16* kp = KL + (c * 128 + r32) * KP + 8 * hi;
#pragma unroll
            for (int ks = 0; ks < 8; ++ks)
#pragma unroll
                for (int mt = 0; mt < 4; ++mt) { const bf16x8 ak = *(const LAS bf16x8*)(kp + mt * 32 * KP + ks * 16); acc[mt] = __builtin_amdgcn_mfma_f32_32x32x16_bf16(ak, bq[c][ks], acc[mt], 0, 0, 0); }
            float sc[64];
#pragma unroll
            for (int mt = 0; mt < 4; ++mt)
#pragma unroll
                for (int r = 0; r < 16; ++r) { const unsigned key = (unsigned)(32 * mt + (r & 3) + 8 * (r >> 2) + 4 * hi); sc[mt * 16 + r] = __uint_as_float((__float_as_uint(acc[mt][r]) & ~0x7Fu) | key); }
            __builtin_amdgcn_sched_barrier(0);
            psel::top16_of_128(sc, ts[c]);
            __builtin_amdgcn_sched_barrier(0);
        }
        unsigned kt0[4], kt1[4]; float v0[16], v1[16];
#pragma unroll
        for (int q = 0; q < 4; ++q) { kt0[q] = 0u; kt1[q] = 0u;
#pragma unroll
            for (int j = 0; j < 4; ++j) { kt0[q] |= (__float_as_uint(ts[0][4 * q + j]) & 0x7Fu) << (8 * j); kt1[q] |= (__float_as_uint(ts[1][4 * q + j]) & 0x7Fu) << (8 * j); } }
#pragma unroll
        for (int i = 0; i < 16; ++i) { v0[i] = __uint_as_float(__float_as_uint(ts[0][i]) & ~0x7Fu); v1[i] = __uint_as_float(__float_as_uint(ts[1][i]) & ~0x7Fu); }
        float cand[25];
        psel::cand_all(cand, v0, v1, hi != 0, std::make_integer_sequence<int, 25>{});
        float c32[32];
#pragma unroll
        for (int i = 0; i < 25; ++i) c32[i] = cand[i];
#pragma unroll
        for (int i = 25; i < 32; ++i) c32[i] = -INFINITY;
        psel::sort16_desc<0, 32>(c32); psel::sort16_desc<16, 32>(c32); psel::top16_merge<0, 16, 32>(c32);
        float best[16];
        psel::top16_cross<32>(c32, best);
        int ex[16];
#pragma unroll
        for (int k = 0; k < 16; ++k) { const unsigned bb = __float_as_uint(best[k]); ex[k] = (int)(psel::lookup7(kt0, (bb >> 4) & 15u) * 128u + psel::lookup7(kt1, bb & 15u)); }
        if (hi == 0) { GAS v4u* o = (GAS v4u*)(IDX + tok * 128 + h * 16);
#pragma unroll
            for (int q = 0; q < 2; ++q) o[q] = (v4u){(unsigned)ex[8 * q] | ((unsigned)ex[8 * q + 1] << 16), (unsigned)ex[8 * q + 2] | ((unsigned)ex[8 * q + 3] << 16), (unsigned)ex[8 * q + 4] | ((unsigned)ex[8 * q + 5] << 16), (unsigned)ex[8 * q + 6] | ((unsigned)ex[8 * q + 7] << 16)}; }
        else {
            float mx = __uint_as_float(__float_as_uint(best[0]) & ~0xFFu); float g[16]; float sum = 0.f;
#pragma unroll
            for (int k = 0; k < 16; ++k) { g[k] = __expf(__uint_as_float(__float_as_uint(best[k]) & ~0xFFu) - mx); sum += g[k]; }
            const float inv = __builtin_amdgcn_rcpf(sum); GAS f32x4* o = (GAS f32x4*)(GATE + tok * 128 + h * 16);
#pragma unroll
            for (int q = 0; q < 4; ++q) o[q] = (f32x4){g[4 * q] * inv, g[4 * q + 1] * inv, g[4 * q + 2] * inv, g[4 * q + 3] * inv}; }
    }
}
__device__ __forceinline__ float gelu_erf(float x) { return 0.5f * x * (1.f + erff(x * 0.70710678118654752f)); }
__device__ __forceinline__ float dppf(float v, const int ctrl_sel) {
    const int x = __builtin_bit_cast(int, v);
    int r;
    if (ctrl_sel == 0) r = __builtin_amdgcn_update_dpp(0, x, 0xB1, 0xf, 0xf, true);
    else if (ctrl_sel == 1) r = __builtin_amdgcn_update_dpp(0, x, 0x4E, 0xf, 0xf, true);
    else if (ctrl_sel == 2) r = __builtin_amdgcn_update_dpp(0, x, 0x141, 0xf, 0xf, true);
    else r = __builtin_amdgcn_update_dpp(0, x, 0x128, 0xf, 0xf, true);
    return __builtin_bit_cast(float, r);
}
__device__ __forceinline__ float swap_add32(float a, float b) { auto rr = __builtin_amdgcn_permlane32_swap(__float_as_uint(a), __float_as_uint(b), false, false); return __uint_as_float(rr[0]) + __uint_as_float(rr[1]); }
__device__ __forceinline__ float swap_add16(float a, float b) { auto rr = __builtin_amdgcn_permlane16_swap(__float_as_uint(a), __float_as_uint(b), false, false); return __uint_as_float(rr[0]) + __uint_as_float(rr[1]); }
__device__ __forceinline__ float reduce8(const float (&p)[8], int lane) {
    const float r0 = swap_add32(p[0], p[4]), r1 = swap_add32(p[1], p[5]), r2 = swap_add32(p[2], p[6]), r3 = swap_add32(p[3], p[7]);
    const float s0 = swap_add16(r0, r2), s1 = swap_add16(r1, r3);
    const bool b3 = (lane & 8) != 0;
    const float keep = b3 ? s1 : s0, send = b3 ? s0 : s1;
    float z = keep + dppf(send, 3);
    z += dppf(z, 0); z += dppf(z, 1); z += dppf(z, 2);
    return z;
}
__device__ __forceinline__ float ub(unsigned w, int k) { return (float)((w >> (8 * k)) & 0xffu); }
constexpr int PEER_TG = 4, PEER_NGRP = M / PEER_TG;
constexpr int CW_PEER = 8192;
__device__ __forceinline__ int peer_dequeue(gu32* ctr, int lane) {
    unsigned v = 0u; if (lane == 0) v = __hip_atomic_fetch_add(ctr, 1u, __ATOMIC_RELAXED, __HIP_MEMORY_SCOPE_AGENT);
    return __builtin_amdgcn_readfirstlane((int)v);
}
__device__ __forceinline__ unsigned peer_dequeue_issue(gu32* ctr, int lane) { unsigned v = 0u, off = 0u; asm volatile("" : "+v"(off));
    if (lane == 0) v = __hip_atomic_fetch_add(ctr + off, 1u, __ATOMIC_RELAXED, __HIP_MEMORY_SCOPE_AGENT); return v; }
__device__ __forceinline__ int peer_dequeue_get(unsigned v) { asm volatile("" : "+v"(v) :: "memory"); return __builtin_amdgcn_readfirstlane((int)v); }
struct HalfBuf { v4u p[8]; };
struct IdSet { v4u id[2]; };
struct TokAux { v4u a[2]; };
__device__ __forceinline__ void ps_ids(IdSet& I, const unsigned short* idrow) {
#pragma unroll
    for (int q = 0; q < 2; ++q) I.id[q] = ((const GAS v4u*)idrow)[q];
}
template <int HALF_> __device__ __forceinline__ void ps_gather(HalfBuf& B, const unsigned char* tab_slice, const IdSet& I, int c) {
    const unsigned c16 = 16u * (unsigned)c;
#pragma unroll
    for (int i = 0; i < 8; ++i) { const unsigned w = I.id[HALF_][i >> 1]; const unsigned e = (i & 1) ? w >> 16 : w & 0xffffu; B.p[i] = *(const GAS v4u*)(tab_slice + (e * 128u + c16)); }
}
__device__ __forceinline__ int dppi(int x, const int sel) {
    if (sel == 0) return __builtin_amdgcn_update_dpp(0, x, 0xB1, 0xf, 0xf, true);
    if (sel == 1) return __builtin_amdgcn_update_dpp(0, x, 0x4E, 0xf, 0xf, true);
    return __builtin_amdgcn_update_dpp(0, x, 0x141, 0xf, 0xf, true);
}
struct UState { int hq[4]; float sc; };
template <int HALF_> __device__ __forceinline__ void ps_compute_u(const HalfBuf& B, const TokAux& X, UState& U, bf16* part_row, int g, int c) {
    if (HALF_ == 0) { U.hq[0] = (int)X.a[0].x; U.hq[1] = (int)X.a[0].y; U.hq[2] = (int)X.a[0].z; U.hq[3] = (int)X.a[0].w; U.sc = __uint_as_float(X.a[1].x); }
    int d[8];
#pragma unroll
    for (int i = 0; i < 8; ++i) { int x = __builtin_amdgcn_sdot4((int)B.p[i].x, U.hq[0], 0, false); x = __builtin_amdgcn_sdot4((int)B.p[i].y, U.hq[1], x, false);
        x = __builtin_amdgcn_sdot4((int)B.p[i].z, U.hq[2], x, false); x = __builtin_amdgcn_sdot4((int)B.p[i].w, U.hq[3], x, false);
        x += dppi(x, 0); x += dppi(x, 1); x += dppi(x, 2); d[i] = x; }
    const float sc = U.sc;
    if (c == 0) *(GAS v4u*)(part_row + 16 * g + 8 * HALF_) = (v4u){pk2((float)d[0] * sc, (float)d[1] * sc), pk2((float)d[2] * sc, (float)d[3] * sc), pk2((float)d[4] * sc, (float)d[5] * sc), pk2((float)d[6] * sc, (float)d[7] * sc)};
}
struct VState { int acc[16]; };
template <int HALF_, bool LAST> __device__ __forceinline__ void ps_compute_v(const HalfBuf& B, const TokAux& X, VState& S, const bf16* res_cols, bf16* res_w, float* out_cols  , int lane) {
    if (HALF_ == 0) {
#pragma unroll
        for (int j = 0; j < 16; ++j) S.acc[j] = 0; }
    const unsigned wq[4] = {X.a[0].x, X.a[0].y, X.a[0].z, X.a[0].w};
#pragma unroll
    for (int q = 0; q < 2; ++q) {
        const unsigned pa[4] = {B.p[4 * q].x, B.p[4 * q].y, B.p[4 * q].z, B.p[4 * q].w}, pb[4] = {B.p[4 * q + 1].x, B.p[4 * q + 1].y, B.p[4 * q + 1].z, B.p[4 * q + 1].w};
        const unsigned pc[4] = {B.p[4 * q + 2].x, B.p[4 * q + 2].y, B.p[4 * q + 2].z, B.p[4 * q + 2].w}, pd[4] = {B.p[4 * q + 3].x, B.p[4 * q + 3].y, B.p[4 * q + 3].z, B.p[4 * q + 3].w};
        const int wv = (int)wq[2 * HALF_ + q];
#pragma unroll
        for (int p = 0; p < 4; ++p) {
            const unsigned ab_lo = __builtin_amdgcn_perm(pb[p], pa[p], 0x05010400u), ab_hi = __builtin_amdgcn_perm(pb[p], pa[p], 0x07030602u);
            const unsigned cd_lo = __builtin_amdgcn_perm(pd[p], pc[p], 0x05010400u), cd_hi = __builtin_amdgcn_perm(pd[p], pc[p], 0x07030602u);
            const unsigned t0 = __builtin_amdgcn_perm(cd_lo, ab_lo, 0x05040100u), t1 = __builtin_amdgcn_perm(cd_lo, ab_lo, 0x07060302u);
            const unsigned t2 = __builtin_amdgcn_perm(cd_hi, ab_hi, 0x05040100u), t3 = __builtin_amdgcn_perm(cd_hi, ab_hi, 0x07060302u);
            S.acc[4 * p] = __builtin_amdgcn_sdot4((int)t0, wv, S.acc[4 * p], false); S.acc[4 * p + 1] = __builtin_amdgcn_sdot4((int)t1, wv, S.acc[4 * p + 1], false);
            S.acc[4 * p + 2] = __builtin_amdgcn_sdot4((int)t2, wv, S.acc[4 * p + 2], false); S.acc[4 * p + 3] = __builtin_amdgcn_sdot4((int)t3, wv, S.acc[4 * p + 3], false);
        }
    }
    if (HALF_ == 1) {
        const float sc = __uint_as_float(X.a[1].x);
        float fa[16];
#pragma unroll
        for (int j = 0; j < 16; ++j) fa[j] = (float)S.acc[j] * sc;
        float r[8];
#pragma unroll
        for (int j = 0; j < 8; ++j) r[j] = swap_add32(fa[j], fa[j + 8]);
        float s4[4];
#pragma unroll
        for (int j = 0; j < 4; ++j) s4[j] = swap_add16(r[j], r[j + 4]);
        const bool b3 = (lane & 8) != 0;
        float z[2];
#pragma unroll
        for (int j = 0; j < 2; ++j) { const float keep = b3 ? s4[j + 2] : s4[j], send = b3 ? s4[j] : s4[j + 2]; z[j] = keep + dppf(send, 3); }
        const int col = 16 * (lane & 7) + 2 * (lane >> 3);
        const unsigned rw = X.a[1].y;
        const float y0 = bflo(rw) + z[0], y1 = bfhi(rw) + z[1];
        if (LAST) { typedef float f32x2v __attribute__((ext_vector_type(2))); *(GAS f32x2v*)(out_cols + col) = (f32x2v){y0, y1}; }
        else *(GAS unsigned*)(res_w + col) = pk2(y0, y1);
    }
}
template <bool IS_V, bool DRY = false, bool LAST = false> __device__ __forceinline__ void peer_sliced(Frame& F, int l) {
    KArgs A = kargs(); unsigned char* const ws = A->ws;
    const int lane = F.lane, g = lane >> 3, c = lane & 7;
    const int xcc = (int)(xb_xcc_id() & 7u);
    gu32* ctr0 = (gu32*)(ws + WS_CTL) + CW_PEER + 64 * ((l * 4 + (IS_V ? 1 : 0) + (DRY ? 2 : 0)) * 8);
    const unsigned short* IDX = (const unsigned short*)(ws + WS_IDX);
    for (int s = 0; s < 8; ++s) {
        const int k = (xcc + s) & 7; gu32* ctr = ctr0 + 64 * k;
        const unsigned char* tab = ws + (IS_V ? WS_TV : WS_TU) + ((size_t)(l * 8 + k) * NEXP) * 128;
        int cur = peer_dequeue(ctr, lane);
        if (cur < PEER_NGRP) {
            size_t t0 = (size_t)cur * PEER_TG;
            HalfBuf H0, H1, H2, H3; IdSet I0, I1; TokAux X0, X1, X2, X3; UState US; VState VS;
#define PS_IDS(IS, t) ps_ids(IS, IDX + (t) * 128 + 16 * g)
#define PS_AUX(XS, t) do { if (IS_V) { XS.a[0] = *(const GAS v4u*)(ws + WS_EW8 + (t) * 128 + 16 * g); XS.a[1].x = __float_as_uint(((const float*)(ws + WS_EWSC))[(t) * 8 + g]); \
                               XS.a[1].y = *(const GAS unsigned*)((const bf16*)(ws + WS_RES) + (t) * D + 128 * k + 16 * c + 2 * g); }   \
                           else { XS.a[0] = *(const GAS v4u*)((const unsigned char*)A->out + OUT_MIX8 + (t) * D + 128 * k + 16 * c); XS.a[1].x = __float_as_uint(((const float*)((const unsigned char*)A->out + OUT_MS))[t]); } } while (0)
#define PS_G(HB, IS, hf) ps_gather<hf>(HB, tab, IS, c)
#define PS_C(HB, XS, t, hf) do { if (IS_V) ps_compute_v<hf, LAST>(HB, XS, VS, (const bf16*)(ws + WS_RES) + (t) * D + 128 * k, (bf16*)(ws + (DRY ? WS_Q2 : WS_RES)) + (t) * D + 128 * k, (DRY ? (float*)(ws + WS_Q2) : A->out) + (t) * D + 128 * k, lane); \
                                 else ps_compute_u<hf>(HB, XS, US, (bf16*)(ws + WS_PART) + ((size_t)k * M + (t)) * 128, g, c); } while (0)
            PS_IDS(I0, t0); PS_IDS(I1, t0 + 1); PS_AUX(X0, t0); PS_G(H0, I0, 0); PS_G(H1, I0, 1); PS_AUX(X1, t0 + 1); PS_G(H2, I1, 0);
            for (;;) {
                const unsigned nxt_v = peer_dequeue_issue(ctr, lane);
                PS_IDS(I0, t0 + 2);                    PS_G(H3, I1, 1); PS_C(H0, X0, t0, 0);
                PS_AUX(X2, t0 + 2);                    PS_G(H0, I0, 0); PS_C(H1, X0, t0, 1);
                PS_IDS(I1, t0 + 3);                    PS_G(H1, I0, 1); PS_C(H2, X1, t0 + 1, 0);
                PS_AUX(X3, t0 + 3);                    PS_G(H2, I1, 0); PS_C(H3, X1, t0 + 1, 1);
                const int nxt = peer_dequeue_get(nxt_v);
                const bool more = nxt < PEER_NGRP; const size_t t1 = (size_t)nxt * PEER_TG;
                if (more) PS_IDS(I0, t1);              PS_G(H3, I1, 1); PS_C(H0, X2, t0 + 2, 0);
                if (more) { PS_AUX(X0, t1);            PS_G(H0, I0, 0); } PS_C(H1, X2, t0 + 2, 1);
                if (more) { PS_IDS(I1, t1 + 1);        PS_G(H1, I0, 1); } PS_C(H2, X3, t0 + 3, 0);
                if (more) { PS_AUX(X1, t1 + 1);        PS_G(H2, I1, 0); } PS_C(H3, X3, t0 + 3, 1);
                if (!more) break;
                t0 = t1;
            }
#undef PS_IDS
#undef PS_AUX
#undef PS_G
#undef PS_C
        }
    }
}
__device__ __forceinline__ void peer_w(Frame& F, int l) {
    KArgs A = kargs(); unsigned char* const ws = A->ws;
    const unsigned short* IDX = (const unsigned short*)(ws + WS_IDX); const float* GATE = (const float*)(ws + WS_GATE); const bf16* PART = (const bf16*)(ws + WS_PART);
    const float* USC = (const float*)(ws + WS_USC) + l * NEXP; const float* VSC = (const float*)(ws + WS_VSC) + l * NEXP; const float* HS = (const float*)(ws + WS_RS);
    signed char* WQ = (signed char*)(ws + WS_EW8); float* WSC = (float*)(ws + WS_EWSC);
    LAS float* UL = (LAS float*)F.lds; LAS float* VL = UL + NEXP;
    for (int i = F.tid; i < NEXP / 4; i += NWAVES * 64) { ((LAS f32x4*)UL)[i] = ((const GAS f32x4*)USC)[i]; ((LAS f32x4*)VL)[i] = ((const GAS f32x4*)VSC)[i]; }
    __syncthreads();
    const unsigned nthr = (unsigned)F.NGW * 64u, pend = (unsigned)M * 64u, pstep = 4u * nthr; unsigned p0 = (unsigned)F.gw * 64u + (unsigned)F.lane;
    unsigned pr[4][8]; unsigned ei[4]; v2u gt[4];
#define W_LOAD(PR_, E_, GT_, P_) do { _Pragma("unroll") for (int j = 0; j < 4; ++j) { const unsigned pp = (P_) + j * nthr; \
            _Pragma("unroll") for (int k = 0; k < 8; ++k) PR_[j][k] = *(const GAS unsigned*)(PART + (size_t)k * M * 128 + 2u * pp); \
            E_[j] = *(const GAS unsigned*)(IDX + 2u * pp); GT_[j] = *(const GAS v2u*)(GATE + 2u * pp); } } while (0)
    if (p0 < pend) W_LOAD(pr, ei, gt, p0);
    for (; p0 < pend; p0 += pstep) {
        const bool hn = p0 + pstep < pend; unsigned prn[4][8]; unsigned ein[4]; v2u gtn[4];
        if (hn) W_LOAD(prn, ein, gtn, p0 + pstep);
#pragma unroll
        for (int j = 0; j < 4; ++j) { const unsigned pp = p0 + j * nthr; float pa = 0.f, pb = 0.f;
#pragma unroll
            for (int k = 0; k < 8; ++k) { pa += bflo(pr[j][k]); pb += bfhi(pr[j][k]); }
            const unsigned ea = ei[j] & 0xffffu, eb = ei[j] >> 16;
            const float wa = __uint_as_float(gt[j].x) * gelu_erf(pa * UL[ea]) * VL[ea], wb = __uint_as_float(gt[j].y) * gelu_erf(pb * UL[eb]) * VL[eb];
            float m = fmaxf(fabsf(wa), fabsf(wb));
            m = fmaxf(m, dppf(m, 0)); m = fmaxf(m, dppf(m, 1)); m = fmaxf(m, dppf(m, 2));
            const float inv = m > 0.f ? 127.f * __builtin_amdgcn_rcpf(m) : 0.f;
            const unsigned qa = __builtin_bit_cast(unsigned, __builtin_fmaf(wa, inv, 12582912.f)) & 0xffu, qb = __builtin_bit_cast(unsigned, __builtin_fmaf(wb, inv, 12582912.f)) & 0xffu;
            *(GAS unsigned short*)(WQ + 2u * pp) = (unsigned short)(qa | (qb << 8));
            if ((F.lane & 7) == 0) WSC[pp >> 3] = m * (1.f / 127.f); }
        if (hn) {
#pragma unroll
            for (int j = 0; j < 4; ++j) { ei[j] = ein[j]; gt[j] = gtn[j];
#pragma unroll
                for (int k = 0; k < 8; ++k) pr[j][k] = prn[j][k]; } }
    }
#undef W_LOAD
}

#define GBAR() asm volatile("s_waitcnt lgkmcnt(0)\n\ts_barrier" ::: "memory")
namespace glas {
constexpr int LPQ = 72, LPG = 136, GP = 65;
constexpr int O_GF = 0, O_TT = 64 * GP * 4, O_BL = O_TT + 2048, O_KR = O_BL + 256, O_KRT = O_KR + 9216, O_QR = O_KRT + 9216, O_QD = O_QR  , O_KI = O_KR  , O_KDT = O_QR + 9216, O_VT = O_KDT + 9216,
              O_AM = O_VT + 18432, O_GO = O_AM + 9216, O_OST = O_GO + 64 * LPG * 2, O_DEC = O_OST + 64 * LPG * 2, O_SS = O_DEC + 256, O_RS = O_SS + 2048  , O_END = O_RS + 2048;
static_assert(O_END <= 131072 && O_TT % 16 == 0 && O_KR % 16 == 0 && O_DEC % 16 == 0 && O_SS % 16 == 0, "gla LDS");
struct Pre { v4u g, go[2], q, v[2], k; };
template <int PASS> __device__ __forceinline__ void prefetch(Pre& P, const unsigned char* ws, size_t t0, int hh, int tid) {
    const bf16* GLOG = (const bf16*)(ws + WS_GLOG); const bf16* GQ = (const bf16*)(ws + WS_GQ); const bf16* GK = (const bf16*)(ws + WS_GK); const bf16* GV = (const bf16*)(ws + WS_GV); const bf16* GO = (const bf16*)(ws + WS_GO);
#pragma unroll
    for (int i = 0; i < 2; ++i) { const int p = tid + 512 * i, c = p >> 4, j = p & 15;
        if (PASS == 2) P.go[i] = *(const GAS v4u*)(GO + (t0 + c) * 512 + hh * 128 + 8 * j);
        const int cv = tid & 63, jv = (tid >> 6) + 8 * i;
        P.v[i] = *(const GAS v4u*)(GV + (t0 + cv) * 512 + hh * 128 + 8 * jv); }
    { const int c = tid >> 3, j = tid & 7; P.g = *(const GAS v4u*)(GLOG + (t0 + c) * 256 + hh * 64 + 8 * j); if (PASS == 2) P.q = *(const GAS v4u*)(GQ + (t0 + c) * 256 + hh * 64 + 8 * j); }
    { const int c = tid & 63, j = tid >> 6; P.k = *(const GAS v4u*)(GK + (t0 + c) * 256 + hh * 64 + 8 * j); }
}
__device__ __forceinline__ float rowsum16(float v) {
    v += dppf(v, 0); v += dppf(v, 1); v += dppf(v, 2);
    v += __builtin_bit_cast(float, __builtin_amdgcn_update_dpp(0, __builtin_bit_cast(int, v), 0x140, 0xf, 0xf, true));
    return v;
}
}
template <int PASS> __device__ __forceinline__ void gla_run(Frame& F, int l, int run) {
    using namespace glas;
    KArgs A = kargs(); unsigned char* const ws = A->ws;
    const int bh = run >> 4, n0 = (run & 15) * 8, b = bh >> 2, hh = bh & 3, tid = F.tid, lane = F.lane, w = F.wave, q4 = lane >> 4, r16 = lane & 15;
    LAS float* Gf = (LAS float*)(F.lds + O_GF); LAS float* Tt = (LAS float*)(F.lds + O_TT); LAS float* BL = (LAS float*)(F.lds + O_BL);
    LAS bf16* Kr = (LAS bf16*)(F.lds + O_KR); LAS bf16* KrT = (LAS bf16*)(F.lds + O_KRT); LAS bf16* Qr = (LAS bf16*)(F.lds + O_QR); LAS bf16* Qd = (LAS bf16*)(F.lds + O_QD); LAS bf16* Ki = (LAS bf16*)(F.lds + O_KI);
    LAS bf16* KdT = (LAS bf16*)(F.lds + O_KDT); LAS bf16* VT = (LAS bf16*)(F.lds + O_VT); LAS bf16* Am = (LAS bf16*)(F.lds + O_AM); LAS bf16* GOs = (LAS bf16*)(F.lds + O_GO); LAS bf16* Ost = (LAS bf16*)(F.lds + O_OST);
    LAS float* DEC = (LAS float*)(F.lds + O_DEC); LAS float* SS = (LAS float*)(F.lds + O_SS); LAS float* RSL = (LAS float*)(F.lds + O_RS) + 64 * F.wave;
    bf16* MIX = (bf16*)A->out;
    float* USUM = (float*)(ws + WS_USUM); float* PDS = (float*)(ws + WS_PDS);
    const float wg = A->in[I_GONW][l * 128 + 16 * w + r16];
    f32x4 S[4], pd[4];
#pragma unroll
    for (int t = 0; t < 4; ++t) { S[t] = (f32x4){0.f, 0.f, 0.f, 0.f}; pd[t] = (f32x4){1.f, 1.f, 1.f, 1.f}; }
    Pre P; prefetch<PASS>(P, ws, (size_t)b * T + (size_t)n0 * 64, hh, tid);
    if (PASS == 2) {
        int rp = run & ~15;
        for (; rp + 2 <= run; rp += 2) {
            f32x4 us[2][4], ps[2][4];
#pragma unroll
            for (int j = 0; j < 2; ++j)
#pragma unroll
                for (int t = 0; t < 4; ++t) { us[j][t] = *(const GAS f32x4*)(USUM + ((size_t)(rp + j) * 512 + tid) * 16 + 4 * t); ps[j][t] = *(const GAS f32x4*)(PDS + (size_t)(rp + j) * 64 + 16 * t + 4 * q4); }
#pragma unroll
            for (int j = 0; j < 2; ++j)
#pragma unroll
                for (int t = 0; t < 4; ++t) S[t] = S[t] * ps[j][t] + us[j][t];
        }
        for (; rp < run; ++rp) {
#pragma unroll
            for (int t = 0; t < 4; ++t) { const f32x4 us = *(const GAS f32x4*)(USUM + ((size_t)rp * 512 + tid) * 16 + 4 * t), ps = *(const GAS f32x4*)(PDS + (size_t)rp * 64 + 16 * t + 4 * q4); S[t] = S[t] * ps + us; }
        }
    }
    for (int nn = 0; nn <= 8; ++nn) {
        const int n = n0 + nn;
        const size_t t0 = (size_t)b * T + (size_t)n * 64;
        if (nn == 8) {
            if (PASS == 2 && nn > 0) {
#pragma unroll
                for (int i = 0; i < 2; ++i) { const int p = tid + 512 * i, c = p >> 4, j = p & 15;
                    *(GAS v4u*)(MIX + (t0 - 64 + c) * 1024 + 512 + hh * 128 + 8 * j) = *(const LAS v4u*)(Ost + c * LPG + 8 * j); }
            }
            break;
        }
#pragma unroll
        for (int i = 0; i < 2; ++i) { const int p = tid + 512 * i, c = p >> 4, j = p & 15;
            if (PASS == 2) *(LAS v4u*)(GOs + c * LPG + 8 * j) = P.go[i];
            const int cv = tid & 63, jv = (tid >> 6) + 8 * i; const unsigned vv[4] = {P.v[i].x, P.v[i].y, P.v[i].z, P.v[i].w};
#pragma unroll
            for (int e = 0; e < 4; ++e) { VT[(8 * jv + 2 * e) * LPQ + cv] = (bf16)(vv[e] & 0xffffu); VT[(8 * jv + 2 * e + 1) * LPQ + cv] = (bf16)(vv[e] >> 16); } }
        { const int c = tid >> 3, j = tid & 7; const unsigned gw_[4] = {P.g.x, P.g.y, P.g.z, P.g.w};
#pragma unroll
          for (int e = 0; e < 4; ++e) { Gf[c * GP + 8 * j + 2 * e] = bflo(gw_[e]); Gf[c * GP + 8 * j + 2 * e + 1] = bfhi(gw_[e]); }
          if (PASS == 2) *(LAS v4u*)(Qr + c * LPQ + 8 * j) = P.q; }
        { const int c = tid & 63, j = tid >> 6; *(LAS v4u*)(Kr + c * LPQ + 8 * j) = P.k; const unsigned kk[4] = {P.k.x, P.k.y, P.k.z, P.k.w};
#pragma unroll
          for (int e = 0; e < 4; ++e) { KrT[(8 * j + 2 * e) * LPQ + c] = (bf16)(kk[e] & 0xffffu); KrT[(8 * j + 2 * e + 1) * LPQ + c] = (bf16)(kk[e] >> 16); } }
        if (PASS == 2 && nn > 0) {
#pragma unroll
            for (int i = 0; i < 2; ++i) { const int p = tid + 512 * i, c = p >> 4, j = p & 15;
                *(GAS v4u*)(MIX + (t0 - 64 + c) * 1024 + 512 + hh * 128 + 8 * j) = *(const LAS v4u*)(Ost + c * LPG + 8 * j); }
        }
        if (nn + 1 < 8) prefetch<PASS>(P, ws, t0 + 64, hh, tid);
        GBAR();
        { const int d = tid & 63, seg = tid >> 6; float bv[8]; float run = 0.f;
#pragma unroll
          for (int i = 0; i < 8; ++i) { run += Gf[(8 * seg + i) * GP + d]; bv[i] = run; }
          Tt[seg * 64 + d] = run;
          GBAR();
          float off = 0.f, bl = 0.f;
#pragma unroll
          for (int s = 0; s < 8; ++s) { const float tt = Tt[s * 64 + d]; bl += tt; off += (s < seg) ? tt : 0.f; }
          if (seg == 0) { DEC[d] = __builtin_amdgcn_exp2f(bl); BL[d] = bl; }
#pragma unroll
          for (int i = 0; i < 8; ++i) { const int c = 8 * seg + i; const float bc = bv[i] + off; Gf[c * GP + d] = bc;
              if (PASS == 2) { const float q = bf2f(Qr[c * LPQ + d]), k = bf2f(Kr[c * LPQ + d]);
                  Qd[c * LPQ + d] = (bf16)f2bf(q * 0.125f * __builtin_amdgcn_exp2f(bc)); Ki[c * LPQ + d] = (bf16)f2bf(k * __builtin_amdgcn_exp2f(-bc)); } } }
        GBAR();
        { const int c = tid & 63, dseg = tid >> 6;
#pragma unroll
          for (int i = 0; i < 8; ++i) { const int d = 8 * dseg + i; KdT[d * LPQ + c] = (bf16)f2bf(bf2f(KrT[d * LPQ + c]) * __builtin_amdgcn_exp2f(BL[d] - Gf[c * GP + d])); } }
        if (PASS == 2) { const int ti = w >> 1;
#pragma unroll
          for (int tjj = 0; tjj < 2; ++tjj) { const int tj = 2 * (w & 1) + tjj; const f32x4 a = mma16_k64(Qd + 16 * ti * LPQ, LPQ, Ki + 16 * tj * LPQ, LPQ, lane);
#pragma unroll
              for (int r = 0; r < 4; ++r) { const int i = 16 * ti + 4 * q4 + r, j = 16 * tj + r16; Am[i * LPQ + j] = (bf16)f2bf(i >= j ? a[r] : 0.f); } } }
        GBAR();
        f32x4 o[4];
        if (PASS == 2) { bf16x8 sb[2];
#pragma unroll
          for (int kk = 0; kk < 2; ++kk) { v4u pk; pk.x = pk2(S[2 * kk][0], S[2 * kk][1]); pk.y = pk2(S[2 * kk][2], S[2 * kk][3]); pk.z = pk2(S[2 * kk + 1][0], S[2 * kk + 1][1]); pk.w = pk2(S[2 * kk + 1][2], S[2 * kk + 1][3]); sb[kk] = __builtin_bit_cast(bf16x8, pk); }
#pragma unroll
          for (int ti = 0; ti < 4; ++ti) { f32x4 acc = mma16_k64(Am + 16 * ti * LPQ, LPQ, VT + 16 * w * LPQ, LPQ, lane);
#pragma unroll
              for (int kk = 0; kk < 2; ++kk) { const LAS bf16* qp = Qd + (16 * ti + r16) * LPQ + 32 * kk + 4 * q4;
                  const v2u lo = *(const LAS v2u*)qp, hi = *(const LAS v2u*)(qp + 16); v4u av; av.x = lo.x; av.y = lo.y; av.z = hi.x; av.w = hi.y;
                  acc = __builtin_amdgcn_mfma_f32_16x16x32_bf16(__builtin_bit_cast(bf16x8, av), sb[kk], acc, 0, 0, 0); }
              o[ti] = acc; } }
#pragma unroll
        for (int t = 0; t < 4; ++t) { const f32x4 dv = *(const LAS f32x4*)(DEC + 16 * t + 4 * q4); f32x4 acc = S[t] * dv;
            pd[t] = pd[t] * dv;
            const LAS bf16* ap = KdT + (16 * t + r16) * LPQ + 8 * q4; const LAS bf16* bp = VT + (16 * w + r16) * LPQ + 8 * q4;
#pragma unroll
            for (int kk = 0; kk < 2; ++kk) acc = __builtin_amdgcn_mfma_f32_16x16x32_bf16(*(const LAS bf16x8*)(ap + 32 * kk), *(const LAS bf16x8*)(bp + 32 * kk), acc, 0, 0, 0);
            S[t] = acc; }
        if (PASS == 1) { GBAR(); continue; }
        { float v16[16];
#pragma unroll
          for (int ti = 0; ti < 4; ++ti)
#pragma unroll
              for (int r = 0; r < 4; ++r) v16[4 * ti + r] = o[ti][r] * o[ti][r];
          const bool b3 = (r16 & 8) != 0, b2 = (r16 & 4) != 0, b1 = (r16 & 2) != 0, b0 = (r16 & 1) != 0;
          float a8[8], a4[4], a2[2];
#pragma unroll
          for (int i = 0; i < 8; ++i) { const float keep = b3 ? v16[i + 8] : v16[i], send = b3 ? v16[i] : v16[i + 8]; a8[i] = keep + dppf(send, 3); }
#pragma unroll
          for (int i = 0; i < 4; ++i) { const float keep = b2 ? a8[i + 4] : a8[i], send = b2 ? a8[i] : a8[i + 4]; a4[i] = keep + dppf(send, 2); }
#pragma unroll
          for (int i = 0; i < 2; ++i) { const float keep = b0 ? a4[i + 2] : a4[i], send = b0 ? a4[i] : a4[i + 2]; a2[i] = keep + dppf(send, 0); }
          const float keep = b1 ? a2[1] : a2[0], send = b1 ? a2[0] : a2[1]; const float tot1 = keep + dppf(send, 1);
          const int idx = ((r16 >> 1) & 1) + 2 * (r16 & 1) + 4 * ((r16 >> 2) & 1) + 8 * (r16 >> 3);
          SS[w * 64 + 16 * (idx >> 2) + 4 * q4 + (idx & 3)] = tot1; }
        GBAR();
        { const int cp = 16 * (r16 >> 2) + 4 * q4 + (r16 & 3); float t = 0.f;
#pragma unroll
          for (int ww = 0; ww < 8; ++ww) t += SS[ww * 64 + cp];
          RSL[cp] = __builtin_amdgcn_rsqf(t * (1.f / 128.f) + RMS_EPS); }
        asm volatile("s_waitcnt lgkmcnt(0)" ::: "memory");
#pragma unroll
        for (int ti = 0; ti < 4; ++ti) { const f32x4 rs4 = *(const LAS f32x4*)(RSL + 16 * ti + 4 * q4);
#pragma unroll
            for (int r = 0; r < 4; ++r) { const int c = 16 * ti + 4 * q4 + r; const float rs = rs4[r];
                const float g = bf2f(GOs[c * LPG + 16 * w + r16]);
                Ost[c * LPG + 16 * w + r16] = (bf16)f2bf(o[ti][r] * rs * wg * (g * __builtin_amdgcn_rcpf(1.f + __expf(-g)))); } }
        GBAR();
    }
    if (PASS == 1) {
#pragma unroll
        for (int t = 0; t < 4; ++t) { *(GAS f32x4*)(USUM + ((size_t)run * 512 + tid) * 16 + 4 * t) = S[t]; if (w == 0 && r16 == 0) *(GAS f32x4*)(PDS + (size_t)run * 64 + 16 * t + 4 * q4) = pd[t]; }
    }
}
__device__ __forceinline__ Frame mkframe(unsigned char* lds) {
    Frame F; int tx = threadIdx.x, bx = blockIdx.x, G = gridDim.x;
    { volatile LAS unsigned* st = (volatile LAS unsigned*)((LAS unsigned char*)lds + MISC_OFF) + 8; if (st[3]) bx = (int)((xb_xcc_id() & 7u) + 8u * st[2]); }
    bx = __builtin_amdgcn_readfirstlane(bx);
    asm volatile("" : "+v"(tx)); asm volatile("" : "+s"(bx)); asm volatile("" : "+s"(G));
    F.lds = (LAS unsigned char*)lds; F.tid = tx; F.lane = tx & 63; F.wave = __builtin_amdgcn_readfirstlane(tx >> 6);
    F.G = G; F.bx = bx; F.vcu = (G % 8 == 0) ? (bx % 8) * (G / 8) + bx / 8 : bx; F.gw = bx * NWAVES + F.wave; F.NGW = G * NWAVES;
    return F;
}
__device__ __forceinline__ void seam(unsigned char* lds, int k) {
    KArgs A = kargs(); const int lo = A->ph_lo, hi = A->ph_hi;
    if (!(lo <= k && k + 1 < hi)) return;
    XcdBarrier b; b.bar = (unsigned*)(A->ws + WS_CTL) + CW_BAR; b.x = xb_xcc_id(); b.st = (volatile LAS unsigned*)((LAS unsigned char*)lds + MISC_OFF) + 8;
    xcd_barrier(b);
#ifdef PROBE_DUP_BAR
    xcd_barrier(b);
#endif
}
__device__ __forceinline__ void seam_local(unsigned char* lds, int k) {
    KArgs A = kargs(); const int lo = A->ph_lo, hi = A->ph_hi;
    if (!(lo <= k && k + 1 < hi)) return;
    XcdBarrier b; b.bar = (unsigned*)(A->ws + WS_CTL) + CW_BAR; b.x = xb_xcc_id(); b.st = (volatile LAS unsigned*)((LAS unsigned char*)lds + MISC_OFF) + 8;
    if (b.st[3]) xcd_local_barrier(b, (unsigned*)(A->ws + WS_CTL) + CW_LBAR); else xcd_barrier(b);
}
__device__ __forceinline__ bool phase_on(int k) { KArgs A = kargs(); return A->ph_lo <= k && k < A->ph_hi; }

__device__ __forceinline__ int probe_reps(bool on) { int n = on ? 2 : 1; asm volatile("" : "+s"(n)); return n; }
#ifdef PROBE_DUP_A1
#define REP_A1 true
#else
#define REP_A1 false
#endif
#ifdef PROBE_DUP_C1
#define REP_C1 true
#else
#define REP_C1 false
#endif
#ifdef PROBE_DUP_P0
#define REP_P0 true
#else
#define REP_P0 false
#endif
#ifdef PROBE_DUP_D1
#define REP_D1 true
#else
#define REP_D1 false
#endif
__device__ __forceinline__ bool attn_scores_bounded(int l) {
    KArgs A = kargs(); int tx = threadIdx.x; asm volatile("" : "+v"(tx)); const int lane = tx & 63;
    float mq = fabsf(A->in[I_QNW][l * 64 + lane]), mk = fabsf(A->in[I_KNW][l * 64 + lane]);
#pragma unroll
    for (int o = 1; o < 64; o <<= 1) { mq = fmaxf(mq, __shfl_xor(mq, o)); mk = fmaxf(mk, __shfl_xor(mk, o)); }
    return __builtin_amdgcn_readfirstlane((int)(8.f * 1.4426950408889634f * mq * mk < 60.f)) != 0;
}
template <int L> __device__ __forceinline__ void layer_fwd(unsigned char* lds) {
    constexpr int pb = 1 + 12 * L;
    if (phase_on(pb + 0)) {
        Frame F = mkframe(lds); KArgs A = kargs(); unsigned char* const ws = A->ws;
        pg8::Gemm g{(const bf16*)(ws + WS_XN8), (const bf16*)(ws + WS_WIN + (size_t)L * NIN * D), M, NIN, D / 2}; pg8::StaticOrder S; S.init(M, NIN, F.G, F.bx);
        pg8::EpiInProj E{ws, A->in[I_GB] + L * 256, A->in[I_QNW] + L * 64, A->in[I_KNW] + L * 64, attn_body::C2, (const float*)(ws + WS_AS), (const float*)(ws + WS_WCS) + L * NIN};
#ifdef PROBE_DUP_A1
        for (int rep = probe_reps(true); rep > 0; --rep)
#endif
        pg8::gemm_phase<pg8::EpiInProj, pg8::StaticOrder, true, true>(F.lds + RING_OFF, g, S, E);
    }
    if (phase_on(pb + 0)) {
        Frame F = mkframe(lds); const int nfull = ((M / 256) * (NIN / 256)) % F.G;
        if (nfull == 0) quant_tables(kargs(), L, F.gw, F.NGW, F.lane);
        else if (F.bx >= nfull) quant_tables(kargs(), L, (F.bx - nfull) * NWAVES + F.wave, (F.G - nfull) * NWAVES, F.lane);
    }
    seam_local(lds, pb + 0);
    if (phase_on(pb + 1)) { Frame F = mkframe(lds);
#ifdef PROBE_DUP_GLA1
        for (int rep = probe_reps(true); rep > 0; --rep)
#endif
        if (F.G == 256) { const int x = F.bx & 7, j = F.bx >> 3; gla_run<1>(F, L, (((x >> 1) * 4 + (j >> 3)) << 4) + 8 * (x & 1) + (j & 7)); }
        else for (int run = F.bx; run < 256; run += F.G) gla_run<1>(F, L, run); }
    seam(lds, pb + 1);
    if (phase_on(pb + 2)) { Frame F = mkframe(lds);
#ifdef PROBE_DUP_GLA2
        for (int rep = probe_reps(true); rep > 0; --rep)
#endif
        if (F.G == 256) { const int x = F.bx & 7, j = F.bx >> 3; gla_run<2>(F, L, (((x >> 1) * 4 + (j >> 3)) << 4) + 8 * (x & 1) + (j & 7)); }
        else for (int run = F.bx; run < 256; run += F.G) gla_run<2>(F, L, run); }
    if (phase_on(pb + 2) && attn_scores_bounded(L)) {
        Frame F = mkframe(lds); unsigned char* const ws = kargs()->ws;
        static_assert(attn_body::L2_BYTES <= RING_BYTES && attn_body::ATTN_LDS_BYTES <= RING_BYTES, "attention LDS");
        const attn_body::StaticOrder128 S(F.G, F.bx);
#ifdef PROBE_DUP_ATTN
        for (int rep = probe_reps(true); rep > 0; --rep)
#endif
        attn_body::attn_phase128((char*)lds + RING_OFF, (const attn_body::bf16*)(ws + WS_Q), (const attn_body::bf16*)(ws + WS_K), (const attn_body::bf16*)(ws + WS_DV), (attn_body::bf16*)(ws + WS_O), S);
    }
    if (phase_on(pb + 2) && !attn_scores_bounded(L)) {
        Frame F = mkframe(lds); unsigned char* const ws = kargs()->ws;
        const attn_body::AttnTensors AT{(const attn_body::bf16*)(ws + WS_Q), (const attn_body::bf16*)(ws + WS_K), (const attn_body::bf16*)(ws + WS_DV), (attn_body::bf16*)(ws + WS_O)};
        const attn_body::StaticOrder S(F.G, F.bx);
        attn_body::attn_phase<attn_body::StaticOrder>((char*)lds + RING_OFF, AT, S);
    }
    seam(lds, pb + 2);
    if (phase_on(pb + 3)) { Frame F = mkframe(lds);
#ifdef PROBE_DUP_DIFF
        for (int rep = probe_reps(true); rep > 0; --rep)
#endif
        diff_rows(F, L); }
    seam_local(lds, pb + 3);
    if (phase_on(pb + 4)) {
        Frame F = mkframe(lds); KArgs A = kargs(); unsigned char* const ws = A->ws;
        pg8::Gemm g{(const bf16*)((const unsigned char*)A->out + OUT_MIX8)  , (const bf16*)(ws + WS_WOUT + (size_t)L * D * D), M, D, D / 2}; pg8::StaticOrder S; S.init(M, D, F.G, F.bx);
        pg8::EpiResid<L == 0> E{A->in[I_X], (bf16*)(ws + WS_RES), (const float*)((const unsigned char*)A->out + OUT_MS), (const float*)(ws + WS_WOCS) + L * D};
#ifdef PROBE_DUP_C2
        for (int rep = probe_reps(L == 0); rep > 0; --rep)
#endif
        pg8::gemm_phase<pg8::EpiResid<L == 0>, pg8::StaticOrder, true, true>(F.lds + RING_OFF, g, S, E);
    }
    seam_local(lds, pb + 4);
    if (phase_on(pb + 5)) { Frame F = mkframe(lds); KArgs A = kargs(); unsigned char* const ws = A->ws;
        unsigned char* XR8 = (unsigned char*)A->out + OUT_MIX8; float* XS = (float*)((unsigned char*)A->out + OUT_MS);
        const int NX = (F.G & 7) == 0 ? 8 : 1, XI = F.bx % NX, RX = M / NX, xw = (F.bx / NX) * NWAVES + F.wave, WX = (F.G / NX) * NWAVES;
        const int mend = RX * (XI + 1), mstep = 4 * WX; int m0 = RX * XI + 4 * xw;
        v4u r[4][2];
#define R8_LOAD(R_, M_) do { _Pragma("unroll") for (int j = 0; j < 4; ++j) { const GAS v4u* rp = (const GAS v4u*)((const bf16*)(ws + WS_RES) + (size_t)((M_) + j) * D + 16 * F.lane); R_[j][0] = rp[0]; R_[j][1] = rp[1]; } } while (0)
        if (m0 < mend) R8_LOAD(r, m0);
        for (; m0 < mend; m0 += mstep) {
            const bool hn = m0 + mstep < mend; v4u rn[4][2];
            if (hn) R8_LOAD(rn, m0 + mstep);
#pragma unroll
            for (int j = 0; j < 4; ++j) { const v4u a0 = r[j][0], a1 = r[j][1]; f32x4 va[4];
                va[0] = (f32x4){bflo(a0.x), bfhi(a0.x), bflo(a0.y), bfhi(a0.y)}; va[1] = (f32x4){bflo(a0.z), bfhi(a0.z), bflo(a0.w), bfhi(a0.w)}; va[2] = (f32x4){bflo(a1.x), bfhi(a1.x), bflo(a1.y), bfhi(a1.y)}; va[3] = (f32x4){bflo(a1.z), bfhi(a1.z), bflo(a1.w), bfhi(a1.w)};
                row_to_i8(F.lane, va, nullptr, XR8 + (size_t)(m0 + j) * D, XS + m0 + j, (float*)(ws + WS_RS) + m0 + j); }
            if (hn) {
#pragma unroll
                for (int j = 0; j < 4; ++j) { r[j][0] = rn[j][0]; r[j][1] = rn[j][1]; } }
        }
#undef R8_LOAD
    }
    seam_local(lds, pb + 5);
    if (phase_on(pb + 6)) {
        Frame F = mkframe(lds); KArgs A = kargs(); unsigned char* const ws = A->ws;
        pg8::Gemm g{(const bf16*)((const unsigned char*)A->out + OUT_MIX8), (const bf16*)(ws + WS_WQ + (size_t)L * 2048 * D), M, 2048, D / 2}; pg8::StaticOrder S; S.init(M, 2048, F.G, F.bx);
        pg8::EpiRowScale E{(bf16*)(ws + WS_Q2), 2048, (const float*)((const unsigned char*)A->out + OUT_MS), (const float*)(ws + WS_WQCS) + L * 2048};
#ifdef PROBE_DUP_D1
        for (int rep = probe_reps(true); rep > 0; --rep)
#endif
        pg8::gemm_phase<pg8::EpiRowScale, pg8::StaticOrder, true, true>(F.lds + RING_OFF, g, S, E);
    }
    seam_local(lds, pb + 6);
    if (phase_on(pb + 7)) { Frame F = mkframe(lds);
#if defined(PROBE_DUP_D2)
        int nrep = 2; asm volatile("" : "+s"(nrep));
        for (int rep = 0; rep < nrep; ++rep)
#endif
        peer_select(F, L);
    }
    seam(lds, pb + 7);
    if (phase_on(pb + 8)) { Frame F = mkframe(lds); peer_sliced<false>(F, L);
#if defined(PROBE_DUP_U)
        peer_sliced<false, true>(F, L);
#endif
    }
    seam(lds, pb + 8);
    if (phase_on(pb + 9)) { Frame F = mkframe(lds);
#ifdef PROBE_DUP_W
        for (int rep = probe_reps(true); rep > 0; --rep)
#endif
        peer_w(F, L); }
    seam(lds, pb + 9);
    if (phase_on(pb + 10)) { Frame F = mkframe(lds);
#if defined(PROBE_DUP_V)
        peer_sliced<true, true, L + 1 == DEPTH>(F, L);
#endif
        peer_sliced<true, false, L + 1 == DEPTH>(F, L); }
    seam(lds, pb + 10);
    if (L + 1 < DEPTH) {
        if (phase_on(pb + 11)) { Frame F = mkframe(lds); KArgs A = kargs(); unsigned char* const ws = A->ws;
            const int NX = (F.G & 7) == 0 ? 8 : 1, XI = F.bx % NX, RX = M / NX, xw = (F.bx / NX) * NWAVES + F.wave, WX = (F.G / NX) * NWAVES;
            const int mend = RX * (XI + 1), mstep = 4 * WX; int m0 = RX * XI + 4 * xw;
            v4u r[4][2];
#define E8_LOAD(R_, M_) do { _Pragma("unroll") for (int j = 0; j < 4; ++j) { const GAS v4u* rp = (const GAS v4u*)((const bf16*)(ws + WS_RES) + (size_t)((M_) + j) * D + 16 * F.lane); R_[j][0] = rp[0]; R_[j][1] = rp[1]; } } while (0)
            if (m0 < mend) E8_LOAD(r, m0);
            for (; m0 < mend; m0 += mstep) {
                const bool hn = m0 + mstep < mend; v4u rn[4][2];
                if (hn) E8_LOAD(rn, m0 + mstep);
#pragma unroll
                for (int j = 0; j < 4; ++j) { const v4u a0 = r[j][0], a1 = r[j][1]; f32x4 va[4];
                    va[0] = (f32x4){bflo(a0.x), bfhi(a0.x), bflo(a0.y), bfhi(a0.y)}; va[1] = (f32x4){bflo(a0.z), bfhi(a0.z), bflo(a0.w), bfhi(a0.w)}; va[2] = (f32x4){bflo(a1.x), bfhi(a1.x), bflo(a1.y), bfhi(a1.y)}; va[3] = (f32x4){bflo(a1.z), bfhi(a1.z), bflo(a1.w), bfhi(a1.w)};
                    row_to_i8(F.lane, va, nullptr, ws + WS_XN8 + (size_t)(m0 + j) * D, (float*)(ws + WS_AS) + m0 + j); }
                if (hn) {
#pragma unroll
                    for (int j = 0; j < 4; ++j) { r[j][0] = rn[j][0]; r[j][1] = rn[j][1]; } }
            }
#undef E8_LOAD
        }
        seam_local(lds, pb + 11);
    }
}

__global__ void __launch_bounds__(NWAVES * 64, 2) mega_fwd(Args args) {
    extern __shared__ __attribute__((aligned(16))) unsigned char lds[];
    (void)args;
    { const int tx = threadIdx.x; for (int u = tx; u < (LDS_BYTES - LDSCTL_OFF) / 4; u += NWAVES * 64) ((LAS unsigned*)((LAS unsigned char*)lds + LDSCTL_OFF))[u] = 0u; }
    __syncthreads();
    { KArgs A = kargs(); if (A->ph_hi - A->ph_lo > 1) (void)xcd_barrier_post((unsigned*)(A->ws + WS_CTL) + CW_BAR, (volatile LAS unsigned*)((LAS unsigned char*)lds + MISC_OFF) + 8); }
    if (phase_on(0)) { Frame F = mkframe(lds);
#ifdef PROBE_DUP_P0
        for (int rep = probe_reps(true); rep > 0; --rep)
#endif
        p0_prologue(F); }
    seam(lds, 0);
    layer_fwd<0>(lds);
    layer_fwd<1>(lds);
}

extern "C" void kernel_launch(void* const* d_in, const int* in_sizes, int n_in, void* d_out, int out_size, void* d_ws, size_t ws_size, hipStream_t stream) {
    static int grid = 0;
    if (grid == 0) {
        if (n_in != 19 || in_sizes[0] != M * D || out_size != M * D || ws_size < WS_END) { fprintf(stderr, "kernel_launch: unexpected shapes (n_in %d, in0 %d, out %d, ws %zu)\n", n_in, n_in > 0 ? in_sizes[0] : -1, out_size, ws_size); grid = -1; return; }
        int dev = 0, cus = 0, per_cu = 0;
        if (hipGetDevice(&dev) != hipSuccess || hipDeviceGetAttribute(&cus, hipDeviceAttributeMultiprocessorCount, dev) != hipSuccess) { grid = -1; return; }
        if (hipFuncSetAttribute((const void*)mega_fwd, hipFuncAttributeMaxDynamicSharedMemorySize, LDS_BYTES) != hipSuccess) { fprintf(stderr, "kernel_launch: hipFuncSetAttribute failed\n"); grid = -1; return; }
        if (hipOccupancyMaxActiveBlocksPerMultiprocessor(&per_cu, (const void*)mega_fwd, NWAVES * 64, LDS_BYTES) != hipSuccess || per_cu < 1) fprintf(stderr, "kernel_launch: occupancy query reports %d\n", per_cu);
        (void)hipGetLastError();
        grid = cus;
    }
    if (grid < 0) return;
    if (hipMemsetAsync((char*)d_ws + WS_CTL, 0, CTL_ZERO_BYTES, stream) != hipSuccess) return;
    Args a{};
    for (int i = 0; i < 19; ++i) a.in[i] = (const float*)d_in[i];
    a.out = (float*)d_out; a.ws = (unsigned char*)d_ws;
#if MK_PER_PHASE
    for (int p = 0; p < NPHASE; ++p) { a.ph_lo = p; a.ph_hi = p + 1; hipLaunchKernelGGL(mega_fwd, dim3(grid), dim3(NWAVES * 64), LDS_BYTES, stream, a); }
#else
    a.ph_lo = 0; a.ph_hi = NPHASE; hipLaunchKernelGGL(mega_fwd, dim3(grid), dim3(NWAVES * 64), LDS_BYTES, stream, a);
#endif
}
```
